# Optimizing an MI355X kernel written in HIP

```python
import math
import jax, jax.numpy as jnp
from jax import lax
import numpy as np


D_MODEL = 1024
BATCH = 2
SEQ = 8192
DEPTH = 2

PLE_DIM = 256
CONV_W = 5
LN_EPS = 1e-5

GDN_HEADS = 4
GDN_DK = 128
GDN_DV = 128
GDN_CHUNK = 64
GDN_WIDTH = GDN_HEADS * GDN_DV
GDN_QKV = 2 * GDN_HEADS * GDN_DK + GDN_WIDTH
GDN_COLS = GDN_QKV + GDN_WIDTH + 2 * 2 * GDN_HEADS

RWKV_HEADS = 8
RWKV_HD = 64
RWKV_WIDTH = RWKV_HEADS * RWKV_HD
RWKV_DECAY_RANK = 64
RWKV_ICL_RANK = 64
RWKV_GATE_RANK = 128
RWKV_GN_EPS = 64e-5
RWKV_COLS = 3 * RWKV_WIDTH + 2 * RWKV_DECAY_RANK + 2 * RWKV_ICL_RANK + RWKV_GATE_RANK

SSD_HEADS = 16
SSD_HD = 64
SSD_WIDTH = SSD_HEADS * SSD_HD
SSD_GROUPS = 2
SSD_STATE = 128
SSD_CHUNK = 128
SSD_XBC = SSD_WIDTH + 2 * SSD_GROUPS * SSD_STATE
SSD_COLS = SSD_WIDTH + SSD_XBC + 2 * SSD_HEADS

N_BRANCH = 3
MIX_WIDTH = GDN_WIDTH + RWKV_WIDTH + SSD_WIDTH
GATE_COLS = N_BRANCH * D_MODEL
IN_COLS = GDN_COLS + RWKV_COLS + SSD_COLS + GATE_COLS

N_EXPERTS = 32
TOP_K = 4
D_EXPERT = 1024
SWIGLU_LIMIT = 7.0
SWIGLU_ALPHA = 1.702
MOE_BLOCK = 256

DEEPNORM_ALPHA = (2 * DEPTH) ** 0.25
DEEPNORM_BETA = (8 * DEPTH) ** -0.25

kernel_name = 'bidir_hybrid_gdn_rwkv7_ssd_moe'


def split_last(t, sizes):
    return jnp.split(t, np.cumsum(sizes)[:-1].tolist(), axis=-1)


def layer_norm(x, g, b):
    xf = x.astype(jnp.float32)
    mu = xf.mean(-1, keepdims=True)
    var = jnp.square(xf - mu).mean(-1, keepdims=True)
    return ((xf - mu) * lax.rsqrt(var + LN_EPS) * g + b).astype(x.dtype)


def rms_norm(x, w, eps):
    return x * lax.rsqrt(jnp.mean(jnp.square(x), -1, keepdims=True) + eps) * w


def l2_normalize(x, eps=1e-6):
    return x * lax.rsqrt(jnp.sum(jnp.square(x), -1, keepdims=True) + eps)


def centred_dwconv(x, w):
    return lax.conv_general_dilated(
        x, w[:, None, :].astype(x.dtype), window_strides=(1,),
        padding=[(CONV_W // 2, CONV_W // 2)], dimension_numbers=('NWC', 'WIO', 'NWC'),
        feature_group_count=x.shape[-1])


def gdn_chunked(q, k, v, g, beta):
    b, s, h, dk = q.shape
    dv = v.shape[-1]
    c = GDN_CHUNK
    n = s // c

    def to_chunks(t):
        t = jnp.moveaxis(t, 2, 1)
        return t.reshape(b, h, n, c, *t.shape[3:])

    qc, kc, vc = to_chunks(q), to_chunks(k), to_chunks(v)
    gc = jnp.cumsum(to_chunks(g), axis=-1)
    bc = to_chunks(beta)
    incl = jnp.tril(jnp.ones((c, c), bool))
    strict = jnp.tril(jnp.ones((c, c), bool), -1)
    decay = jnp.exp(jnp.where(incl, gc[..., :, None] - gc[..., None, :], -jnp.inf))
    kb = kc * bc[..., None]
    kkt = jnp.einsum('bhnid,bhnjd->bhnij', kb, kc) * decay
    lhs = jnp.where(strict, kkt, 0.0) + jnp.eye(c, dtype=kkt.dtype)
    rhs = jnp.concatenate([vc * bc[..., None], kb * jnp.exp(gc)[..., None]], -1)
    sol = lax.linalg.triangular_solve(lhs, rhs, left_side=True, lower=True, unit_diagonal=True)
    u, w = sol[..., :dv], sol[..., dv:]
    qk = jnp.einsum('bhnid,bhnjd->bhnij', qc, kc) * decay
    q_dec = qc * jnp.exp(gc)[..., None]
    k_dec = kc * jnp.exp(gc[..., -1:] - gc)[..., None]
    g_end = jnp.exp(gc[..., -1])

    def step(state, inp):
        u_i, w_i, qk_i, qd_i, kd_i, ge_i = inp
        v_new = u_i - jnp.einsum('bhcd,bhde->bhce', w_i, state)
        o = jnp.einsum('bhcd,bhde->bhce', qd_i, state) + jnp.einsum('bhij,bhje->bhie', qk_i, v_new)
        state = state * ge_i[..., None, None] + jnp.einsum('bhcd,bhce->bhde', kd_i, v_new)
        return state, o

    xs = tuple(jnp.moveaxis(t, 2, 0) for t in (u, w, qk, q_dec, k_dec, g_end))
    _, o = lax.scan(step, jnp.zeros((b, h, dk, dv), u.dtype), xs)
    return jnp.moveaxis(o, 0, 2).reshape(b, h, s, dv).transpose(0, 2, 1, 3)


def gdn_branch(cols, conv_w, a_log, dt_bias, norm_w):
    bs = cols.shape[:2]
    qkv, z, beta_raw, a_raw = split_last(cols, [GDN_QKV, GDN_WIDTH, 2 * GDN_HEADS, 2 * GDN_HEADS])
    qkv = jax.nn.silu(centred_dwconv(qkv, conv_w))
    q, k, v = split_last(qkv, [GDN_HEADS * GDN_DK, GDN_HEADS * GDN_DK, GDN_WIDTH])
    q = l2_normalize(q.reshape(*bs, GDN_HEADS, GDN_DK)) * GDN_DK ** -0.5
    k = l2_normalize(k.reshape(*bs, GDN_HEADS, GDN_DK))
    v = v.reshape(*bs, GDN_HEADS, GDN_DV)
    beta = jax.nn.sigmoid(beta_raw.reshape(*bs, 2, GDN_HEADS))
    g = -jnp.exp(a_log) * jax.nn.softplus(a_raw.reshape(*bs, 2, GDN_HEADS) + dt_bias)
    fwd = gdn_chunked(q, k, v, g[:, :, 0], beta[:, :, 0])
    bwd = gdn_chunked(*(jnp.flip(t, 1) for t in (q, k, v, g[:, :, 1], beta[:, :, 1])))
    o = fwd + jnp.flip(bwd, 1)
    o = rms_norm(o, norm_w, 1e-6) * jax.nn.silu(z.reshape(*bs, GDN_HEADS, GDN_DV))
    return o.reshape(*bs, GDN_WIDTH)


def token_shift(t, mu_prev, mu_next):
    prev = jnp.pad(t[:, :-1], ((0, 0), (1, 0), (0, 0)))
    nxt = jnp.pad(t[:, 1:], ((0, 0), (0, 1), (0, 0)))
    return t + mu_prev * (prev - t) + mu_next * (nxt - t)


def rwkv7_scan(r, w, k, v, kk, a):
    d, b, s, h, n = r.shape

    def step(state, inp):
        r_t, w_t, k_t, v_t, kk_t, a_t = inp
        sa = jnp.einsum('dbhvk,dbhk->dbhv', state, kk_t)
        state = (state * w_t[..., None, :] - sa[..., :, None] * (kk_t * a_t)[..., None, :]
                 + v_t[..., :, None] * k_t[..., None, :])
        return state, jnp.einsum('dbhvk,dbhk->dbhv', state, r_t)

    xs = tuple(jnp.moveaxis(t, 2, 0) for t in (r, w, k, v, kk, a))
    _, y = lax.scan(step, jnp.zeros((d, b, h, n, n), r.dtype), xs)
    return jnp.moveaxis(y, 0, 2)


def rwkv7_branch(cols, mu_prev, mu_next, w0, w_up, a0, a_up, g_up, k_k, k_a, r_k, ln_g, ln_b):
    bs = cols.shape[:2]
    cols = token_shift(cols, mu_prev, mu_next)
    r, k, v, wl, al, gl = split_last(cols, [RWKV_WIDTH] * 3 + [2 * RWKV_DECAY_RANK, 2 * RWKV_ICL_RANK, RWKV_GATE_RANK])
    w_raw = w0 + jnp.einsum('bsdr,drc->bsdc', jnp.tanh(wl.reshape(*bs, 2, RWKV_DECAY_RANK)), w_up)
    decay = jnp.exp(-jnp.exp(-jax.nn.softplus(-w_raw) - 0.5))
    a = jax.nn.sigmoid(a0 + jnp.einsum('bsdr,drc->bsdc', al.reshape(*bs, 2, RWKV_ICL_RANK), a_up))
    g = jax.nn.sigmoid(gl) @ g_up

    def heads(t):
        return t.reshape(*t.shape[:-1], RWKV_HEADS, RWKV_HD)

    def both(t):
        return jnp.stack([t, jnp.flip(t, 1)])

    def per_dir(t):
        return jnp.stack([t[:, :, 0], jnp.flip(t[:, :, 1], 1)])

    kk = l2_normalize(heads(k * k_k))
    k_dir = k[:, :, None] * (1.0 + (a - 1.0) * k_a)
    r_h, v_h = heads(r), heads(v)
    y = rwkv7_scan(both(r_h), heads(per_dir(decay)), heads(per_dir(k_dir)), both(v_h), both(kk),
                   heads(per_dir(a)))
    y = y[0] + jnp.flip(y[1], 1)
    mu = y.mean(-1, keepdims=True)
    var = jnp.square(y - mu).mean(-1, keepdims=True)
    y = ((y - mu) * lax.rsqrt(var + RWKV_GN_EPS)).reshape(*bs, RWKV_WIDTH) * ln_g + ln_b
    bonus = jnp.sum(r_h[:, :, None] * heads(k_dir) * r_k, -1, keepdims=True).sum(2)
    y = y + (bonus * v_h).reshape(*bs, RWKV_WIDTH)
    return y * g


def ssd_chunked(x, a, bm, cm):
    b, s, g, hg, p = x.shape
    n = bm.shape[-1]
    q = SSD_CHUNK
    nc = s // q
    xc = x.reshape(b, nc, q, g, hg, p)
    bc = bm.reshape(b, nc, q, g, n)
    cc = cm.reshape(b, nc, q, g, n)
    acum = jnp.cumsum(a.reshape(b, nc, q, g, hg), axis=2)
    incl = jnp.tril(jnp.ones((q, q), bool))[:, :, None, None]
    seg = jnp.exp(jnp.where(incl, acum[:, :, :, None] - acum[:, :, None], -jnp.inf))
    scores = jnp.einsum('bclgn,bcsgn->bclsg', cc, bc)[..., None] * seg
    y_diag = jnp.einsum('bclsgh,bcsghp->bclghp', scores, xc)
    x_end = xc * jnp.exp(acum[:, :, -1:] - acum)[..., None]
    chunk_states = jnp.einsum('bcsgn,bcsghp->bcghpn', bc, x_end)
    chunk_decay = jnp.exp(acum[:, :, -1])

    def step(h, inp):
        st, dec = inp
        return h * dec[..., None, None] + st, h

    _, h_in = lax.scan(step, jnp.zeros((b, g, hg, p, n), x.dtype),
                       (jnp.moveaxis(chunk_states, 1, 0), jnp.moveaxis(chunk_decay, 1, 0)))
    y_off = jnp.einsum('bclgn,cbghpn->bclghp', cc, h_in) * jnp.exp(acum)[..., None]
    return (y_diag + y_off).reshape(b, s, g, hg, p)


def ssd_branch(cols, conv_w, conv_b, a_log, dt_bias, d_skip, norm_w):
    bs = cols.shape[:2]
    hg = SSD_HEADS // SSD_GROUPS
    z, xbc, dt_raw = split_last(cols, [SSD_WIDTH, SSD_XBC, 2 * SSD_HEADS])
    xbc = jax.nn.silu(centred_dwconv(xbc, conv_w) + conv_b)
    x, bm, cm = split_last(xbc, [SSD_WIDTH, SSD_GROUPS * SSD_STATE, SSD_GROUPS * SSD_STATE])
    x = x.reshape(*bs, SSD_GROUPS, hg, SSD_HD)
    bm = bm.reshape(*bs, SSD_GROUPS, SSD_STATE)
    cm = cm.reshape(*bs, SSD_GROUPS, SSD_STATE)
    dt = jax.nn.softplus(dt_raw.reshape(*bs, 2, SSD_HEADS) + dt_bias)
    log_a = (dt * -jnp.exp(a_log)).reshape(*bs, 2, SSD_GROUPS, hg)
    dt = dt.reshape(*bs, 2, SSD_GROUPS, hg)
    fwd = ssd_chunked(x * dt[:, :, 0, ..., None], log_a[:, :, 0], bm, cm)
    bwd = ssd_chunked(*(jnp.flip(t, 1) for t in (x * dt[:, :, 1, ..., None], log_a[:, :, 1], bm, cm)))
    y = fwd + jnp.flip(bwd, 1) + x * d_skip.reshape(SSD_GROUPS, hg, 1)
    y = y.reshape(*bs, SSD_WIDTH) * jax.nn.silu(z)
    y = rms_norm(y.reshape(*bs, SSD_GROUPS, SSD_WIDTH // SSD_GROUPS),
                 norm_w.reshape(SSD_GROUPS, SSD_WIDTH // SSD_GROUPS), 1e-5)
    return y.reshape(*bs, SSD_WIDTH)


def moe_ffn(h, w_router, b_router, w_gu, b_gu, w_down, b_down):
    t, d = h.shape
    logits = jnp.dot(h, w_router).astype(jnp.float32) + b_router
    top_val, top_idx = lax.top_k(logits, TOP_K)
    gate = jax.nn.softmax(top_val, axis=-1)
    n_slots = t * TOP_K
    n_blocks = -(-n_slots // MOE_BLOCK) + N_EXPERTS
    flat_e = top_idx.reshape(-1)
    order = jnp.argsort(flat_e)
    sorted_e = flat_e[order]
    counts = jnp.bincount(flat_e, length=N_EXPERTS)
    padded = (counts + MOE_BLOCK - 1) // MOE_BLOCK * MOE_BLOCK
    pad_end = jnp.cumsum(padded)
    grp_start = jnp.cumsum(counts) - counts
    dest = (pad_end - padded)[sorted_e] + jnp.arange(n_slots) - grp_start[sorted_e]
    row_tok = jnp.full((n_blocks * MOE_BLOCK,), t, jnp.int32).at[dest].set((order // TOP_K).astype(jnp.int32))
    row_gate = jnp.zeros((n_blocks * MOE_BLOCK,), jnp.float32).at[dest].set(gate.reshape(-1)[order])
    block_e = jnp.minimum(jnp.searchsorted(pad_end, jnp.arange(n_blocks) * MOE_BLOCK, side='right'),
                          N_EXPERTS - 1)
    x_rows = h[jnp.minimum(row_tok, t - 1)].reshape(n_blocks, MOE_BLOCK, d)

    def expert_block(args):
        xb, e = args
        gu = xb @ w_gu[e] + b_gu[e]
        glu, up = gu[:, :D_EXPERT], gu[:, D_EXPERT:]
        glu = jnp.minimum(glu, SWIGLU_LIMIT)
        up = jnp.clip(up, -SWIGLU_LIMIT, SWIGLU_LIMIT)
        return ((up + 1.0) * glu * jax.nn.sigmoid(SWIGLU_ALPHA * glu)) @ w_down[e] + b_down[e]

    y_rows = lax.map(expert_block, (x_rows, block_e)).reshape(-1, d)
    out = jnp.zeros((t, d), jnp.float32).at[row_tok].add(y_rows * row_gate[:, None], mode='drop')
    return out.astype(h.dtype)


def setup_inputs(seed: int = 0) -> dict:
    key = jax.random.key(seed)
    keys = iter(jax.random.split(key, 64))

    def normal(shape, scale):
        return jax.random.normal(next(keys), shape, jnp.float32) * scale

    def uniform(shape, lo, hi):
        return jax.random.uniform(next(keys), shape, jnp.float32, lo, hi)

    def gain(shape):
        return 1.0 + normal(shape, 0.02)

    def dt_bias(shape):
        dt = jnp.exp(uniform(shape, math.log(1e-3), math.log(1e-1)))
        return dt + jnp.log(-jnp.expm1(-dt))

    L, D, beta = DEPTH, D_MODEL, DEEPNORM_BETA
    return {
        'x': normal((BATCH, SEQ, D), 1.0),
        'p': normal((L, BATCH, SEQ, PLE_DIM), 1.0),
        'ln_in_g': gain((D,)),
        'ln_in_b': normal((D,), 0.02),
        'w_in': normal((L, D, IN_COLS), D ** -0.5),
        'gdn_conv': normal((L, CONV_W, GDN_QKV), CONV_W ** -0.5),
        'gdn_a_log': jnp.log(uniform((L, 2, GDN_HEADS), 1.0, 16.0)),
        'gdn_dt_bias': dt_bias((L, 2, GDN_HEADS)),
        'gdn_norm': gain((L, GDN_DV)),
        'rwkv_mu_prev': uniform((L, RWKV_COLS), 0.0, 0.5),
        'rwkv_mu_next': uniform((L, RWKV_COLS), 0.0, 0.5),
        'rwkv_w0': uniform((L, 2, RWKV_WIDTH), -6.5, -1.5),
        'rwkv_w_up': normal((L, 2, RWKV_DECAY_RANK, RWKV_WIDTH), 0.3 * RWKV_DECAY_RANK ** -0.5),
        'rwkv_a0': normal((L, 2, RWKV_WIDTH), 0.1),
        'rwkv_a_up': normal((L, 2, RWKV_ICL_RANK, RWKV_WIDTH), 0.3 * RWKV_ICL_RANK ** -0.5),
        'rwkv_g_up': normal((L, RWKV_GATE_RANK, RWKV_WIDTH), RWKV_GATE_RANK ** -0.5),
        'rwkv_k_k': 0.85 + normal((L, RWKV_WIDTH), 0.02),
        'rwkv_k_a': gain((L, RWKV_WIDTH)),
        'rwkv_r_k': normal((L, RWKV_HEADS, RWKV_HD), 0.1),
        'rwkv_ln_g': gain((L, RWKV_WIDTH)),
        'rwkv_ln_b': normal((L, RWKV_WIDTH), 0.02),
        'ssd_conv': normal((L, CONV_W, SSD_XBC), CONV_W ** -0.5),
        'ssd_conv_b': normal((L, SSD_XBC), 0.02),
        'ssd_a_log': jnp.log(uniform((L, 2, SSD_HEADS), 1.0, 16.0)),
        'ssd_dt_bias': dt_bias((L, 2, SSD_HEADS)),
        'ssd_d': gain((L, SSD_HEADS)),
        'ssd_norm': gain((L, SSD_WIDTH)),
        'w_branch': jnp.concatenate([normal((L, GDN_WIDTH, D), beta * GDN_WIDTH ** -0.5),
                                     normal((L, RWKV_WIDTH, D), beta * RWKV_WIDTH ** -0.5),
                                     normal((L, SSD_WIDTH, D), beta * SSD_WIDTH ** -0.5)], axis=1),
        'w_o': normal((L, D, D), beta * D ** -0.5),
        'ln1_g': gain((L, D)),
        'ln1_b': normal((L, D), 0.02),
        'w_router': normal((L, D, N_EXPERTS), D ** -0.5),
        'b_router': normal((L, N_EXPERTS), 0.01),
        'w_gu': normal((L, N_EXPERTS, D, 2 * D_EXPERT), D ** -0.5),
        'b_gu': normal((L, N_EXPERTS, 2 * D_EXPERT), 0.01),
        'w_down': normal((L, N_EXPERTS, D_EXPERT, D), beta * D_EXPERT ** -0.5),
        'b_down': normal((L, N_EXPERTS, D), 0.01),
        'w_pl': normal((L, PLE_DIM, D), beta * PLE_DIM ** -0.5),
        'w_pl_gate': normal((L, D, D), D ** -0.5),
        'ln2_g': gain((L, D)),
        'ln2_b': normal((L, D), 0.02),
    }


def reference(x, p, ln_in_g, ln_in_b, w_in, gdn_conv, gdn_a_log, gdn_dt_bias, gdn_norm,
              rwkv_mu_prev, rwkv_mu_next, rwkv_w0, rwkv_w_up, rwkv_a0, rwkv_a_up, rwkv_g_up,
              rwkv_k_k, rwkv_k_a, rwkv_r_k, rwkv_ln_g, rwkv_ln_b, ssd_conv, ssd_conv_b, ssd_a_log,
              ssd_dt_bias, ssd_d, ssd_norm, w_branch, w_o, ln1_g, ln1_b, w_router, b_router,
              w_gu, b_gu, w_down, b_down, w_pl, w_pl_gate, ln2_g, ln2_b):
    b, s, d = x.shape
    f32 = jnp.float32
    x = layer_norm(x, ln_in_g, ln_in_b)
    for i in range(DEPTH):
        cols = x @ w_in[i]
        c_gdn, c_rwkv, c_ssd, c_gate = split_last(cols, [GDN_COLS, RWKV_COLS, SSD_COLS, GATE_COLS])
        y_a = gdn_branch(c_gdn.astype(f32), gdn_conv[i], gdn_a_log[i], gdn_dt_bias[i], gdn_norm[i])
        y_b = rwkv7_branch(c_rwkv.astype(f32), rwkv_mu_prev[i], rwkv_mu_next[i], rwkv_w0[i],
                           rwkv_w_up[i], rwkv_a0[i], rwkv_a_up[i], rwkv_g_up[i], rwkv_k_k[i],
                           rwkv_k_a[i], rwkv_r_k[i], rwkv_ln_g[i], rwkv_ln_b[i])
        y_c = ssd_branch(c_ssd.astype(f32), ssd_conv[i], ssd_conv_b[i], ssd_a_log[i],
                         ssd_dt_bias[i], ssd_d[i], ssd_norm[i])
        wb = w_branch[i]
        gates = jax.nn.sigmoid(c_gate.reshape(b, s, N_BRANCH, d))
        merged = (gates[:, :, 0] * (y_a.astype(x.dtype) @ wb[:GDN_WIDTH])
                  + gates[:, :, 1] * (y_b.astype(x.dtype) @ wb[GDN_WIDTH:GDN_WIDTH + RWKV_WIDTH])
                  + gates[:, :, 2] * (y_c.astype(x.dtype) @ wb[GDN_WIDTH + RWKV_WIDTH:]))
        x = layer_norm(DEEPNORM_ALPHA * x + merged @ w_o[i], ln1_g[i], ln1_b[i])
        ffn = moe_ffn(x.reshape(b * s, d), w_router[i], b_router[i], w_gu[i], b_gu[i],
                      w_down[i], b_down[i]).reshape(b, s, d)
        ple = (p[i] @ w_pl[i]) * jax.nn.sigmoid(x @ w_pl_gate[i])
        x = layer_norm(DEEPNORM_ALPHA * x + ffn + ple, ln2_g[i], ln2_b[i])
    return x
```

```cpp
#include <hip/hip_runtime.h>
#include <cstdio>
#include <cstdint>

#define GAS __attribute__((address_space(1)))
#define LAS __attribute__((address_space(3)))
typedef unsigned short bf16;
typedef unsigned u32x4 __attribute__((ext_vector_type(4)));
typedef unsigned u32x2 __attribute__((ext_vector_type(2)));
typedef float f32x4 __attribute__((ext_vector_type(4)));
typedef float f32x2 __attribute__((ext_vector_type(2)));
typedef short bf16x8 __attribute__((ext_vector_type(8)));
typedef GAS unsigned gu32;
#define RLX_AGENT __ATOMIC_RELAXED, __HIP_MEMORY_SCOPE_AGENT

constexpr int DM = 1024, SEQ = 8192, NB = 2, MTOK = NB * SEQ, DEPTH = 2, PLE = 256, NEXP = 32, TOPK = 4, DEXP = 1024;
constexpr int NCB = 9472;
constexpr int NPN_IN = 38;
constexpr int MPAD = 73728;
constexpr float LN_EPS = 1e-5f;
constexpr float DN_ALPHA = 1.4142135623730951f;
constexpr int C_GQKV = 0, C_GZ = 1536, C_RRKV = 2048, C_RAL = 3584, C_RGL = 3712, C_SZ = 3840, C_SXBC = 4864, C_GATE = 6400;

constexpr size_t MiB = 1u << 20;
constexpr size_t WS_CTL = 0, CTL_ZERO_BYTES = 1 * MiB;
constexpr size_t W_IN_SZ = (size_t)9728 * 1024 * 2, W_BR_SZ = (size_t)1024 * 2048 * 2, W_SQ_SZ = (size_t)1024 * 1024 * 2, W_GU_SZ = (size_t)2048 * 1024 * 2,
                 W_PL_SZ = (size_t)1024 * 1024 * 2, W_LORA_SZ = (size_t)2560 * 384 * 2;
constexpr size_t WS_W_IN = 1 * MiB;
constexpr size_t WS_W_BR = WS_W_IN + 2 * W_IN_SZ;
constexpr size_t WS_W_O = WS_W_BR + 2 * W_BR_SZ;
constexpr size_t WS_W_PLG = WS_W_O + 2 * W_SQ_SZ;
constexpr size_t WS_W_PL = WS_W_PLG + 2 * W_SQ_SZ;
constexpr size_t WS_W_LORA = WS_W_PL + 2 * W_PL_SZ;
constexpr size_t WS_W_GU = ((WS_W_LORA + 2 * W_LORA_SZ + MiB - 1) / MiB) * MiB;
constexpr size_t WS_W_DN = WS_W_GU + 64 * W_GU_SZ;
constexpr size_t WS_ACT0 = WS_W_DN + 64 * W_SQ_SZ;
constexpr size_t A_XF = WS_ACT0;
constexpr size_t A_XB = A_XF + 64 * MiB;
constexpr size_t A_COLS = A_XB + 32 * MiB;
constexpr size_t A_ACT = A_COLS;
constexpr size_t A_YE = A_COLS + 144 * MiB;
constexpr size_t A_SIDE = A_COLS + 296 * MiB;
constexpr size_t A_PB = A_SIDE + 16 * MiB;
constexpr size_t A_GQKV = A_PB + 64 * MiB;
constexpr size_t A_GSC = A_GQKV + 48 * MiB;
constexpr size_t A_SXBC = A_GSC + 1 * MiB;
constexpr size_t A_SSC = A_SXBC + 48 * MiB;
constexpr size_t A_RKV = A_SSC + 4 * MiB;
constexpr size_t A_RKK = A_RKV + 48 * MiB;
constexpr size_t A_LIN = A_RKK + 16 * MiB;
constexpr size_t A_RLOGW = A_LIN + 12 * MiB;
constexpr size_t A_RKDIR = A_RLOGW + 64 * MiB;
constexpr size_t A_RKKA = A_RKDIR + 32 * MiB;
constexpr size_t A_RG = A_RKKA + 32 * MiB;
constexpr size_t A_OG = A_RG + 16 * MiB;
constexpr size_t A_OR = A_OG + 64 * MiB;
constexpr size_t A_OS = A_OR + 64 * MiB;
constexpr size_t A_HS = A_OS;
constexpr size_t A_SDEC = A_OS + 64 * MiB;
constexpr size_t A_YMIX = A_OS + 128 * MiB;
constexpr size_t A_MPART = A_YMIX + 64 * MiB;
constexpr size_t A_MERGED = A_MPART + 64 * MiB;
constexpr size_t A_PRE = A_OG;
constexpr size_t A_X1F = A_OR;
constexpr size_t A_X1B = A_OS;
constexpr size_t A_SG = A_OS + 32 * MiB;
constexpr size_t A_PLEB = A_OS + 64 * MiB;
constexpr size_t A_TOPE = A_RKK;
constexpr size_t A_TOPG = A_TOPE + 256 * 1024;
constexpr size_t A_TOPR = A_TOPG + 256 * 1024;
constexpr size_t A_ROWTOK = A_TOPR + 256 * 1024;
constexpr size_t A_WRT = A_MERGED + 32 * MiB;
constexpr size_t A_GPSI = A_WRT + 1 * MiB;
constexpr size_t A_GLAM = A_GPSI + 64 * MiB;
constexpr size_t A_GQT = A_GLAM + 64 * MiB;
constexpr size_t A_GO0 = A_GQT + 32 * MiB;
constexpr size_t A_GH = A_GO0 + 32 * MiB;
constexpr size_t A_GD = A_GH + 64 * MiB;
constexpr size_t A_RPSI = A_OG;
constexpr size_t A_RLAM = A_OG + 32 * MiB;
constexpr size_t A_RRT = A_OR;
constexpr size_t A_RY0 = A_OR + 32 * MiB;
constexpr size_t A_RH = A_MPART;
constexpr size_t A_RPC = A_MPART + 32 * MiB;
constexpr size_t WS_END = A_GD + 1 * MiB;
static_assert(WS_END <= (size_t)2040 * MiB, "d_ws map");
constexpr int CW_BAR = 4096;
constexpr int CW_GCNT = 16384;

constexpr int LDS_BYTES = 163840;
constexpr int L_STAGE = 0;
constexpr int L_EXTRA = 131072;
constexpr int L_MISC = LDS_BYTES - 256;
constexpr int NWAVES = 8, NTHR = 512;

#define LDS_WAIT() asm volatile("s_waitcnt lgkmcnt(0)" ::: "memory")
#define VM_WAIT() asm volatile("s_waitcnt vmcnt(0)" ::: "memory")
__device__ __forceinline__ unsigned f2bf(float f) { unsigned u = __builtin_bit_cast(unsigned, f); return (u + 0x7fffu + ((u >> 16) & 1u)) >> 16; }
typedef __bf16 bf16x2_t __attribute__((ext_vector_type(2)));
__device__ __forceinline__ unsigned pk2(float lo, float hi) { const f32x2 v = {lo, hi}; return __builtin_bit_cast(unsigned, __builtin_convertvector(v, bf16x2_t)); }
__device__ __forceinline__ float bf2f(unsigned h) { return __builtin_bit_cast(float, h << 16); }
__device__ __forceinline__ float bflo(unsigned w) { return __builtin_bit_cast(float, w << 16); }
__device__ __forceinline__ float bfhi(unsigned w) { return __builtin_bit_cast(float, w & 0xffff0000u); }
__device__ __forceinline__ float sigmoidf_(float x) { return __builtin_amdgcn_rcpf(1.0f + __expf(-x)); }
__device__ __forceinline__ float siluf_(float x) { return x * __builtin_amdgcn_rcpf(1.0f + __expf(-x)); }
__device__ __forceinline__ float softplusf_(float x) { return x > 20.f ? x : log1pf(__expf(x)); }
__device__ __forceinline__ float wave_sum(float v) {
#pragma unroll
    for (int o = 1; o < 64; o <<= 1) v += __shfl_xor(v, o);
    return v;
}
__device__ __forceinline__ void unpack8(u32x4 w, float (&f)[8]) {
    f[0] = bflo(w.x); f[1] = bfhi(w.x); f[2] = bflo(w.y); f[3] = bfhi(w.y); f[4] = bflo(w.z); f[5] = bfhi(w.z); f[6] = bflo(w.w); f[7] = bfhi(w.w);
}
__device__ __forceinline__ u32x4 pack8(const float (&f)[8]) { u32x4 w; w.x = pk2(f[0], f[1]); w.y = pk2(f[2], f[3]); w.z = pk2(f[4], f[5]); w.w = pk2(f[6], f[7]); return w; }

#define XB_TMO      128
#define XB_XCNT(j)  (256  + 64 * (j))
#define XB_XSUB(j)  (1280 + 64 * (j))
#define XB_XGEN(j)  (2304 + 64 * (j))
#define XB_TOP      3328
#define XB_TOPGEN   3392
#define XCD_BAR_WORDS 3456
#define XB_SPIN_CAP (1u << 22)
__device__ __forceinline__ unsigned xb_ld(unsigned* p)              { return __hip_atomic_load(p, __ATOMIC_RELAXED, __HIP_MEMORY_SCOPE_AGENT); }
__device__ __forceinline__ unsigned xb_add(unsigned* p, unsigned v) { return __hip_atomic_fetch_add(p, v, __ATOMIC_RELAXED, __HIP_MEMORY_SCOPE_AGENT); }
__device__ __forceinline__ unsigned xb_xcc_id() { return (unsigned)__builtin_amdgcn_s_getreg((3 << 11) | 20) & 0xFu; }
#define XB_SPIN(cond, bar) do { unsigned _sp = 0; while (cond) { __builtin_amdgcn_s_sleep(1); \
    if ((++_sp & 255u) == 0u) { if (xb_ld(&(bar)[XB_TMO])) break; if (_sp > XB_SPIN_CAP) { atomicAdd(&(bar)[XB_TMO], 1u); break; } } } } while (0)
struct XcdBarrier { unsigned* bar; unsigned x; volatile LAS unsigned* st; };
__device__ __forceinline__ XcdBarrier xcd_barrier_post(unsigned* bar, volatile LAS unsigned* st) {
    XcdBarrier b; b.bar = bar; b.x = xb_xcc_id(); b.st = st;
    if (threadIdx.x == 0) (void)xb_add(&bar[XB_XCNT(b.x)], 1u);
    return b;
}
__device__ __forceinline__ void xcd_barrier_complete(unsigned* bar, unsigned x, unsigned& nloc, unsigned& nx) {
    const unsigned G = gridDim.x * gridDim.y * gridDim.z;
    unsigned sum, cnt, mine, sp = 0u;
    for (;;) {
        sum = 0u; cnt = 0u; mine = 0u;
#pragma unroll
        for (unsigned j = 0; j < 16; ++j) { const unsigned c = xb_ld(&bar[XB_XCNT(j)]); sum += c; cnt += (c > 0u) ? 1u : 0u; mine = (j == x) ? c : mine; }
        if (sum == G) break;
        __builtin_amdgcn_s_sleep(1);
        if ((++sp & 255u) == 0u) { if (xb_ld(&bar[XB_TMO])) break; if (sp > XB_SPIN_CAP) { atomicAdd(&bar[XB_TMO], 1u); break; } }
    }
    nloc = mine > 0u ? mine : 1u; nx = cnt > 0u ? cnt : 1u;
}
__device__ __forceinline__ void xcd_barrier(const XcdBarrier& b) {
    asm volatile("s_waitcnt vmcnt(0)" ::: "memory");
    __syncthreads();
    if (threadIdx.x == 0) {
        unsigned* bar = b.bar;
        __builtin_amdgcn_s_waitcnt(0);
        unsigned nloc = b.st[0], nx = b.st[1];
        if (nloc == 0u) { xcd_barrier_complete(bar, b.x, nloc, nx); b.st[0] = nloc; b.st[1] = nx; }
        const unsigned old = xb_add(&bar[XB_XSUB(b.x)], 1u);
        const unsigned gen = old / nloc;
        if (old + 1u == (gen + 1u) * nloc) {
            __builtin_amdgcn_fence(__ATOMIC_RELEASE, "agent");
            asm volatile("s_waitcnt vmcnt(0)" ::: "memory");
            const unsigned og = xb_add(&bar[XB_TOP], 1u);
            const unsigned tg = og / nx;
            if (og + 1u == (tg + 1u) * nx) xb_add(&bar[XB_TOPGEN], 1u);
            else XB_SPIN(xb_ld(&bar[XB_TOPGEN]) == tg, bar);
            __builtin_amdgcn_fence(__ATOMIC_ACQUIRE, "agent");
            xb_add(&bar[XB_XGEN(b.x)], 1u);
            asm volatile("s_waitcnt vmcnt(0)" ::: "memory");
        } else {
            XB_SPIN(xb_ld(&bar[XB_XGEN(b.x)]) == gen, bar);
            __builtin_amdgcn_fence(__ATOMIC_ACQUIRE, "agent");
            asm volatile("s_waitcnt vmcnt(0)" ::: "memory");
        }
    }
    __syncthreads();
}

struct Params {
    const float* in[41];
    float* out;
    unsigned char* ws;
};
enum { I_X = 0, I_P, I_LNIN_G, I_LNIN_B, I_W_IN, I_GDN_CONV, I_GDN_ALOG, I_GDN_DTB, I_GDN_NORM, I_R_MUP, I_R_MUN, I_R_W0, I_R_WUP, I_R_A0, I_R_AUP, I_R_GUP,
       I_R_KK, I_R_KA, I_R_RK, I_R_LNG, I_R_LNB, I_S_CONV, I_S_CONVB, I_S_ALOG, I_S_DTB, I_S_D, I_S_NORM, I_W_BR, I_W_O, I_LN1G, I_LN1B, I_W_RT, I_B_RT,
       I_W_GU, I_B_GU, I_W_DN, I_B_DN, I_W_PL, I_W_PLG, I_LN2G, I_LN2B };

struct Frame {
    LAS unsigned char* lds;
    volatile LAS unsigned* MISC;
    gu32* ctl;
    unsigned char* ws;
    int tid, lane, wave, vcu, G;
};
#define WSP(T, off) ((T*)(F.ws + (off)))

namespace pg8 {
constexpr int BM = 256, BK = 64, HALF = 128, HTB = HALF * BK * 2, STAGE_BYTES = 8 * HTB, NXCD = 8, WGM = 8;
__host__ __device__ __forceinline__ int lds_byte(int r, int c) { const int st = (r >> 4) * 2 + (c >> 5), rr = r & 15, cc = c & 31, ob = rr * 64 + cc * 2; return st * 1024 + (ob ^ (((ob >> 9) & 1) << 5)); }
__host__ __device__ __forceinline__ void stage_rc(int b, int& R, int& C) { const int st = b / 1024, sb = b % 1024, swz = sb ^ (((sb >> 9) & 1) << 5); R = (st >> 1) * 16 + swz / 64; C = (st & 1) * 32 + (swz % 64) / 2; }
__host__ __device__ __forceinline__ int perm32(int rho) { const int n = rho >> 4, i = rho & 15; return 8 * (i >> 2) + 4 * n + (i & 3); }

struct GUnit {
    const char* A; const char* B;
    int nt;
    int arow0;
    int kind, pm, pn, aux;
};
__device__ __forceinline__ void tile_order(int L, int nM, int nN, int& pm, int& pn) {
    const int nwg = nM * nN; int wgid = L;
    { const int q = nwg / NXCD, r = nwg % NXCD, xcd = wgid % NXCD, off = wgid / NXCD; wgid = (xcd < r ? xcd * (q + 1) : r * (q + 1) + (xcd - r) * q) + off; }
    const int nig = WGM * nN, gid = wgid / nig, fm = gid * WGM, gsz = (nM - fm) < WGM ? (nM - fm) : WGM;
    pm = fm + ((wgid % nig) % gsz); pn = (wgid % nig) / gsz;
}

template <bool GATHER, class Sched, class Epi>
__device__ __forceinline__ void gemm_phase(LAS unsigned char* lds, const Sched& S, const Epi& E, const int lda, const int ldb, const int* gather) {
    int tid = threadIdx.x; asm volatile("" : "+v"(tid));
    const int wid = __builtin_amdgcn_readfirstlane(tid >> 6), lane = tid & 63, wr = wid >> 2, wc = wid & 3, fr = lane & 15, fq = lane >> 4;
    unsigned voffA[2], voffB[2], gA1[2]; int gR[2], gC[2];
#pragma unroll
    for (int i = 0; i < 2; ++i) { int R, C; stage_rc(tid * 16 + i * 8192, R, C); const int Rb = (R & ~31) + perm32(R & 31);
        voffA[i] = (unsigned)(R * lda + C * 2); voffB[i] = (unsigned)(Rb * ldb + C * 2); gR[i] = R; gC[i] = C * 2; gA1[i] = 0u; }
    const size_t kstep = (size_t)(BK * 2);
    const size_t hstepA = GATHER ? 0 : (size_t)HALF * lda, hstepB = (size_t)HALF * ldb;
    const unsigned ldsw = (unsigned)wid * 1024u;
    const int aoff = lds_byte(wr * 64 + fr, fq * 8), boff = lds_byte(wc * 32 + fr, fq * 8);
#define PG8_SA(b, h) (((b) * 2 + (h)) * HTB)
#define PG8_SB(b, h) ((4 + (b) * 2 + (h)) * HTB)
#define PG8_STAGE(bufoff, gbase, voff) do { _Pragma("unroll") for (int _i = 0; _i < 2; ++_i) \
        __builtin_amdgcn_global_load_lds((const unsigned*)((const char*)(gbase) + (voff)[_i]), (LAS unsigned*)(lds + (bufoff) + ldsw + _i * 8192), 16, 0, 0); } while (0)
#define PG8_LDA(dst, b, h) do { _Pragma("unroll") for (int m = 0; m < 4; ++m) _Pragma("unroll") for (int k = 0; k < 2; ++k) dst[m][k] = *(const LAS bf16x8*)(lds + PG8_SA(b, h) + aoff + m * 2048 + k * 1024); } while (0)
#define PG8_LDB(dst, b, h) do { _Pragma("unroll") for (int n = 0; n < 2; ++n) _Pragma("unroll") for (int k = 0; k < 2; ++k) dst[n][k] = *(const LAS bf16x8*)(lds + PG8_SB(b, h) + boff + n * 2048 + k * 1024); } while (0)
#define PG8_MMA(ai, bj, At, Bt) do { __builtin_amdgcn_s_setprio(1); _Pragma("unroll") for (int m = 0; m < 4; ++m) _Pragma("unroll") for (int n = 0; n < 2; ++n) _Pragma("unroll") for (int k = 0; k < 2; ++k) \
        acc[ai][bj][m][n] = __builtin_amdgcn_mfma_f32_16x16x32_bf16(Bt[n][k], At[m][k], acc[ai][bj][m][n], 0, 0, 0); __builtin_amdgcn_s_setprio(0); } while (0)
#define PG8_WAIT_V(n) asm volatile("s_waitcnt vmcnt(" #n ")" ::: "memory")
#define PG8_WAIT_L(n) asm volatile("s_waitcnt lgkmcnt(" #n ")" ::: "memory")
#define PG8_BAR __builtin_amdgcn_s_barrier()
#define PG8_SCHED __builtin_amdgcn_sched_barrier(0)
#define PG8_GOFFS(slot, o0, o1) do { _Pragma("unroll") for (int _i = 0; _i < 2; ++_i) { \
        unsigned r0 = (unsigned)gidx[(slot) * 256 + gR[_i]], r1 = (unsigned)gidx[(slot) * 256 + HALF + gR[_i]]; \
        r0 = r0 < (unsigned)MTOK ? r0 : (unsigned)(MTOK - 1); r1 = r1 < (unsigned)MTOK ? r1 : (unsigned)(MTOK - 1); \
        o0[_i] = r0 * (unsigned)lda + (unsigned)gC[_i]; o1[_i] = r1 * (unsigned)lda + (unsigned)gC[_i]; } } while (0)
    GUnit cur, nxt; int ui = 0;
    LAS int* gidx = (LAS int*)(lds + STAGE_BYTES);
    if constexpr (GATHER) {
#pragma unroll 1
        for (int i = 0; i < 16; ++i) { GUnit t; if (!S.next(i, t)) break; if (tid < 256) gidx[i * 256 + tid] = gather[t.arow0 + tid]; }
        __syncthreads(); }
    if (!S.next(0, cur)) return;
    f32x4 acc[2][2][4][2];
#pragma unroll
    for (int a = 0; a < 2; ++a)
#pragma unroll
        for (int b = 0; b < 2; ++b)
#pragma unroll
            for (int m = 0; m < 4; ++m)
#pragma unroll
                for (int n = 0; n < 2; ++n) acc[a][b][m][n] = (f32x4){0.f, 0.f, 0.f, 0.f};
    bf16x8 At[4][2], B0[2][2], B1[2][2];
    if constexpr (GATHER) { PG8_GOFFS(0, voffA, gA1); }
    const char* cA = cur.A; const char* cB = cur.B;
#define PG8_A1(off) (GATHER ? gA1 : voffA)
    PG8_STAGE(PG8_SB(0, 0), cB, voffB); PG8_STAGE(PG8_SB(0, 1), cB + hstepB, voffB); PG8_STAGE(PG8_SA(0, 0), cA, voffA);
    if constexpr (GATHER) { PG8_STAGE(PG8_SA(0, 1), cA, gA1); } else { PG8_STAGE(PG8_SA(0, 1), cA + hstepA, voffA); }
    if (wr == 1) PG8_BAR;
    PG8_WAIT_V(2); PG8_BAR;
    PG8_STAGE(PG8_SB(1, 0), cB + kstep, voffB); PG8_STAGE(PG8_SA(1, 0), cA + kstep, voffA); PG8_STAGE(PG8_SB(1, 1), cB + hstepB + kstep, voffB);
    PG8_WAIT_V(6); PG8_BAR;
    for (;;) {
        const bool has_next = S.next(ui + 1, nxt);
        const int nt = cur.nt;
        const char* nA = has_next ? nxt.A : cA; const char* nB = has_next ? nxt.B : cB;
        for (int t = 0; t < nt; t += 2) {
            const bool last = (t == nt - 2);
            const char* a1 = cA + (size_t)(t + 1) * kstep;
            const char* a2 = last ? nA : cA + (size_t)(t + 2) * kstep; const char* b2 = last ? nB : cB + (size_t)(t + 2) * kstep;
            const char* a3 = a2 + kstep; const char* b3 = b2 + kstep;
            unsigned pA0[2], pA1[2];
            if constexpr (GATHER) {
                if (last && has_next) { PG8_GOFFS(ui + 1, pA0, pA1); }
                else {
#pragma unroll
                    for (int i = 0; i < 2; ++i) { pA0[i] = voffA[i]; pA1[i] = gA1[i]; } }
            }
            PG8_LDB(B0, 0, 0); PG8_LDB(B1, 0, 1); PG8_SCHED; PG8_LDA(At, 0, 0);
            if constexpr (GATHER) { PG8_STAGE(PG8_SA(1, 1), a1, gA1); } else { PG8_STAGE(PG8_SA(1, 1), a1 + hstepA, voffA); }
            PG8_WAIT_V(8); PG8_WAIT_L(0); PG8_BAR; PG8_MMA(0, 0, At, B0); PG8_MMA(0, 1, At, B1); PG8_BAR; PG8_SCHED;
            PG8_LDA(At, 0, 1); PG8_STAGE(PG8_SB(0, 0), b2, voffB); PG8_STAGE(PG8_SB(0, 1), b2 + hstepB, voffB);
            if constexpr (GATHER) { PG8_STAGE(PG8_SA(0, 0), a2, pA0); } else { PG8_STAGE(PG8_SA(0, 0), a2, voffA); }
            PG8_WAIT_V(8); PG8_WAIT_L(0); PG8_BAR; PG8_MMA(1, 0, At, B0); PG8_MMA(1, 1, At, B1); PG8_BAR; PG8_SCHED;
            PG8_LDB(B0, 1, 0); PG8_LDB(B1, 1, 1); PG8_SCHED; PG8_LDA(At, 1, 0);
            if constexpr (GATHER) { PG8_STAGE(PG8_SA(0, 1), a2, pA1); } else { PG8_STAGE(PG8_SA(0, 1), a2 + hstepA, voffA); }
            PG8_WAIT_V(8); PG8_WAIT_L(0); PG8_BAR; PG8_MMA(0, 0, At, B0); PG8_MMA(0, 1, At, B1); PG8_BAR; PG8_SCHED;
            PG8_LDA(At, 1, 1); PG8_STAGE(PG8_SB(1, 0), b3, voffB); PG8_STAGE(PG8_SB(1, 1), b3 + hstepB, voffB);
            if constexpr (GATHER) { PG8_STAGE(PG8_SA(1, 0), a3, pA0); } else { PG8_STAGE(PG8_SA(1, 0), a3, voffA); }
            PG8_WAIT_V(8); PG8_WAIT_L(0); PG8_BAR; PG8_MMA(1, 0, At, B0); PG8_MMA(1, 1, At, B1); PG8_BAR; PG8_SCHED;
            if constexpr (GATHER) { if (last) {
#pragma unroll
                for (int i = 0; i < 2; ++i) { voffA[i] = pA0[i]; gA1[i] = pA1[i]; } } }
        }
        if (wr == 0) PG8_BAR;
        bool keep = false;
        if constexpr (Epi::CHAIN) { keep = E.chain(acc, cur, wr, wc, fr, fq); }
        if (!keep) E(acc, cur, wr, wc, fr, fq);
        if (!has_next) break;
        if (!keep) {
#pragma unroll
        for (int a = 0; a < 2; ++a)
#pragma unroll
            for (int b = 0; b < 2; ++b)
#pragma unroll
                for (int m = 0; m < 4; ++m)
#pragma unroll
                    for (int n = 0; n < 2; ++n) acc[a][b][m][n] = (f32x4){0.f, 0.f, 0.f, 0.f}; }
        cur = nxt; cA = nA; cB = nB; ++ui;
        if (wr == 1) PG8_BAR;
    }
    PG8_WAIT_V(0);
    PG8_BAR;
#undef PG8_SA
#undef PG8_SB
#undef PG8_STAGE
#undef PG8_LDA
#undef PG8_LDB
#undef PG8_MMA
#undef PG8_WAIT_V
#undef PG8_WAIT_L
#undef PG8_BAR
#undef PG8_SCHED
#undef PG8_GOFFS
#undef PG8_A1
}
}

using pg8::GUnit;
#define EPI_LOOP for (int ai = 0; ai < 2; ++ai) _Pragma("unroll") for (int m = 0; m < 4; ++m) _Pragma("unroll") for (int bj = 0; bj < 2; ++bj)
#define EPI_ARGS const f32x4 (&acc)[2][2][4][2], const GUnit& u, int wr, int wc, int fr, int fq

struct EpiInproj {
    static constexpr bool CHAIN = false;
    bf16* cols; float* side;
    __device__ __forceinline__ void operator()(EPI_ARGS) const {
        const int row0 = u.pm * 256 + wr * 64 + fr, cw = wc * 32 + 8 * fq;
        if (u.pn < 37) {
            const bool sg = u.pn >= 25;
#pragma unroll
            EPI_LOOP { f32x4 v0 = acc[ai][bj][m][0], v1 = acc[ai][bj][m][1];
                if (sg) {
#pragma unroll
                    for (int j = 0; j < 4; ++j) { v0[j] = sigmoidf_(v0[j]); v1[j] = sigmoidf_(v1[j]); } }
                u32x4 w; w.x = pk2(v0[0], v0[1]); w.y = pk2(v0[2], v0[3]); w.z = pk2(v1[0], v1[1]); w.w = pk2(v1[2], v1[3]);
                *(u32x4*)(cols + (size_t)(row0 + ai * 128 + m * 16) * NCB + u.pn * 256 + bj * 128 + cw) = w; }
        } else {
#pragma unroll
            EPI_LOOP { float* p = side + (size_t)(row0 + ai * 128 + m * 16) * 256 + bj * 128 + cw;
                *(f32x4*)p = acc[ai][bj][m][0]; *(f32x4*)(p + 4) = acc[ai][bj][m][1]; }
        }
    }
};
struct EpiLora {
    static constexpr bool CHAIN = false;
    float* rlogw; bf16* rkdir; bf16* rkka; bf16* rg; const bf16* rkv; const bf16* rkk; const float* w0; const float* a0; const float* k_a;
    __device__ __forceinline__ void operator()(EPI_ARGS) const {
        const int row0 = u.pm * 256 + wr * 64 + fr, cw = wc * 32 + 8 * fq;
        if (u.pn < 4) {
            f32x4 wb[2][2];
#pragma unroll
            for (int bj = 0; bj < 2; ++bj) { wb[bj][0] = *(const f32x4*)(w0 + u.pn * 256 + bj * 128 + cw); wb[bj][1] = *(const f32x4*)(w0 + u.pn * 256 + bj * 128 + cw + 4); }
#pragma unroll
            EPI_LOOP { const int col = u.pn * 256 + bj * 128 + cw; const size_t row = (size_t)(row0 + ai * 128 + m * 16);
                f32x4 v0 = acc[ai][bj][m][0] + wb[bj][0], v1 = acc[ai][bj][m][1] + wb[bj][1];
#pragma unroll
                for (int j = 0; j < 4; ++j) { v0[j] = -__expf(-softplusf_(-v0[j]) - 0.5f); v1[j] = -__expf(-softplusf_(-v1[j]) - 0.5f); }
                *(f32x4*)(rlogw + row * 1024 + col) = v0; *(f32x4*)(rlogw + row * 1024 + col + 4) = v1; }
        } else if (u.pn < 8) {
            f32x4 pb0[2], pb1[2], pk0[2], pk1[2];
#pragma unroll
            for (int bj = 0; bj < 2; ++bj) { const int col = (u.pn - 4) * 256 + bj * 128 + cw, ch = col & 511;
                pb0[bj] = *(const f32x4*)(a0 + col); pb1[bj] = *(const f32x4*)(a0 + col + 4); pk0[bj] = *(const f32x4*)(k_a + ch); pk1[bj] = *(const f32x4*)(k_a + ch + 4); }
#pragma unroll
            EPI_LOOP { const int col = (u.pn - 4) * 256 + bj * 128 + cw, ch = col & 511; const size_t row = (size_t)(row0 + ai * 128 + m * 16);
                const f32x4 b0 = pb0[bj], b1 = pb1[bj], ka0 = pk0[bj], ka1 = pk1[bj];
                float a[8], kv[8], kkv[8], kd[8], ka[8];
#pragma unroll
                for (int j = 0; j < 4; ++j) { a[j] = sigmoidf_(acc[ai][bj][m][0][j] + b0[j]); a[4 + j] = sigmoidf_(acc[ai][bj][m][1][j] + b1[j]); }
                unpack8(*(const u32x4*)(rkv + row * 1536 + 512 + ch), kv); unpack8(*(const u32x4*)(rkk + row * 512 + ch), kkv);
#pragma unroll
                for (int j = 0; j < 8; ++j) { const float kaj = j < 4 ? ka0[j] : ka1[j - 4]; kd[j] = kv[j] * (1.f + (a[j] - 1.f) * kaj); ka[j] = kkv[j] * a[j]; }
                *(u32x4*)(rkdir + row * 1024 + col) = pack8(kd); *(u32x4*)(rkka + row * 1024 + col) = pack8(ka); }
        } else {
#pragma unroll
            EPI_LOOP { const int col = (u.pn - 8) * 256 + bj * 128 + cw; const size_t row = (size_t)(row0 + ai * 128 + m * 16);
                const f32x4 v0 = acc[ai][bj][m][0], v1 = acc[ai][bj][m][1]; u32x4 w; w.x = pk2(v0[0], v0[1]); w.y = pk2(v0[2], v0[3]); w.z = pk2(v1[0], v1[1]); w.w = pk2(v1[2], v1[3]);
                *(u32x4*)(rg + row * 512 + col) = w; }
        }
    }
};
struct EpiBranch {
    static constexpr bool CHAIN = true;
    const bf16* cols; bf16* merged;
    __device__ __forceinline__ bool chain(f32x4 (&acc)[2][2][4][2], const GUnit& u, int wr, int wc, int fr, int fq) const {
        const int br = u.aux; if (br >= 2) return false;
        const int row0 = u.pm * 256 + wr * 64 + fr, cw = wc * 32 + 8 * fq;
#pragma unroll
        EPI_LOOP { const int col = u.pn * 256 + bj * 128 + cw; const size_t row = (size_t)(row0 + ai * 128 + m * 16);
            float g[8], gn[8]; unpack8(*(const u32x4*)(cols + row * NCB + C_GATE + br * 1024 + col), g); unpack8(*(const u32x4*)(cols + row * NCB + C_GATE + (br + 1) * 1024 + col), gn);
#pragma unroll
            for (int j = 0; j < 4; ++j) { acc[ai][bj][m][0][j] *= g[j] * __builtin_amdgcn_rcpf(fmaxf(gn[j], 1e-20f)); acc[ai][bj][m][1][j] *= g[4 + j] * __builtin_amdgcn_rcpf(fmaxf(gn[4 + j], 1e-20f)); } }
        return true;
    }
    __device__ __forceinline__ void operator()(EPI_ARGS) const {
        const int row0 = u.pm * 256 + wr * 64 + fr, cw = wc * 32 + 8 * fq;
#pragma unroll
        EPI_LOOP { const int col = u.pn * 256 + bj * 128 + cw; const size_t row = (size_t)(row0 + ai * 128 + m * 16);
            float g[8]; unpack8(*(const u32x4*)(cols + row * NCB + C_GATE + 2 * 1024 + col), g);
            const f32x4 v0 = acc[ai][bj][m][0], v1 = acc[ai][bj][m][1];
            u32x4 w; w.x = pk2(v0[0] * fmaxf(g[0], 1e-20f), v0[1] * fmaxf(g[1], 1e-20f)); w.y = pk2(v0[2] * fmaxf(g[2], 1e-20f), v0[3] * fmaxf(g[3], 1e-20f));
            w.z = pk2(v1[0] * fmaxf(g[4], 1e-20f), v1[1] * fmaxf(g[5], 1e-20f)); w.w = pk2(v1[2] * fmaxf(g[6], 1e-20f), v1[3] * fmaxf(g[7], 1e-20f)); *(u32x4*)(merged + row * 1024 + col) = w; }
    }
};
struct EpiWo {
    static constexpr bool CHAIN = false;
    const float* xf; float* pre;
    __device__ __forceinline__ void operator()(EPI_ARGS) const {
        const int row0 = u.pm * 256 + wr * 64 + fr, cw = wc * 32 + 8 * fq;
        f32x4 nx[2][2];
#define EW_LD(ai_, m_) do { _Pragma("unroll") for (int bj = 0; bj < 2; ++bj) { const size_t o_ = (size_t)(row0 + (ai_) * 128 + (m_) * 16) * 1024 + u.pn * 256 + bj * 128 + cw; \
            nx[bj][0] = *(const f32x4*)(xf + o_); nx[bj][1] = *(const f32x4*)(xf + o_ + 4); } } while (0)
        EW_LD(0, 0);
#pragma unroll
        for (int ai = 0; ai < 2; ++ai)
#pragma unroll
        for (int m = 0; m < 4; ++m) { const f32x4 c00 = nx[0][0], c01 = nx[0][1], c10 = nx[1][0], c11 = nx[1][1];
            if (!(ai == 1 && m == 3)) { if (m < 3) EW_LD(ai, m + 1); else EW_LD(ai + 1, 0); }
#pragma unroll
            for (int bj = 0; bj < 2; ++bj) { const size_t o = (size_t)(row0 + ai * 128 + m * 16) * 1024 + u.pn * 256 + bj * 128 + cw;
                *(f32x4*)(pre + o) = (bj ? c10 : c00) * DN_ALPHA + acc[ai][bj][m][0]; *(f32x4*)(pre + o + 4) = (bj ? c11 : c01) * DN_ALPHA + acc[ai][bj][m][1]; } }
#undef EW_LD
    }
};
struct EpiPlg {
    static constexpr bool CHAIN = false;
    bf16* sg;
    __device__ __forceinline__ void operator()(EPI_ARGS) const {
        const int row0 = u.pm * 256 + wr * 64 + fr, cw = wc * 32 + 8 * fq;
#pragma unroll
        EPI_LOOP { const size_t o = (size_t)(row0 + ai * 128 + m * 16) * 1024 + u.pn * 256 + bj * 128 + cw; const f32x4 v0 = acc[ai][bj][m][0], v1 = acc[ai][bj][m][1];
            u32x4 w; w.x = pk2(sigmoidf_(v0[0]), sigmoidf_(v0[1])); w.y = pk2(sigmoidf_(v0[2]), sigmoidf_(v0[3])); w.z = pk2(sigmoidf_(v1[0]), sigmoidf_(v1[1])); w.w = pk2(sigmoidf_(v1[2]), sigmoidf_(v1[3]));
            *(u32x4*)(sg + o) = w; }
    }
};
struct EpiGu {
    static constexpr bool CHAIN = false;
    bf16* act; const float* b_gu;
    __device__ __forceinline__ void operator()(EPI_ARGS) const {
        const int row0 = u.pm * 256 + wr * 64 + fr, cw = wc * 32 + 8 * fq, c0 = u.pn * 128 + cw; const float* bg = b_gu + (size_t)u.aux * 2048;
        const f32x4 bg0 = *(const f32x4*)(bg + c0), bg1 = *(const f32x4*)(bg + c0 + 4), bu0 = *(const f32x4*)(bg + 1024 + c0), bu1 = *(const f32x4*)(bg + 1024 + c0 + 4);
#pragma unroll
        for (int ai = 0; ai < 2; ++ai)
#pragma unroll
            for (int m = 0; m < 4; ++m) { float o[8];
#pragma unroll
                for (int j = 0; j < 8; ++j) { float gl = (j < 4 ? acc[ai][0][m][0][j] + bg0[j] : acc[ai][0][m][1][j - 4] + bg1[j - 4]), up = (j < 4 ? acc[ai][1][m][0][j] + bu0[j] : acc[ai][1][m][1][j - 4] + bu1[j - 4]);
                    gl = fminf(gl, 7.0f); up = fminf(fmaxf(up, -7.0f), 7.0f); o[j] = (up + 1.0f) * gl * sigmoidf_(1.702f * gl); }
                *(u32x4*)(act + (size_t)(row0 + ai * 128 + m * 16) * 1024 + c0) = pack8(o); }
    }
};
enum { K_DN = 0, K_PLE = 1, K_PLG = 2 };
struct EpiGuPlg {
    static constexpr bool CHAIN = false;
    EpiGu gu; EpiPlg plg;
    __device__ __forceinline__ void operator()(EPI_ARGS) const { if (u.kind == K_PLG) plg(acc, u, wr, wc, fr, fq); else gu(acc, u, wr, wc, fr, fq); }
};
struct EpiDnPle {
    static constexpr bool CHAIN = false;
    bf16* ye; const float* b_dn; bf16* pleb; const bf16* sg; bf16* sgw;
    __device__ __forceinline__ void operator()(EPI_ARGS) const {
        const int row0 = u.pm * 256 + wr * 64 + fr, cw = wc * 32 + 8 * fq;
        if (u.kind == K_DN) { const float* bd = b_dn + (size_t)u.aux * 1024;
            f32x4 bb[2][2];
#pragma unroll
            for (int bj = 0; bj < 2; ++bj) { bb[bj][0] = *(const f32x4*)(bd + u.pn * 256 + bj * 128 + cw); bb[bj][1] = *(const f32x4*)(bd + u.pn * 256 + bj * 128 + cw + 4); }
#pragma unroll
            EPI_LOOP { const int col = u.pn * 256 + bj * 128 + cw; const f32x4 v0 = acc[ai][bj][m][0] + bb[bj][0], v1 = acc[ai][bj][m][1] + bb[bj][1];
                u32x4 w; w.x = pk2(v0[0], v0[1]); w.y = pk2(v0[2], v0[3]); w.z = pk2(v1[0], v1[1]); w.w = pk2(v1[2], v1[3]);
                *(u32x4*)(ye + (size_t)(row0 + ai * 128 + m * 16) * 1024 + col) = w; }
        } else if (u.kind == K_PLG) { EpiPlg{sgw}(acc, u, wr, wc, fr, fq);
        } else {
            u32x4 ng[2];
#define EP_LD(ai_, m_) do { _Pragma("unroll") for (int bj = 0; bj < 2; ++bj) ng[bj] = *(const u32x4*)(sg + (size_t)(row0 + (ai_) * 128 + (m_) * 16) * 1024 + u.pn * 256 + bj * 128 + cw); } while (0)
            EP_LD(0, 0);
#pragma unroll
            for (int ai = 0; ai < 2; ++ai)
#pragma unroll
            for (int m = 0; m < 4; ++m) { const u32x4 cg0 = ng[0], cg1 = ng[1];
                if (!(ai == 1 && m == 3)) { if (m < 3) EP_LD(ai, m + 1); else EP_LD(ai + 1, 0); }
#pragma unroll
              for (int bj = 0; bj < 2; ++bj) { const size_t o = (size_t)(row0 + ai * 128 + m * 16) * 1024 + u.pn * 256 + bj * 128 + cw; float s[8]; unpack8(bj ? cg1 : cg0, s);
                const f32x4 v0 = acc[ai][bj][m][0], v1 = acc[ai][bj][m][1];
                u32x4 w; w.x = pk2(v0[0] * s[0], v0[1] * s[1]); w.y = pk2(v0[2] * s[2], v0[3] * s[3]); w.z = pk2(v1[0] * s[4], v1[1] * s[5]); w.w = pk2(v1[2] * s[6], v1[3] * s[7]);
                *(u32x4*)(pleb + o) = w; } }
#undef EP_LD
        }
    }
};

struct SchedPlain {
    const char* A; const char* B; int lda, ldb, nt, nM, nN, G, c;
    __device__ __forceinline__ bool next(int i, GUnit& u) const {
        const int L = i * G + c; if (L >= nM * nN) return false;
        pg8::tile_order(L, nM, nN, u.pm, u.pn);
        u.A = A + (size_t)u.pm * 256 * lda; u.B = B + (size_t)u.pn * 256 * ldb; u.nt = nt; u.arow0 = 0; u.kind = 0; u.aux = 0; return true;
    }
};
struct SchedBranch {
    const char* ymix; const char* wbr; int G, c;
    __device__ __forceinline__ bool next(int i, GUnit& u) const {
        const int tile = (i / 3) * G + c, br = i % 3; if (tile >= 256) return false;
        pg8::tile_order(tile, 64, 4, u.pm, u.pn);
        const int k0 = br == 0 ? 0 : (br == 1 ? 512 : 1024);
        u.A = ymix + (size_t)u.pm * 256 * 4096 + k0 * 2; u.B = wbr + (size_t)u.pn * 256 * 4096 + k0 * 2; u.nt = br == 2 ? 16 : 8; u.arow0 = 0; u.kind = 0; u.aux = br; return true;
    }
};
struct MoeTab { const LAS int* pstart; const LAS int* panel_e; int npanels; };
struct SchedGu {
    const char* x1b; const char* wgu; const char* wplg; MoeTab T; int G, c;
    static __device__ __forceinline__ int plg_in_gu(int npanels, int G) { const int r = (npanels * 8) % G; const int x = r ? G - r : 0; return x < 256 ? x : 256; }
    __device__ __forceinline__ bool next(int i, GUnit& u) const {
        const int L = i * G + c, n1 = T.npanels * 8;
        if (L >= n1) { const int x = L - n1; if (x >= plg_in_gu(T.npanels, G)) return false;
            pg8::tile_order(x, 64, 4, u.pm, u.pn);
            u.A = x1b; u.B = wplg + (size_t)u.pn * 256 * 2048; u.nt = 16; u.arow0 = MPAD + u.pm * 256; u.kind = K_PLG; u.aux = 0; return true; }
        pg8::tile_order(L, T.npanels, 8, u.pm, u.pn);
        const int e = T.panel_e[u.pm];
        u.A = x1b; u.B = wgu + (size_t)e * W_GU_SZ + (size_t)u.pn * 256 * 2048; u.nt = 16; u.arow0 = u.pm * 256; u.kind = 0; u.aux = e; return true;
    }
};
struct SchedDnPle {
    const char* act; const char* wdn; const char* pb; const char* wpl; const char* x1b; const char* wplg; MoeTab T; int G, c;
    __device__ __forceinline__ bool next(int i, GUnit& u) const {
        const int L = i * G + c, n1 = T.npanels * 4;
        if (L < n1) { pg8::tile_order(L, T.npanels, 4, u.pm, u.pn); const int e = T.panel_e[u.pm];
            u.A = act + (size_t)u.pm * 256 * 2048; u.B = wdn + (size_t)e * W_SQ_SZ + (size_t)u.pn * 256 * 2048; u.nt = 16; u.arow0 = 0; u.kind = K_DN; u.aux = e; return true; }
        const int nmine = c < n1 ? (n1 - c + G - 1) / G : 0, j = i - nmine, r = n1 % G, rho = (c - r + G) % G, XG = SchedGu::plg_in_gu(T.npanels, G), NP = 256 - XG;
        int x; bool plg;
        if (rho < NP) { if (j > 1) return false; x = XG + rho; plg = (j == 0); } else { if (j > 0) return false; x = rho - NP; plg = false; }
        pg8::tile_order(x, 64, 4, u.pm, u.pn);
        if (plg) { u.A = x1b + (size_t)u.pm * 256 * 2048; u.B = wplg + (size_t)u.pn * 256 * 2048; u.nt = 16; u.arow0 = 0; u.kind = K_PLG; u.aux = 0; return true; }
        u.A = pb + (size_t)u.pm * 256 * 2048; u.B = wpl + (size_t)u.pn * 256 * 2048; u.nt = 4; u.arow0 = 0; u.kind = K_PLE; u.aux = 0; return true;
    }
};

struct TrDesc { const float* W; bf16* WT; int Nsrc, k0, srccol, dstK, n0, dk0; };
__device__ __forceinline__ void tr_load(const TrDesc& d, f32x4 (&v)[16], int lane) {
    const int kr = lane >> 4; const float* p = d.W + (size_t)(d.k0 + kr) * d.Nsrc + (d.srccol >= 0 ? d.srccol : 0);
#pragma unroll
    for (int t = 0; t < 16; ++t) v[t] = d.srccol >= 0 ? __builtin_nontemporal_load((const f32x4*)(p + (size_t)(4 * t) * d.Nsrc)) : (f32x4){0.f, 0.f, 0.f, 0.f};
}
__device__ __forceinline__ void tr_proc(const TrDesc& d, const f32x4 (&v)[16], LAS float* scr, int lane) {
    const int q = lane & 15, kr = lane >> 4;
#pragma unroll
    for (int t = 0; t < 16; ++t) { const int kk = 4 * t + kr; *(LAS f32x4*)(scr + kk * 64 + ((q ^ ((kk >> 3) & 7)) << 2)) = v[t]; }
    LDS_WAIT(); asm volatile("" ::: "memory");
    const int c = lane & 7;
#pragma unroll
    for (int jj = 0; jj < 8; ++jj) { const int n = (lane >> 3) + 8 * jj; const LAS float* sp = scr + (8 * c) * 64 + ((((n >> 2) ^ c) & 15) << 2) + (n & 3);
        u32x4 o; o.x = pk2(sp[0], sp[64]); o.y = pk2(sp[2 * 64], sp[3 * 64]); o.z = pk2(sp[4 * 64], sp[5 * 64]); o.w = pk2(sp[6 * 64], sp[7 * 64]);
        __builtin_nontemporal_store(o, (u32x4*)(d.WT + (size_t)(d.n0 + n) * d.dstK + d.dk0 + 8 * c)); }
    LDS_WAIT(); asm volatile("" ::: "memory");
}
template <class DescFn> __device__ __forceinline__ void tr_run(int n, int first, int stride, const DescFn& fn, LAS float* scr, int lane) {
    int it = first; if (it >= n) return;
    TrDesc dA = fn(it), dB = dA; f32x4 vA[16], vB[16]; tr_load(dA, vA, lane);
    for (;;) {
        const int it2 = it + stride; const bool has2 = it2 < n; if (has2) { dB = fn(it2); tr_load(dB, vB, lane); }
        tr_proc(dA, vA, scr, lane); if (!has2) break;
        const int it3 = it2 + stride; const bool has3 = it3 < n; if (has3) { dA = fn(it3); tr_load(dA, vA, lane); }
        tr_proc(dB, vB, scr, lane); if (!has3) break;
        it = it3;
    }
}
__device__ __forceinline__ int win_src(int n) {
    if (n < 2048) return n;
    if (n < 3584) return n - 2048 + 2064;
    if (n < 3712) return n - 3584 + 3728;
    if (n < 3840) return n - 3712 + 3856;
    if (n < 4864) return n - 3840 + 3984;
    if (n < 6400) return n - 4864 + 5008;
    if (n < 9472) return n - 6400 + 6576;
    if (n < 9488) return n - 9472 + 2048;
    if (n < 9520) return n - 9488 + 6544;
    if (n < 9648) return n - 9520 + 3600;
    return -1;
}
__device__ __forceinline__ void ln_row(f32x4 (&v)[4], const f32x4 (&gg)[4], const f32x4 (&bb)[4], float* of, bf16* ob, int lane) {
    float s = 0.f;
#pragma unroll
    for (int j = 0; j < 4; ++j) s += (v[j].x + v[j].y) + (v[j].z + v[j].w);
    const float mean = wave_sum(s) * (1.f / DM); float s2 = 0.f;
#pragma unroll
    for (int j = 0; j < 4; ++j) { v[j] = v[j] - mean; s2 += (v[j].x * v[j].x + v[j].y * v[j].y) + (v[j].z * v[j].z + v[j].w * v[j].w); }
    const float rstd = 1.f / sqrtf(wave_sum(s2) * (1.f / DM) + LN_EPS);
#pragma unroll
    for (int j = 0; j < 4; ++j) { const f32x4 o = v[j] * rstd * gg[j] + bb[j];
        *(f32x4*)(of + 256 * j + 4 * lane) = o; u32x2 w; w.x = pk2(o.x, o.y); w.y = pk2(o.z, o.w); *(u32x2*)(ob + 256 * j + 4 * lane) = w; }
}
__device__ __forceinline__ void phase_prologue(Frame& F, const Params& P) {
    LAS float* scr = (LAS float*)(F.lds + F.wave * 16384);
    const int gw = F.vcu * NWAVES + F.wave, NGW = F.G * NWAVES; int lane = F.lane; asm volatile("" : "+v"(lane)); const int q4 = 4 * (lane & 15);
    int rot = 0;
#define ITEMS(n, ...) do { const int _n = (n); tr_run(_n, (gw + NGW - rot) % NGW, NGW, [&](int it) -> TrDesc { __VA_ARGS__ }, scr, lane); rot = (rot + _n) % NGW; } while (0)
    for (int l = 0; l < DEPTH; ++l) {
        { const float* W = P.in[I_W_IN] + (size_t)l * 1024 * 9648; bf16* D = (bf16*)(P.ws + WS_W_IN + l * W_IN_SZ);
          ITEMS(16 * 152, const int kb = it / 152, nb = it % 152; return TrDesc{W, D, 9648, kb * 64, win_src(nb * 64 + q4), 1024, nb * 64, kb * 64};); }
        { const float* W = P.in[I_W_BR] + (size_t)l * 2048 * 1024; bf16* D = (bf16*)(P.ws + WS_W_BR + l * W_BR_SZ);
          ITEMS(32 * 16, const int kb = it / 16, nb = it % 16; return TrDesc{W, D, 1024, kb * 64, nb * 64 + q4, 2048, nb * 64, kb * 64};); }
        { const float* W = P.in[I_W_O] + (size_t)l * 1024 * 1024; bf16* D = (bf16*)(P.ws + WS_W_O + l * W_SQ_SZ);
          ITEMS(16 * 16, const int kb = it / 16, nb = it % 16; return TrDesc{W, D, 1024, kb * 64, nb * 64 + q4, 1024, nb * 64, kb * 64};); }
        { const float* W = P.in[I_W_PLG] + (size_t)l * 1024 * 1024; bf16* D = (bf16*)(P.ws + WS_W_PLG + l * W_SQ_SZ);
          ITEMS(16 * 16, const int kb = it / 16, nb = it % 16; return TrDesc{W, D, 1024, kb * 64, nb * 64 + q4, 1024, nb * 64, kb * 64};); }
        { const float* W = P.in[I_W_PL] + (size_t)l * 256 * 1024; bf16* D = (bf16*)(P.ws + WS_W_PL + l * W_PL_SZ);
          ITEMS(4 * 16, const int kb = it / 16, nb = it % 16; return TrDesc{W, D, 1024, kb * 64, nb * 64 + q4, 1024, nb * 64, kb * 64};); }
        { bf16* D = (bf16*)(P.ws + WS_W_LORA + l * W_LORA_SZ); const float* wup = P.in[I_R_WUP]; const float* aup = P.in[I_R_AUP]; const float* gup = P.in[I_R_GUP];
          ITEMS(6 * 40, const int kb = it / 40, nb = it % 40; const int rb = nb / 8;
              const float* W = nullptr; int kl = 0;
              if (rb < 4) { if (kb == rb) { W = (rb < 2 ? wup : aup) + ((size_t)l * 2 + (rb & 1)) * 64 * 512; kl = 0; } }
              else if (kb >= 4) { W = gup + (size_t)l * 128 * 512; kl = (kb - 4) * 64; }
              return TrDesc{W ? W : gup, D, 512, kl, W ? (nb % 8) * 64 + q4 : -1, 384, nb * 64, kb * 64};); }
        { const float* W = P.in[I_W_GU] + (size_t)l * 32 * 1024 * 2048; bf16* D = (bf16*)(P.ws + WS_W_GU + (size_t)l * 32 * W_GU_SZ);
          ITEMS(32 * 16 * 32, const int e = it / 512, r = it % 512, kb = r / 32, nb = r % 32; const int n0 = nb * 64, pn = n0 >> 8, bj = (n0 >> 7) & 1, j0 = n0 & 127;
              return TrDesc{W + (size_t)e * 1024 * 2048, D + (size_t)e * 2048 * 1024, 2048, kb * 64, bj * 1024 + pn * 128 + j0 + q4, 1024, n0, kb * 64};); }
        { const float* W = P.in[I_W_DN] + (size_t)l * 32 * 1024 * 1024; bf16* D = (bf16*)(P.ws + WS_W_DN + (size_t)l * 32 * W_SQ_SZ);
          ITEMS(32 * 16 * 16, const int e = it / 256, r = it % 256, kb = r / 16, nb = r % 16;
              return TrDesc{W + (size_t)e * 1024 * 1024, D + (size_t)e * 1024 * 1024, 1024, kb * 64, nb * 64 + q4, 1024, nb * 64, kb * 64};); }
    }
#undef ITEMS
    { f32x4 gg[4], bb[4], vn[4];
#pragma unroll
      for (int j = 0; j < 4; ++j) { gg[j] = *(const f32x4*)(P.in[I_LNIN_G] + 256 * j + 4 * lane); bb[j] = *(const f32x4*)(P.in[I_LNIN_B] + 256 * j + 4 * lane); vn[j] = (f32x4){0.f, 0.f, 0.f, 0.f}; }
      if (gw < MTOK) {
#pragma unroll
          for (int j = 0; j < 4; ++j) vn[j] = *(const f32x4*)(P.in[I_X] + (size_t)gw * DM + 256 * j + 4 * lane); }
      for (int m = gw; m < MTOK; m += NGW) { f32x4 v[4];
#pragma unroll
          for (int j = 0; j < 4; ++j) v[j] = vn[j];
          if (m + NGW < MTOK) {
#pragma unroll
              for (int j = 0; j < 4; ++j) vn[j] = *(const f32x4*)(P.in[I_X] + (size_t)(m + NGW) * DM + 256 * j + 4 * lane); }
          ln_row(v, gg, bb, (float*)(P.ws + A_XF) + (size_t)m * DM, (bf16*)(P.ws + A_XB) + (size_t)m * DM, lane); } }
    for (int r0 = gw; r0 < DEPTH * MTOK; r0 += 4 * NGW) { f32x4 v[4];
#pragma unroll
        for (int k = 0; k < 4; ++k) v[k] = *(const f32x4*)(P.in[I_P] + (size_t)(r0 + k * NGW) * PLE + 4 * lane);
#pragma unroll
        for (int k = 0; k < 4; ++k) { u32x2 w; w.x = pk2(v[k].x, v[k].y); w.y = pk2(v[k].z, v[k].w); *(u32x2*)((bf16*)(P.ws + A_PB) + (size_t)(r0 + k * NGW) * 1024 + 4 * lane) = w; } }
}

__device__ __forceinline__ void phase_prep(Frame& F, const Params& P, int l) {
    const int gw = F.vcu * NWAVES + F.wave, NGW = F.G * NWAVES; int lane = F.lane; asm volatile("" : "+v"(lane));
    const bf16* cols = (const bf16*)(P.ws + A_COLS); const float* side = (const float*)(P.ws + A_SIDE);
    bf16* gqkv = (bf16*)(P.ws + A_GQKV); float* gsc = (float*)(P.ws + A_GSC); bf16* sxbc = (bf16*)(P.ws + A_SXBC); float* ssc = (float*)(P.ws + A_SSC);
    bf16* rkv = (bf16*)(P.ws + A_RKV); bf16* rkk = (bf16*)(P.ws + A_RKK); bf16* lin = (bf16*)(P.ws + A_LIN);
    const float* gconv = P.in[I_GDN_CONV] + (size_t)l * 5 * 1536; const float* sconv = P.in[I_S_CONV] + (size_t)l * 5 * 1536; const float* sconvb = P.in[I_S_CONVB] + (size_t)l * 1536;
    const float* mup = P.in[I_R_MUP] + (size_t)l * 1920; const float* mun = P.in[I_R_MUN] + (size_t)l * 1920; const float* k_k = P.in[I_R_KK] + (size_t)l * 512;
    for (int g8 = gw; g8 < MTOK / 8; g8 += NGW) {
        const int m0 = g8 * 8, t0 = m0 % SEQ; const bf16* crow = cols + (size_t)m0 * NCB;
        u32x4 xn[12];
#define PREP_LD(part_) do { const int p_ = (part_); const bf16* src_ = crow + (p_ < 3 ? C_GQKV + p_ * 512 : C_SXBC + (p_ - 3) * 512) + 8 * lane; \
            _Pragma("unroll") for (int rr = 0; rr < 12; ++rr) { const int tt = t0 - 2 + rr; xn[rr] = (tt >= 0 && tt < SEQ) ? *(const u32x4*)(src_ + (ptrdiff_t)(rr - 2) * NCB) : (u32x4){0u, 0u, 0u, 0u}; } } while (0)
        PREP_LD(0);
#pragma unroll 1
        for (int part = 0; part < 6; ++part) { const bool isg = part < 3; const int pp = isg ? part : part - 3, ch = pp * 512 + 8 * lane; const float* cw = (isg ? gconv : sconv) + ch;
            u32x4 xr[12];
#pragma unroll
            for (int rr = 0; rr < 12; ++rr) xr[rr] = xn[rr];
            if (part < 5) PREP_LD(part + 1);
            float w[5][8];
#pragma unroll
            for (int tap = 0; tap < 5; ++tap) { const f32x4 w0 = *(const f32x4*)(cw + tap * 1536), w1 = *(const f32x4*)(cw + tap * 1536 + 4);
#pragma unroll
                for (int j = 0; j < 4; ++j) { w[tap][j] = w0[j]; w[tap][4 + j] = w1[j]; } }
            float bias[8];
#pragma unroll
            for (int j = 0; j < 8; ++j) bias[j] = 0.f;
            if (!isg) { const f32x4 b0 = *(const f32x4*)(sconvb + ch), b1 = *(const f32x4*)(sconvb + ch + 4);
#pragma unroll
                for (int j = 0; j < 4; ++j) { bias[j] = b0[j]; bias[4 + j] = b1[j]; } }
#pragma unroll
            for (int tk = 0; tk < 8; ++tk) { float o[8];
#pragma unroll
                for (int j = 0; j < 8; ++j) o[j] = bias[j];
#pragma unroll
                for (int tap = 0; tap < 5; ++tap) { float x[8]; unpack8(xr[tk + tap], x);
#pragma unroll
                    for (int j = 0; j < 8; ++j) o[j] += x[j] * w[tap][j]; }
                float ss = 0.f;
#pragma unroll
                for (int j = 0; j < 8; ++j) { o[j] = siluf_(o[j]); ss += o[j] * o[j]; }
                if (isg && pp < 2) { ss += __shfl_xor(ss, 1); ss += __shfl_xor(ss, 2); ss += __shfl_xor(ss, 4); ss += __shfl_xor(ss, 8);
                    const float sc = rsqrtf(ss + 1e-6f) * (pp == 0 ? 0.08838834764831845f : 1.0f);
#pragma unroll
                    for (int j = 0; j < 8; ++j) o[j] *= sc; }
                *(u32x4*)((isg ? gqkv : sxbc) + (size_t)(m0 + tk) * 1536 + ch) = pack8(o); } }
#undef PREP_LD
        { const int tk = lane >> 3, i8 = lane & 7; const size_t m = (size_t)m0 + tk;
          { const float r0 = side[m * 256 + i8], r1 = side[m * 256 + 8 + i8];
            gsc[m * 16 + i8] = sigmoidf_(r0); gsc[m * 16 + 8 + i8] = -__expf(P.in[I_GDN_ALOG][l * 8 + i8]) * softplusf_(r1 + P.in[I_GDN_DTB][l * 8 + i8]); }
#pragma unroll
          for (int q = 0; q < 4; ++q) { const int i = i8 + 8 * q; const float dt = softplusf_(side[m * 256 + 16 + i] + P.in[I_S_DTB][l * 32 + i]);
              ssc[m * 64 + i] = dt; ssc[m * 64 + 32 + i] = -__expf(P.in[I_S_ALOG][l * 32 + i]) * dt; } }
        f32x2 lw[10]; unsigned la[10], lg[10];
#pragma unroll
        for (int rr = 0; rr < 10; ++rr) { const int tt = t0 - 1 + rr; const bool ok = tt >= 0 && tt < SEQ; const ptrdiff_t mr = (ptrdiff_t)m0 - 1 + rr;
            lw[rr] = ok ? *(const f32x2*)(side + mr * 256 + 48 + 2 * lane) : (f32x2){0.f, 0.f};
            la[rr] = ok ? *(const unsigned*)(cols + mr * NCB + C_RAL + 2 * lane) : 0u; lg[rr] = ok ? *(const unsigned*)(cols + mr * NCB + C_RAL + 128 + 2 * lane) : 0u; }
        u32x4 yn[10];
#define PREP_LR(part_) do { const bf16* src_ = crow + C_RRKV + (part_) * 512 + 8 * lane; \
            _Pragma("unroll") for (int rr = 0; rr < 10; ++rr) { const int tt = t0 - 1 + rr; yn[rr] = (tt >= 0 && tt < SEQ) ? *(const u32x4*)(src_ + (ptrdiff_t)(rr - 1) * NCB) : (u32x4){0u, 0u, 0u, 0u}; } } while (0)
        PREP_LR(0);
#pragma unroll 1
        for (int part = 0; part < 3; ++part) { const int ch = part * 512 + 8 * lane;
            u32x4 xr[10];
#pragma unroll
            for (int rr = 0; rr < 10; ++rr) xr[rr] = yn[rr];
            if (part < 2) PREP_LR(part + 1);
            const f32x4 mp0 = *(const f32x4*)(mup + ch), mp1 = *(const f32x4*)(mup + ch + 4), mn0 = *(const f32x4*)(mun + ch), mn1 = *(const f32x4*)(mun + ch + 4);
            const f32x4 kk0 = *(const f32x4*)(k_k + 8 * lane), kk1 = *(const f32x4*)(k_k + 8 * lane + 4);
#pragma unroll
            for (int tk = 0; tk < 8; ++tk) { float c[8], p[8], n[8], o[8]; unpack8(xr[tk], p); unpack8(xr[tk + 1], c); unpack8(xr[tk + 2], n);
#pragma unroll
                for (int j = 0; j < 8; ++j) o[j] = c[j] + (j < 4 ? mp0[j] : mp1[j - 4]) * (p[j] - c[j]) + (j < 4 ? mn0[j] : mn1[j - 4]) * (n[j] - c[j]);
                *(u32x4*)(rkv + (size_t)(m0 + tk) * 1536 + ch) = pack8(o);
                if (part == 1) { float ss = 0.f;
#pragma unroll
                    for (int j = 0; j < 8; ++j) { o[j] *= (j < 4 ? kk0[j] : kk1[j - 4]); ss += o[j] * o[j]; }
                    ss += __shfl_xor(ss, 1); ss += __shfl_xor(ss, 2); ss += __shfl_xor(ss, 4);
                    const float sc = rsqrtf(ss + 1e-6f);
#pragma unroll
                    for (int j = 0; j < 8; ++j) o[j] *= sc;
                    *(u32x4*)(rkk + (size_t)(m0 + tk) * 512 + 8 * lane) = pack8(o); } } }
#undef PREP_LR
        { const f32x2 mp0 = *(const f32x2*)(mup + 1536 + 2 * lane), mn0 = *(const f32x2*)(mun + 1536 + 2 * lane), mp1 = *(const f32x2*)(mup + 1664 + 2 * lane), mn1 = *(const f32x2*)(mun + 1664 + 2 * lane),
                      mp2 = *(const f32x2*)(mup + 1792 + 2 * lane), mn2 = *(const f32x2*)(mun + 1792 + 2 * lane);
#pragma unroll
          for (int tk = 0; tk < 8; ++tk) { const size_t m = (size_t)m0 + tk;
              { const f32x2 c = lw[tk + 1], p = lw[tk], n = lw[tk + 2]; const float o0 = c.x + mp0.x * (p.x - c.x) + mn0.x * (n.x - c.x), o1 = c.y + mp0.y * (p.y - c.y) + mn0.y * (n.y - c.y);
                *(unsigned*)(lin + m * 384 + 2 * lane) = pk2(tanhf(o0), tanhf(o1)); }
              { const float c0 = bflo(la[tk + 1]), c1 = bfhi(la[tk + 1]), p0 = bflo(la[tk]), p1 = bfhi(la[tk]), n0 = bflo(la[tk + 2]), n1 = bfhi(la[tk + 2]);
                *(unsigned*)(lin + m * 384 + 128 + 2 * lane) = pk2(c0 + mp1.x * (p0 - c0) + mn1.x * (n0 - c0), c1 + mp1.y * (p1 - c1) + mn1.y * (n1 - c1)); }
              { const float c0 = bflo(lg[tk + 1]), c1 = bfhi(lg[tk + 1]), p0 = bflo(lg[tk]), p1 = bfhi(lg[tk]), n0 = bflo(lg[tk + 2]), n1 = bfhi(lg[tk + 2]);
                *(unsigned*)(lin + m * 384 + 256 + 2 * lane) = pk2(sigmoidf_(c0 + mp2.x * (p0 - c0) + mn2.x * (n0 - c0)), sigmoidf_(c1 + mp2.y * (p1 - c1) + mn2.y * (n1 - c1))); } } }
    }
}

__device__ __forceinline__ void ssd_scan_item(const Params& P, int item);
__device__ __forceinline__ void gdn_scan_unit(Frame& F, const Params& P, int unit, int lane);
__device__ __forceinline__ void rwkv_scan_unit(Frame& F, const Params& P, int unit, int lane);
__device__ __forceinline__ void ssd_out_unit(Frame& F, const Params& P, int l_, int u, int tid, int lane);
__device__ __forceinline__ void phase_scan_seq(Frame& F, const Params& P, int l_) {
    int lane = F.lane; asm volatile("" : "+v"(lane));
    const int xg = F.vcu >> 5, xi = F.vcu & 31;
    if (xi < 8) { const int chain = xg + 8 * (xi >> 2); gdn_scan_unit(F, P, chain * 4 + (xi & 3), lane); return; }
    if (xi < 12) { rwkv_scan_unit(F, P, xg + 8 * (xi - 8), lane); return; }
    { int tid2 = F.tid; asm volatile("" : "+v"(tid2)); for (int u = xg * 20 + (xi - 12); u < 256; u += 160) ssd_out_unit(F, P, l_, u, tid2, lane); }
}

typedef float f32x16 __attribute__((ext_vector_type(16)));
typedef short s16x4 __attribute__((ext_vector_type(4)));
#define MFMA32(X, Y, C) __builtin_amdgcn_mfma_f32_32x32x16_bf16((X), (Y), (C), 0, 0, 0)
__device__ __forceinline__ bf16x8 frag_g(const bf16* M, int ld, int row0, int k0, int lane) { return *(const bf16x8*)(M + (size_t)(row0 + (lane & 31)) * ld + k0 + 8 * (lane >> 5)); }
__device__ __forceinline__ bf16x8 frag_l(const LAS bf16* M, int ld, int row0, int k0, int lane) { return *(const LAS bf16x8*)(M + (row0 + (lane & 31)) * ld + k0 + 8 * (lane >> 5)); }
__device__ __forceinline__ bf16x8 frag_tr(const LAS bf16* T, int ld, int k0, int n0, int lane) {
    const int h = lane >> 5, blk = (lane >> 4) & 1, q = (lane & 15) >> 2, p = lane & 3;
    const LAS bf16* a = T + (k0 + 8 * h + q) * ld + n0 + 16 * blk + 4 * p;
    const s16x4 lo = __builtin_bit_cast(s16x4, __builtin_amdgcn_ds_read_tr16_b64_v4i16((LAS s16x4*)a)), hi = __builtin_bit_cast(s16x4, __builtin_amdgcn_ds_read_tr16_b64_v4i16((LAS s16x4*)(a + 4 * ld)));
    return (bf16x8){lo[0], lo[1], lo[2], lo[3], hi[0], hi[1], hi[2], hi[3]};
}
template <int KS, class FX, class FY> __device__ __forceinline__ f32x16 mma_ks(f32x16 acc, const FX& fx, const FY& fy) {
    bf16x8 xa[KS], ya[KS];
#pragma unroll
    for (int ks = 0; ks < KS; ++ks) { xa[ks] = fx(ks); ya[ks] = fy(ks); }
    __builtin_amdgcn_sched_barrier(0);
#pragma unroll
    for (int ks = 0; ks < KS; ++ks) acc = MFMA32(xa[ks], ya[ks], acc);
    return acc;
}
__device__ __forceinline__ float scan_incl(float v, int lane) {
#pragma unroll
    for (int o = 1; o < 64; o <<= 1) { const float t = __shfl_up(v, o); v += lane >= o ? t : 0.f; }
    return v;
}
__device__ __forceinline__ float scan_incl_rev(float v, int lane) {
#pragma unroll
    for (int o = 1; o < 64; o <<= 1) { const float t = __shfl_down(v, o); v += lane + o < 64 ? t : 0.f; }
    return v;
}
__device__ __forceinline__ f32x16 zero16() { f32x16 z; for (int i = 0; i < 16; ++i) z[i] = 0.f; return z; }

__device__ __forceinline__ void st_frag2(bf16* f0, const f32x16& a, int lane);
constexpr int SSD_LDB = 136, SSD_LDX = 264;
__device__ __forceinline__ void ssd_states_unit(Frame& F, const Params& P, int u, int tid, int lane) {
    const int b = u >> 8, c = (u >> 2) & 63, g = (u >> 1) & 1, hh = u & 1, wave = F.wave; const size_t m0 = (size_t)b * SEQ + c * 128;
    const bf16* sx = (const bf16*)(P.ws + A_SXBC); const float* ssc = (const float*)(P.ws + A_SSC);
    LAS bf16* Bl = (LAS bf16*)(F.lds); LAS bf16* Xl = (LAS bf16*)(F.lds + 34816); LAS float* wS = (LAS float*)(F.lds + 102400) + wave * 128;
    __syncthreads();
    for (int i = tid; i < 2048; i += NTHR) { const int row = i >> 4, ch = i & 15; *(LAS u32x4*)(Bl + row * SSD_LDB + ch * 8) = *(const u32x4*)(sx + (m0 + row) * 1536 + 1024 + g * 128 + ch * 8); }
    for (int i = tid; i < 4096; i += NTHR) { const int row = i >> 5, ch = i & 31; *(LAS u32x4*)(Xl + row * SSD_LDX + ch * 8) = *(const u32x4*)(sx + (m0 + row) * 1536 + g * 512 + hh * 256 + ch * 8); }
    const int hq = wave & 3, dir = wave >> 2, head = g * 8 + hh * 4 + hq;
    { const float a0 = ssc[(m0 + lane) * 64 + 32 + dir * 16 + head], a1 = ssc[(m0 + lane + 64) * 64 + 32 + dir * 16 + head];
      const float d0 = ssc[(m0 + lane) * 64 + dir * 16 + head], d1 = ssc[(m0 + lane + 64) * 64 + dir * 16 + head];
      float p0, p1, tot;
      if (dir == 0) { p0 = scan_incl(a0, lane); const float t0 = __shfl(p0, 63); p1 = scan_incl(a1, lane) + t0; tot = __shfl(p1, 63); }
      else { p1 = scan_incl_rev(a1, lane); const float t1 = __shfl(p1, 0); p0 = scan_incl_rev(a0, lane) + t1; tot = __shfl(p0, 0); }
      wS[lane] = d0 * __expf(tot - p0); wS[lane + 64] = d1 * __expf(tot - p1);
      if (lane == 0) ((float*)(P.ws + A_SDEC))[((b * 2 + dir) * 64 + (dir ? 63 - c : c)) * 16 + head] = __expf(tot); }
    __syncthreads();
    bf16* hs = (bf16*)(P.ws + A_HS) + ((size_t)(((b * 2 + dir) * 64 + (dir ? 63 - c : c)) * 16 + head)) * 8192;
#pragma unroll 1
    for (int pt = 0; pt < 2; ++pt) {
        bf16x8 Yf[8];
#pragma unroll
        for (int ks = 0; ks < 8; ++ks) { const bf16x8 raw = frag_tr(Xl, SSD_LDX, 16 * ks, hq * 64 + 32 * pt, lane);
            const f32x4 w0 = *(const LAS f32x4*)(wS + 16 * ks + 8 * (lane >> 5)), w1 = *(const LAS f32x4*)(wS + 16 * ks + 8 * (lane >> 5) + 4);
            float f[8];
#pragma unroll
            for (int j = 0; j < 8; ++j) f[j] = bf2f((unsigned short)raw[j]) * (j < 4 ? w0[j] : w1[j - 4]);
            const u32x4 pk = pack8(f); Yf[ks] = __builtin_bit_cast(bf16x8, pk); }
#pragma unroll 1
        for (int nt = 0; nt < 4; ++nt) { f32x16 acc = zero16();
            acc = mma_ks<8>(acc, [&](int ks) { return frag_tr(Bl, SSD_LDB, 16 * ks, 32 * nt, lane); }, [&](int ks) { return Yf[ks]; });
            st_frag2(hs + (pt * 8 + 2 * nt) * 512, acc, lane); }
    }
}
__device__ __forceinline__ void phase_ssd_states(Frame& F, const Params& P) {
    int lane = F.lane; asm volatile("" : "+v"(lane)); int tid = F.tid; asm volatile("" : "+v"(tid));
    for (int u = F.vcu; u < 512; u += F.G) ssd_states_unit(F, P, u, tid, lane);
}
__device__ __forceinline__ void ssd_scan_item(const Params& P, int item) {
    const int bdh = item >> 11, e4 = item & 2047, bd = bdh >> 4, h = bdh & 15;
    bf16* base = (bf16*)(P.ws + A_HS) + ((size_t)(bd * 64) * 16 + h) * 8192 + e4 * 4; const float* dec = (const float*)(P.ws + A_SDEC) + (bd * 64) * 16 + h;
    float run[4] = {0.f, 0.f, 0.f, 0.f};
#pragma unroll 1
    for (int c0 = 0; c0 < 64; c0 += 32) { u32x2 v[32]; float d[32];
#pragma unroll
        for (int j = 0; j < 32; ++j) { v[j] = *(const u32x2*)(base + (size_t)(c0 + j) * 16 * 8192); d[j] = dec[(c0 + j) * 16]; }
#pragma unroll
        for (int j = 0; j < 32; ++j) { u32x2 o; o.x = pk2(run[0], run[1]); o.y = pk2(run[2], run[3]); *(u32x2*)(base + (size_t)(c0 + j) * 16 * 8192) = o;
            run[0] = run[0] * d[j] + bflo(v[j].x); run[1] = run[1] * d[j] + bfhi(v[j].x); run[2] = run[2] * d[j] + bflo(v[j].y); run[3] = run[3] * d[j] + bfhi(v[j].y); } }
}
__device__ __forceinline__ bf16x8 frag_l_perm(const LAS bf16* M, int ld, int row0, int k0, int lane) {
    const LAS bf16* p = M + (row0 + (lane & 31)) * ld + k0 + 4 * (lane >> 5); const s16x4 lo = *(const LAS s16x4*)p, hi = *(const LAS s16x4*)(p + 8);
    return (bf16x8){lo[0], lo[1], lo[2], lo[3], hi[0], hi[1], hi[2], hi[3]};
}
constexpr int SO_G = 0, SO_C = 34816, SO_X = 69632, SO_Y = 104448, SO_SC = 141312, SO_SQ = 145408;
__device__ __forceinline__ void ssd_out_unit(Frame& F, const Params& P, int l_, int u, int tid, int lane) {
    const int b = u >> 7, c = (u >> 1) & 63, g = u & 1, wave = F.wave, h5 = lane >> 5, l31 = lane & 31; const size_t m0 = (size_t)b * SEQ + c * 128;
    const bf16* sx = (const bf16*)(P.ws + A_SXBC); const float* ssc = (const float*)(P.ws + A_SSC); const bf16* cols = (const bf16*)(P.ws + A_COLS); bf16* ymix = (bf16*)(P.ws + A_YMIX);
    LAS bf16* Gl = (LAS bf16*)(F.lds + SO_G); LAS bf16* Cl = (LAS bf16*)(F.lds + SO_C); LAS bf16* Xl = (LAS bf16*)(F.lds + SO_X); LAS bf16* Yst = (LAS bf16*)(F.lds + SO_Y + wave * 4608);
    LAS float* sumsq = (LAS float*)(F.lds + SO_SQ);
    const float* sd = P.in[I_S_D] + (size_t)l_ * 16; const float* snorm = P.in[I_S_NORM] + (size_t)l_ * 1024;
    __syncthreads();
    for (int i = tid; i < 2048; i += NTHR) { const int row = i >> 4, ch = i & 15; const bf16* src = sx + (m0 + row) * 1536 + 1024 + g * 128 + ch * 8;
        *(LAS u32x4*)(Xl + row * SSD_LDB + ch * 8) = *(const u32x4*)src; *(LAS u32x4*)(Cl + row * SSD_LDB + ch * 8) = *(const u32x4*)(src + 256); }
    __syncthreads();
    { const int lt = wave >> 1;
#pragma unroll 1
      for (int k2 = 0; k2 < 2; ++k2) { const int st = (wave & 1) * 2 + k2; f32x16 acc = zero16();
        acc = mma_ks<8>(acc, [&](int ks) { return frag_l(Xl, SSD_LDB, 32 * st, 16 * ks, lane); }, [&](int ks) { return frag_l(Cl, SSD_LDB, 32 * lt, 16 * ks, lane); });
        LAS bf16* o = Gl + (32 * lt + l31) * SSD_LDB + 32 * st + 4 * h5;
#pragma unroll
        for (int qd = 0; qd < 4; ++qd) { u32x2 w; w.x = pk2(acc[4 * qd], acc[4 * qd + 1]); w.y = pk2(acc[4 * qd + 2], acc[4 * qd + 3]); *(LAS u32x2*)(o + 8 * qd) = w; } } }
    const int hq = wave >> 2, lt = wave & 3, l = 32 * lt + l31;
    u32x4 xr[4]; float sv[8];
#define SO_PF(rr) do { _Pragma("unroll") for (int k = 0; k < 4; ++k) { const int i = tid + NTHR * k, row = i >> 4, ch = i & 15; xr[k] = *(const u32x4*)(sx + (m0 + row) * 1536 + g * 512 + (rr) * 128 + ch * 8); } \
        if (lt == 0) { const int hd_ = g * 8 + (rr) * 2 + hq; const float* s0_ = ssc + (m0 + lane) * 64 + hd_; const float* s1_ = s0_ + 64 * 64; \
            sv[0] = s0_[32]; sv[1] = s1_[32]; sv[2] = s0_[48]; sv[3] = s1_[48]; sv[4] = s0_[0]; sv[5] = s1_[0]; sv[6] = s0_[16]; sv[7] = s1_[16]; } } while (0)
#pragma unroll
    for (int k = 0; k < 8; ++k) sv[k] = 0.f;
    SO_PF(0);
#pragma unroll 1
    for (int r = 0; r < 4; ++r) {
        const int head = g * 8 + r * 2 + hq;
        LAS float* sc = (LAS float*)(F.lds + SO_SC + hq * 2048); LAS float* af = sc, *ab = sc + 128, *dtf = sc + 256, *dtb = sc + 384;
        __syncthreads();
#pragma unroll
        for (int k = 0; k < 4; ++k) { const int i = tid + NTHR * k, row = i >> 4, ch = i & 15; *(LAS u32x4*)(Xl + row * SSD_LDB + ch * 8) = xr[k]; }
        if (lt == 0) { const float a0 = sv[0], a1 = sv[1], c0 = sv[2], c1 = sv[3];
          const float p0 = scan_incl(a0, lane), t0 = __shfl(p0, 63), p1 = scan_incl(a1, lane) + t0;
          const float q1 = scan_incl_rev(c1, lane), t1 = __shfl(q1, 0), q0 = scan_incl_rev(c0, lane) + t1;
          af[lane] = p0; af[lane + 64] = p1; ab[lane] = q0; ab[lane + 64] = q1;
          dtf[lane] = sv[4]; dtf[lane + 64] = sv[5]; dtb[lane] = sv[6]; dtb[lane + 64] = sv[7]; }
        __syncthreads();
        const bf16* hf = (const bf16*)(P.ws + A_HS) + ((size_t)(((b * 2 + 0) * 64 + c) * 16 + head)) * 8192;
        const bf16* hb = (const bf16*)(P.ws + A_HS) + ((size_t)(((b * 2 + 1) * 64 + (63 - c)) * 16 + head)) * 8192;
        const float dskip = sd[head], afl = af[l], abl = ab[l];
        f32x16 acc0 = zero16(), acc1 = zero16();
        acc0 = mma_ks<8>(acc0, [&](int ks) { return *(const bf16x8*)(hf + (0 * 8 + ks) * 512 + lane * 8); }, [&](int ks) { return frag_l_perm(Cl, SSD_LDB, 32 * lt, 16 * ks, lane); });
        acc1 = mma_ks<8>(acc1, [&](int ks) { return *(const bf16x8*)(hf + (1 * 8 + ks) * 512 + lane * 8); }, [&](int ks) { return frag_l_perm(Cl, SSD_LDB, 32 * lt, 16 * ks, lane); });
        { const float e = __expf(afl);
#pragma unroll
          for (int i = 0; i < 16; ++i) { acc0[i] *= e; acc1[i] *= e; } }
        { f32x16 t0 = zero16(), t1 = zero16();
          t0 = mma_ks<8>(t0, [&](int ks) { return *(const bf16x8*)(hb + (0 * 8 + ks) * 512 + lane * 8); }, [&](int ks) { return frag_l_perm(Cl, SSD_LDB, 32 * lt, 16 * ks, lane); });
          t1 = mma_ks<8>(t1, [&](int ks) { return *(const bf16x8*)(hb + (1 * 8 + ks) * 512 + lane * 8); }, [&](int ks) { return frag_l_perm(Cl, SSD_LDB, 32 * lt, 16 * ks, lane); });
          const float e = __expf(abl);
#pragma unroll
          for (int i = 0; i < 16; ++i) { acc0[i] += t0[i] * e; acc1[i] += t1[i] * e; } }
        if (r < 3) SO_PF(r + 1);
#pragma unroll 1
        for (int kh = 0; kh < 2; ++kh) {
            bf16x8 xx0[4], xx1[4], grw[4];
#pragma unroll
            for (int k4 = 0; k4 < 4; ++k4) { const int ks = 4 * kh + k4, s0 = 16 * ks + 8 * h5; xx0[k4] = frag_tr(Xl, SSD_LDB, 16 * ks, hq * 64, lane); xx1[k4] = frag_tr(Xl, SSD_LDB, 16 * ks, hq * 64 + 32, lane); grw[k4] = *(const LAS bf16x8*)(Gl + l * SSD_LDB + s0); }
#pragma unroll
            for (int k4 = 0; k4 < 4; ++k4) { const int ks = 4 * kh + k4, s0 = 16 * ks + 8 * h5; float f[8];
                f32x4 afs[2], abs_[2], dfs[2], dbs[2];
#pragma unroll
                for (int q = 0; q < 2; ++q) { afs[q] = *(const LAS f32x4*)(af + s0 + 4 * q); abs_[q] = *(const LAS f32x4*)(ab + s0 + 4 * q); dfs[q] = *(const LAS f32x4*)(dtf + s0 + 4 * q); dbs[q] = *(const LAS f32x4*)(dtb + s0 + 4 * q); }
#pragma unroll
                for (int j = 0; j < 8; ++j) { const int s = s0 + j; const float gv = bf2f((unsigned short)grw[k4][j]);
                    const float afv = afs[j >> 2][j & 3], abv = abs_[j >> 2][j & 3], dfv = dfs[j >> 2][j & 3], dbv = dbs[j >> 2][j & 3];
                    const float e = __expf(s < l ? afl - afv : abl - abv);
                    const float w = s < l ? e * dfv : (s > l ? e * dbv : dfv + dbv);
                    f[j] = gv * w + (s == l ? dskip : 0.f); }
                const u32x4 pk = pack8(f); const bf16x8 mf = __builtin_bit_cast(bf16x8, pk);
                acc0 = MFMA32(xx0[k4], mf, acc0); acc1 = MFMA32(xx1[k4], mf, acc1); } }
        { LAS bf16* o = Yst + l31 * 72 + 4 * h5;
#pragma unroll
          for (int qd = 0; qd < 4; ++qd) { u32x2 w; w.x = pk2(acc0[4 * qd], acc0[4 * qd + 1]); w.y = pk2(acc0[4 * qd + 2], acc0[4 * qd + 3]); *(LAS u32x2*)(o + 8 * qd) = w;
              w.x = pk2(acc1[4 * qd], acc1[4 * qd + 1]); w.y = pk2(acc1[4 * qd + 2], acc1[4 * qd + 3]); *(LAS u32x2*)(o + 32 + 8 * qd) = w; } }
        u32x4 zr[4];
#pragma unroll
        for (int k = 0; k < 4; ++k) { const int it = lane + 64 * k, tl = it >> 3, cg = it & 7; zr[k] = *(const u32x4*)(cols + (m0 + 32 * lt + tl) * NCB + C_SZ + head * 64 + 8 * cg); }
        LDS_WAIT();
#pragma unroll
        for (int k = 0; k < 4; ++k) { const int it = lane + 64 * k, tl = it >> 3, cg = it & 7; const size_t m = m0 + 32 * lt + tl;
            float y[8], z[8]; unpack8(*(const LAS u32x4*)(Yst + tl * 72 + 8 * cg), y); unpack8(zr[k], z);
            float ss = 0.f;
#pragma unroll
            for (int j = 0; j < 8; ++j) { y[j] *= siluf_(z[j]); ss += y[j] * y[j]; }
            ss += __shfl_xor(ss, 1); ss += __shfl_xor(ss, 2); ss += __shfl_xor(ss, 4);
            if (cg == 0) sumsq[(r * 2 + hq) * 128 + 32 * lt + tl] = ss;
            *(u32x4*)(ymix + m * 2048 + 1024 + head * 64 + 8 * cg) = pack8(y); }
        LDS_WAIT();
    }
#undef SO_PF
    __syncthreads();
    { u32x4 yv[4][4];
#pragma unroll
      for (int r = 0; r < 4; ++r) { const int head = g * 8 + r * 2 + hq;
#pragma unroll
          for (int k = 0; k < 4; ++k) { const int it = lane + 64 * k, tl = it >> 3, cg = it & 7; yv[r][k] = *(const u32x4*)(ymix + (m0 + 32 * lt + tl) * 2048 + 1024 + head * 64 + 8 * cg); } }
      float rs4[4];
#pragma unroll
      for (int k = 0; k < 4; ++k) { const int it = lane + 64 * k, tl = it >> 3; float sq = 0.f;
#pragma unroll
          for (int q8 = 0; q8 < 8; ++q8) sq += sumsq[q8 * 128 + 32 * lt + tl];
          rs4[k] = rsqrtf(sq * (1.f / 512.f) + 1e-5f); }
#pragma unroll
      for (int r = 0; r < 4; ++r) { const int head = g * 8 + r * 2 + hq; const int cg = lane & 7;
          const f32x4 w0 = *(const f32x4*)(snorm + head * 64 + 8 * cg), w1 = *(const f32x4*)(snorm + head * 64 + 8 * cg + 4);
#pragma unroll
          for (int k = 0; k < 4; ++k) { const int it = lane + 64 * k, tl = it >> 3; float y[8]; unpack8(yv[r][k], y);
#pragma unroll
              for (int j = 0; j < 8; ++j) y[j] = y[j] * rs4[k] * (j < 4 ? w0[j] : w1[j - 4]);
              *(u32x4*)(ymix + (m0 + 32 * lt + tl) * 2048 + 1024 + head * 64 + 8 * cg) = pack8(y); } } }
}

__device__ __forceinline__ void st_tile_tm(LAS bf16* M, int row, int col0, const f32x16& a, int h5, float sgn) {
#pragma unroll
    for (int qd = 0; qd < 4; ++qd) { u32x2 w; w.x = pk2(sgn * a[4 * qd], sgn * a[4 * qd + 1]); w.y = pk2(sgn * a[4 * qd + 2], sgn * a[4 * qd + 3]); *(LAS u32x2*)(M + row * 72 + col0 + 8 * qd + 4 * h5) = w; }
}
__device__ __forceinline__ f32x16 mm_tile(const LAS bf16* A, const LAS bf16* B, int it, int jt, int lane, f32x16 acc) {
    return mma_ks<4>(acc, [&](int ks) { return frag_tr(B, 72, 16 * ks, 32 * jt, lane); }, [&](int ks) { return frag_l(A, 72, 32 * it, 16 * ks, lane); });
}
__device__ __forceinline__ f32x16 ld_tile_tm(const LAS bf16* M, int row, int col0, int h5) {
    f32x16 a;
#pragma unroll
    for (int qd = 0; qd < 4; ++qd) { const u32x2 w = *(const LAS u32x2*)(M + row * 72 + col0 + 8 * qd + 4 * h5); a[4 * qd] = bflo(w.x); a[4 * qd + 1] = bfhi(w.x); a[4 * qd + 2] = bflo(w.y); a[4 * qd + 3] = bfhi(w.y); }
    return a;
}
template <class Fin, class Extra>
__device__ __forceinline__ void nilp_inverse(const LAS bf16* L, LAS bf16* Sb0, LAS bf16* Sb1, LAS bf16* Tb0, LAS bf16* Tb1, int wave, int lane, const Fin& fin, const Extra& extra) {
    const int it = (wave >> 1) & 1, jt = wave & 1, h5 = lane >> 5, row = 32 * it + (lane & 31);
    LAS bf16* Sb[2] = {Sb0, Sb1}; LAS bf16* Tb[2] = {Tb0, Tb1};
    if (wave < 4) st_tile_tm(Sb[1], row, 32 * jt, mm_tile(L, L, it, jt, lane, zero16()), h5, 1.f);
    else { f32x16 a = ld_tile_tm(L, row, 32 * jt, h5);
#pragma unroll
        for (int r = 0; r < 16; ++r) { const int j = 32 * jt + 8 * (r >> 2) + 4 * h5 + (r & 3); a[r] = (j == row ? 1.f : 0.f) - a[r]; }
        st_tile_tm(Tb[1], row, 32 * jt, a, h5, 1.f); }
    __syncthreads();
#pragma unroll
    for (int k = 1; k <= 5; ++k) {
        if (wave < 4) { const f32x16 acc = mm_tile(Tb[k & 1], Sb[k & 1], it, jt, lane, ld_tile_tm(Tb[k & 1], row, 32 * jt, h5));
            if (k < 5) st_tile_tm(Tb[(k + 1) & 1], row, 32 * jt, acc, h5, 1.f); else fin(acc, it, jt); }
        else { if (k < 5) st_tile_tm(Sb[(k + 1) & 1], row, 32 * jt, mm_tile(Sb[k & 1], Sb[k & 1], it, jt, lane, zero16()), h5, 1.f); else extra(); }
        __syncthreads();
    }
}
__device__ __forceinline__ void st_acc(bf16* tile, const f32x16& a, int lane) {
    u32x4 w0, w1; w0.x = pk2(a[0], a[1]); w0.y = pk2(a[2], a[3]); w0.z = pk2(a[4], a[5]); w0.w = pk2(a[6], a[7]); w1.x = pk2(a[8], a[9]); w1.y = pk2(a[10], a[11]); w1.z = pk2(a[12], a[13]); w1.w = pk2(a[14], a[15]);
    *(u32x4*)(tile + lane * 16) = w0; *(u32x4*)(tile + lane * 16 + 8) = w1; }
__device__ __forceinline__ void ld_acc_add(const bf16* tile, f32x16& a, int lane) {
    float f[8]; unpack8(*(const u32x4*)(tile + lane * 16), f);
#pragma unroll
    for (int j = 0; j < 8; ++j) a[j] += f[j];
    unpack8(*(const u32x4*)(tile + lane * 16 + 8), f);
#pragma unroll
    for (int j = 0; j < 8; ++j) a[8 + j] += f[j]; }
__device__ __forceinline__ void st_frag2(bf16* f0  , const f32x16& a, int lane) {
    u32x4 w0, w1; w0.x = pk2(a[0], a[1]); w0.y = pk2(a[2], a[3]); w0.z = pk2(a[4], a[5]); w0.w = pk2(a[6], a[7]); w1.x = pk2(a[8], a[9]); w1.y = pk2(a[10], a[11]); w1.z = pk2(a[12], a[13]); w1.w = pk2(a[14], a[15]);
    *(u32x4*)(f0 + lane * 8) = w0; *(u32x4*)(f0 + 512 + lane * 8) = w1; }
constexpr int GL_KN = 0, GL_QN = 17408, GL_V = 34816, GL_QK = 52224, GL_TU = 61440, GL_TW = 70656, GL_LF = 79872, GL_UT = 79872, GL_UST = 98304, GL_WT = 116736, GL_WST = 135168, GL_SC = 153600;
struct GdnRaw { u32x4 q[2], k[2], v[2]; float g, bt; };
__device__ __forceinline__ void gdn_a_load(const Params& P, int u, int tid, GdnRaw& r) {
    const int head = (u >> 1) & 3, c = (u >> 3) & 127, b = u >> 10; const size_t m0 = (size_t)b * SEQ + c * 64; const bf16* gq = (const bf16*)(P.ws + A_GQKV);
#pragma unroll
    for (int k = 0; k < 2; ++k) { const int i = tid + k * NTHR, row = i >> 4, ch = i & 15; const bf16* src = gq + (m0 + row) * 1536 + head * 128 + ch * 8;
        r.q[k] = *(const u32x4*)src; r.k[k] = *(const u32x4*)(src + 512); r.v[k] = *(const u32x4*)(src + 1024); }
    r.g = 0.f; r.bt = 0.f;
    if (tid < 64) { const float* gsc = (const float*)(P.ws + A_GSC); const int dir = u & 1; r.g = gsc[(m0 + tid) * 16 + 8 + dir * 4 + head]; r.bt = gsc[(m0 + tid) * 16 + dir * 4 + head]; }
}
__device__ __forceinline__ void gdn_a_unit(Frame& F, const Params& P, int u, int tid, int lane, const GdnRaw& raw, int u_next, GdnRaw& raw_next) {
    const int dir = u & 1, head = (u >> 1) & 3, c = (u >> 3) & 127, b = u >> 10, wave = F.wave, h5 = lane >> 5, l31 = lane & 31; const size_t m0 = (size_t)b * SEQ + c * 64;
    const int uu = ((b * 2 + dir) * 128 + (dir ? 127 - c : c)) * 4 + head;
    const bf16* gq = (const bf16*)(P.ws + A_GQKV); const float* gsc = (const float*)(P.ws + A_GSC);
    LAS bf16* Kn = (LAS bf16*)(F.lds + GL_KN); LAS bf16* Qn = (LAS bf16*)(F.lds + GL_QN); LAS bf16* Vv = (LAS bf16*)(F.lds + GL_V); LAS bf16* QK = (LAS bf16*)(F.lds + GL_QK);
    LAS bf16* Tu = (LAS bf16*)(F.lds + GL_TU); LAS bf16* Tw = (LAS bf16*)(F.lds + GL_TW); LAS bf16* Lb = (LAS bf16*)(F.lds + GL_LF);
    LAS bf16* Ut = (LAS bf16*)(F.lds + GL_UT); LAS bf16* Ust = (LAS bf16*)(F.lds + GL_UST); LAS bf16* Wt = (LAS bf16*)(F.lds + GL_WT); LAS bf16* Wst = (LAS bf16*)(F.lds + GL_WST);
    LAS float* GC = (LAS float*)(F.lds + GL_SC); LAS float* BT = GC + 64; LAS float* EG = GC + 128; LAS float* SV = GC + 192;
    __syncthreads();
#pragma unroll
    for (int k = 0; k < 2; ++k) { const int i = tid + k * NTHR, row = i >> 4, ch = i & 15;
        *(LAS u32x4*)(Qn + row * 136 + ch * 8) = raw.q[k]; *(LAS u32x4*)(Kn + row * 136 + ch * 8) = raw.k[k]; *(LAS u32x4*)(Vv + row * 136 + ch * 8) = raw.v[k]; }
    if (u_next < 2048) gdn_a_load(P, u_next, tid, raw_next);
    if (wave == 0) { const float g = raw.g, bt = raw.bt;
        const float gc = dir ? scan_incl_rev(g, lane) : scan_incl(g, lane), tot = __shfl(gc, dir ? 0 : 63);
        GC[lane] = gc; BT[lane] = bt; EG[lane] = __expf(gc); SV[lane] = __expf(tot - gc);
        if (lane == 0) ((float*)(P.ws + A_GD))[uu] = __expf(tot); }
    __syncthreads();
    { const int kind = wave >> 2, it = (wave >> 1) & 1, jt = wave & 1; f32x16 acc = zero16();
      acc = mma_ks<8>(acc, [&](int ks) { return frag_l(Kn, 136, 32 * jt, 16 * ks, lane); }, [&](int ks) { return frag_l(kind ? Qn : Kn, 136, 32 * it, 16 * ks, lane); });
      const int i = 32 * it + l31; const float gci = GC[i], bi = BT[i];
#pragma unroll
      for (int qd = 0; qd < 4; ++qd) { const int j0 = 32 * jt + 8 * qd + 4 * h5; float v[4];
#pragma unroll
          for (int r = 0; r < 4; ++r) { const int j = j0 + r; const bool before = dir ? (j > i) : (j < i); const float e = __expf(fminf(gci - GC[j], 0.f));
              v[r] = kind == 0 ? (before ? bi * acc[4 * qd + r] * e : 0.f) : ((before || j == i) ? acc[4 * qd + r] * e : 0.f); }
          { u32x2 w; w.x = pk2(v[0], v[1]); w.y = pk2(v[2], v[3]); *(LAS u32x2*)((kind == 0 ? Lb : QK) + i * 72 + j0) = w; } } }
    __syncthreads();
    nilp_inverse(Lb, (LAS bf16*)(F.lds + GL_UST), (LAS bf16*)(F.lds + GL_UST + 9216), (LAS bf16*)(F.lds + GL_WT), (LAS bf16*)(F.lds + GL_WT + 9216), wave, lane,
        [&](const f32x16& acc, int it, int jt) { const int row = 32 * it + l31;
#pragma unroll
            for (int qd = 0; qd < 4; ++qd) { const int j0 = 32 * jt + 8 * qd + 4 * h5; const f32x4 bt = *(const LAS f32x4*)(BT + j0), eg = *(const LAS f32x4*)(EG + j0); u32x2 w;
                w.x = pk2(acc[4 * qd] * bt[0], acc[4 * qd + 1] * bt[1]); w.y = pk2(acc[4 * qd + 2] * bt[2], acc[4 * qd + 3] * bt[3]); *(LAS u32x2*)(Tu + row * 72 + j0) = w;
                w.x = pk2(acc[4 * qd] * bt[0] * eg[0], acc[4 * qd + 1] * bt[1] * eg[1]); w.y = pk2(acc[4 * qd + 2] * bt[2] * eg[2], acc[4 * qd + 3] * bt[3] * eg[3]); *(LAS u32x2*)(Tw + row * 72 + j0) = w; } },
        [&]() {});
    { const int it = wave >> 2, et = wave & 3;
#pragma unroll
      for (int k2 = 0; k2 < 2; ++k2) { f32x16 acc = zero16(); const LAS bf16* Tm = k2 ? Tw : Tu; const LAS bf16* Src = k2 ? Kn : Vv; LAS bf16* O1 = k2 ? Wt : Ut; LAS bf16* O2 = k2 ? Wst : Ust;
        acc = mma_ks<4>(acc, [&](int ks) { return frag_l(Tm, 72, 32 * it, 16 * ks, lane); }, [&](int ks) { return frag_tr(Src, 136, 16 * ks, 32 * et, lane); });
#pragma unroll
        for (int qd = 0; qd < 4; ++qd) { const int i0 = 32 * it + 8 * qd + 4 * h5; const f32x4 sv = *(const LAS f32x4*)(SV + i0); u32x2 w;
            w.x = pk2(acc[4 * qd], acc[4 * qd + 1]); w.y = pk2(acc[4 * qd + 2], acc[4 * qd + 3]); *(LAS u32x2*)(O1 + (32 * et + l31) * 72 + i0) = w;
            w.x = pk2(acc[4 * qd] * sv[0], acc[4 * qd + 1] * sv[1]); w.y = pk2(acc[4 * qd + 2] * sv[2], acc[4 * qd + 3] * sv[3]); *(LAS u32x2*)(O2 + (32 * et + l31) * 72 + i0) = w; } } }
    __syncthreads();
    { bf16* gpsi = (bf16*)(P.ws + A_GPSI) + (size_t)uu * 16384; bf16* glam = (bf16*)(P.ws + A_GLAM) + (size_t)uu * 16384; bf16* gqt = (bf16*)(P.ws + A_GQT) + (size_t)uu * 8192; bf16* go0 = (bf16*)(P.ws + A_GO0) + (size_t)uu * 8192;
      const int dt = wave & 3, hi2 = wave >> 2;
#pragma unroll
      for (int k2 = 0; k2 < 2; ++k2) { const int et = 2 * hi2 + k2; f32x16 acc = zero16();
        acc = mma_ks<4>(acc, [&](int ks) { return frag_tr(Kn, 136, 16 * ks, 32 * dt, lane); }, [&](int ks) { return frag_l(Ust, 72, 32 * et, 16 * ks, lane); });
        st_acc(gpsi + (dt * 4 + et) * 1024, acc, lane); }
#pragma unroll
      for (int k2 = 0; k2 < 2; ++k2) { const int dpt = 2 * hi2 + k2; f32x16 acc = zero16();
        acc = mma_ks<4>(acc, [&](int ks) { return frag_l(Wst, 72, 32 * dpt, 16 * ks, lane); }, [&](int ks) { return frag_tr(Kn, 136, 16 * ks, 32 * dt, lane); });
#pragma unroll
        for (int r = 0; r < 16; ++r) acc[r] = -acc[r];
        st_frag2(glam + (dt * 8 + 2 * dpt) * 512, acc, lane); }
      { const int it = hi2, dpt = dt; f32x16 acc = zero16();
        acc = mma_ks<4>(acc, [&](int ks) { return frag_l(Wt, 72, 32 * dpt, 16 * ks, lane); }, [&](int ks) { return frag_l(QK, 72, 32 * it, 16 * ks, lane); });
        const int i = 32 * it + l31; const float eg = EG[i];
#pragma unroll
        for (int qd = 0; qd < 4; ++qd) { const u32x2 qw = *(const LAS u32x2*)(Qn + i * 136 + 32 * dpt + 8 * qd + 4 * h5);
            acc[4 * qd] = eg * bflo(qw.x) - acc[4 * qd]; acc[4 * qd + 1] = eg * bfhi(qw.x) - acc[4 * qd + 1]; acc[4 * qd + 2] = eg * bflo(qw.y) - acc[4 * qd + 2]; acc[4 * qd + 3] = eg * bfhi(qw.y) - acc[4 * qd + 3]; }
        st_frag2(gqt + (it * 8 + 2 * dpt) * 512, acc, lane); }
      { const int it = hi2, et = dt; f32x16 acc = zero16();
        acc = mma_ks<4>(acc, [&](int ks) { return frag_l(Ut, 72, 32 * et, 16 * ks, lane); }, [&](int ks) { return frag_l(QK, 72, 32 * it, 16 * ks, lane); });
        st_acc(go0 + (et * 2 + it) * 1024, acc, lane); } }
}
__device__ __forceinline__ void phase_gdn_a(Frame& F, const Params& P) {
    int lane = F.lane; asm volatile("" : "+v"(lane)); int tid = F.tid; asm volatile("" : "+v"(tid));
    GdnRaw A, B; int u = F.vcu; if (u >= 2048) return;
    gdn_a_load(P, u, tid, A);
    for (;;) { gdn_a_unit(F, P, u, tid, lane, A, u + F.G, B); u += F.G; if (u >= 2048) break;
               gdn_a_unit(F, P, u, tid, lane, B, u + F.G, A); u += F.G; if (u >= 2048) break; }
}
struct GdnScanOps { bf16x8 lam[8]; u32x4 ps0, ps1; float d; };
__device__ __forceinline__ void gdn_scan_unit(Frame& F, const Params& P, int unit, int lane) {
    const int eq = unit & 3, chain = unit >> 2, wave = F.wave, dt = wave & 3, et = eq, bd = chain >> 2, head = chain & 3;
    LAS bf16* Hf = (LAS bf16*)(F.lds);
    __syncthreads();
    if (wave >= 4) {
        const bf16* glam_ = (const bf16*)(P.ws + A_GLAM); const bf16* gpsi_ = (const bf16*)(P.ws + A_GPSI); const int w4 = wave - 4;
        u32x4 pa[4], pb[4];
#pragma unroll
        for (int j = 0; j < 4; ++j) { pa[j] = (u32x4){0u, 0u, 0u, 0u}; pb[j] = pa[j]; }
#define GS_PF(cqx, J) do { const size_t un_ = (size_t)(bd * 128 + ((cqx) < 128 ? (cqx) : 127)) * 4 + head; \
            pa[J] = *(const u32x4*)(glam_ + un_ * 16384 + (eq * 8 + 2 * w4) * 512 + lane * 16); pb[J] = *(const u32x4*)(gpsi_ + un_ * 16384 + (w4 * 4 + et) * 1024 + lane * 16); } while (0)
#pragma unroll 1
        for (int cq = 0; cq < 128; cq += 4) {
#pragma unroll
            for (int j = 0; j < 4; ++j) { asm volatile("" :: "v"(pa[j]), "v"(pb[j])); GS_PF(cq + j + 5, j);
                asm volatile("s_waitcnt lgkmcnt(0)" ::: "memory"); __builtin_amdgcn_s_barrier(); } }
#pragma unroll
        for (int j = 0; j < 4; ++j) asm volatile("" :: "v"(pa[j]), "v"(pb[j]));
#undef GS_PF
        return; }
    f32x16 Hm = zero16();
    const bf16* gpsi = (const bf16*)(P.ws + A_GPSI); const bf16* glam = (const bf16*)(P.ws + A_GLAM); bf16* gh = (bf16*)(P.ws + A_GH); const float* gd = (const float*)(P.ws + A_GD);
#define GS_LOAD(S, cqx) do { const size_t un_ = (size_t)(bd * 128 + ((cqx) < 128 ? (cqx) : 127)) * 4 + head; \
        _Pragma("unroll") for (int ks = 0; ks < 8; ++ks) S.lam[ks] = *(const bf16x8*)(glam + un_ * 16384 + (dt * 8 + ks) * 512 + lane * 8); \
        S.ps0 = *(const u32x4*)(gpsi + un_ * 16384 + (dt * 4 + et) * 1024 + lane * 16); S.ps1 = *(const u32x4*)(gpsi + un_ * 16384 + (dt * 4 + et) * 1024 + lane * 16 + 8); S.d = gd[un_]; } while (0)
#define GS_STEP(CUR, NXT, cqx) do { const size_t uu_ = (size_t)(bd * 128 + (cqx)) * 4 + head; const int par_ = (cqx) & 1; \
        { u32x4 w0, w1; w0.x = pk2(Hm[0], Hm[1]); w0.y = pk2(Hm[2], Hm[3]); w0.z = pk2(Hm[4], Hm[5]); w0.w = pk2(Hm[6], Hm[7]); w1.x = pk2(Hm[8], Hm[9]); w1.y = pk2(Hm[10], Hm[11]); w1.z = pk2(Hm[12], Hm[13]); w1.w = pk2(Hm[14], Hm[15]); \
          LAS bf16* lf = Hf + (par_ * 8 + 2 * dt) * 512 + lane * 8; *(LAS u32x4*)lf = w0; *(LAS u32x4*)(lf + 512) = w1; \
          bf16* gf = gh + uu_ * 16384 + (et * 8 + 2 * dt) * 512 + lane * 8; *(u32x4*)gf = w0; *(u32x4*)(gf + 512) = w1; } \
        GS_LOAD(NXT, (cqx) + 3); \
        asm volatile("s_waitcnt lgkmcnt(0)" ::: "memory"); __builtin_amdgcn_s_barrier(); asm volatile("" ::: "memory"); \
        bf16x8 hv[8]; const LAS bf16* hb = Hf + (par_ * 8) * 512 + lane * 8; \
        _Pragma("unroll") for (int ks = 0; ks < 8; ++ks) hv[ks] = *(const LAS bf16x8*)(hb + ks * 512); \
        f32x16 acc; { float f[8]; unpack8(CUR.ps0, f); _Pragma("unroll") for (int j = 0; j < 8; ++j) acc[j] = CUR.d * Hm[j] + f[j]; \
          unpack8(CUR.ps1, f); _Pragma("unroll") for (int j = 0; j < 8; ++j) acc[8 + j] = CUR.d * Hm[8 + j] + f[j]; } \
        asm volatile("s_waitcnt lgkmcnt(0)" ::: "memory"); __builtin_amdgcn_sched_barrier(0); \
        f32x16 acc2 = zero16();     \
        _Pragma("unroll") for (int ks = 0; ks < 8; ks += 2) { acc = MFMA32(CUR.lam[ks], hv[ks], acc); acc2 = MFMA32(CUR.lam[ks + 1], hv[ks + 1], acc2); } \
        _Pragma("unroll") for (int j = 0; j < 16; ++j) acc[j] += acc2[j]; \
        Hm = acc; } while (0)
    GdnScanOps A, B, C, D;
    GS_LOAD(A, 0); GS_LOAD(B, 1); GS_LOAD(C, 2);
#pragma unroll 1
    for (int cq = 0; cq < 128; cq += 4) { GS_STEP(A, D, cq); GS_STEP(B, A, cq + 1); GS_STEP(C, B, cq + 2); GS_STEP(D, C, cq + 3); }
#undef GS_LOAD
#undef GS_STEP
}
__device__ __forceinline__ void gdn_out_wave(Frame& F, const Params& P, int l_, int u, int lane) {
    const int it = u & 1, head = (u >> 1) & 3, c = (u >> 3) & 127, b = u >> 10, h5 = lane >> 5, l31 = lane & 31; const size_t m0 = (size_t)b * SEQ + c * 64 + 32 * it;
    const bf16* gh = (const bf16*)(P.ws + A_GH); const bf16* gqt = (const bf16*)(P.ws + A_GQT); const bf16* go0 = (const bf16*)(P.ws + A_GO0);
    const bf16* cols = (const bf16*)(P.ws + A_COLS); bf16* ymix = (bf16*)(P.ws + A_YMIX); const float* gnorm = P.in[I_GDN_NORM] + (size_t)l_ * 128;
    LAS float* Ost = (LAS float*)(F.lds + F.wave * 17408);
    const size_t uf = (size_t)((b * 2 + 0) * 128 + c) * 4 + head, ub = (size_t)((b * 2 + 1) * 128 + (127 - c)) * 4 + head;
    u32x4 zr[8];
#pragma unroll
    for (int pass = 0; pass < 8; ++pass) zr[pass] = *(const u32x4*)(cols + (m0 + pass * 4 + (lane >> 4)) * NCB + C_GZ + head * 128 + 8 * (lane & 15));
    const f32x4 w0 = *(const f32x4*)(gnorm + 8 * (lane & 15)), w1 = *(const f32x4*)(gnorm + 8 * (lane & 15) + 4);
    f32x16 acc[4];
#pragma unroll
    for (int et = 0; et < 4; ++et) { acc[et] = zero16(); ld_acc_add(go0 + uf * 8192 + (et * 2 + it) * 1024, acc[et], lane); ld_acc_add(go0 + ub * 8192 + (et * 2 + it) * 1024, acc[et], lane); }
    bf16x8 nq[2], nh[2][4];
#define GO_LD(ks_) do { nq[0] = *(const bf16x8*)(gqt + uf * 8192 + (it * 8 + (ks_)) * 512 + lane * 8); nq[1] = *(const bf16x8*)(gqt + ub * 8192 + (it * 8 + (ks_)) * 512 + lane * 8); \
        _Pragma("unroll") for (int et = 0; et < 4; ++et) { nh[0][et] = *(const bf16x8*)(gh + uf * 16384 + (et * 8 + (ks_)) * 512 + lane * 8); nh[1][et] = *(const bf16x8*)(gh + ub * 16384 + (et * 8 + (ks_)) * 512 + lane * 8); } } while (0)
    GO_LD(0);
#pragma unroll 1
    for (int ks = 0; ks < 8; ++ks) { const bf16x8 cq0 = nq[0], cq1 = nq[1]; bf16x8 ch0[4], ch1[4];
#pragma unroll
        for (int et = 0; et < 4; ++et) { ch0[et] = nh[0][et]; ch1[et] = nh[1][et]; }
        if (ks < 7) GO_LD(ks + 1);
#pragma unroll
        for (int et = 0; et < 4; ++et) { acc[et] = MFMA32(ch0[et], cq0, acc[et]); acc[et] = MFMA32(ch1[et], cq1, acc[et]); } }
#undef GO_LD
#pragma unroll
    for (int et = 0; et < 4; ++et) {
#pragma unroll
        for (int qd = 0; qd < 4; ++qd) *(LAS f32x4*)(Ost + l31 * 132 + 32 * et + 8 * qd + 4 * h5) = (f32x4){acc[et][4 * qd], acc[et][4 * qd + 1], acc[et][4 * qd + 2], acc[et][4 * qd + 3]}; }
    LDS_WAIT();
#pragma unroll
    for (int pass = 0; pass < 8; ++pass) { const int tok = pass * 4 + (lane >> 4), e0 = 8 * (lane & 15); const size_t m = m0 + tok;
        const f32x4 a0 = *(const LAS f32x4*)(Ost + tok * 132 + e0), a1 = *(const LAS f32x4*)(Ost + tok * 132 + e0 + 4); float o[8] = {a0[0], a0[1], a0[2], a0[3], a1[0], a1[1], a1[2], a1[3]}, z[8];
        float ss = 0.f;
#pragma unroll
        for (int j = 0; j < 8; ++j) ss += o[j] * o[j];
        ss += __shfl_xor(ss, 1); ss += __shfl_xor(ss, 2); ss += __shfl_xor(ss, 4); ss += __shfl_xor(ss, 8);
        const float sc = rsqrtf(ss * (1.f / 128.f) + 1e-6f); unpack8(zr[pass], z);
#pragma unroll
        for (int j = 0; j < 8; ++j) o[j] = o[j] * sc * (j < 4 ? w0[j] : w1[j - 4]) * siluf_(z[j]);
        *(u32x4*)(ymix + m * 2048 + head * 128 + e0) = pack8(o); }
    LDS_WAIT();
}
__device__ __forceinline__ void phase_gdn_out(Frame& F, const Params& P, int l) {
    int lane = F.lane; asm volatile("" : "+v"(lane));
    for (int u = F.vcu * NWAVES + F.wave; u < 2048; u += F.G * NWAVES) gdn_out_wave(F, P, l, u, lane);
}

constexpr int RL_KAP = 0, RL_KH = 9216, RL_AH = 18432, RL_RHO = 27648, RL_V = 36864, RL_AKK = 46080, RL_BQK = 55296, RL_BQA = 64512, RL_T = 73728, RL_ZT = 82944, RL_NWT = 92160, RL_NU0T = 101376,
              RL_LF = 110592, RL_PART = 128000, RL_PC = 130048;
struct RwkvRaw { u32x4 a0, a1, a2, a3, a4; f32x4 l0, l1; };
__device__ __forceinline__ void rwkv_a_load(const Params& P, int u, int tid, RwkvRaw& r) {
    const int dir = u & 1, head = (u >> 1) & 7, c = (u >> 4) & 127, b = u >> 11; const size_t m0 = (size_t)b * SEQ + c * 64;
    const bf16* rkv = (const bf16*)(P.ws + A_RKV); const bf16* rkk = (const bf16*)(P.ws + A_RKK); const float* rlogw = (const float*)(P.ws + A_RLOGW); const bf16* rkdir = (const bf16*)(P.ws + A_RKDIR); const bf16* rkka = (const bf16*)(P.ws + A_RKKA);
    const int t = tid >> 3, col8 = head * 64 + 8 * (tid & 7); const size_t m = m0 + t;
    r.a0 = *(const u32x4*)(rkv + m * 1536 + col8); r.a1 = *(const u32x4*)(rkv + m * 1536 + 1024 + col8); r.a2 = *(const u32x4*)(rkk + m * 512 + col8);
    r.a3 = *(const u32x4*)(rkdir + m * 1024 + dir * 512 + col8); r.a4 = *(const u32x4*)(rkka + m * 1024 + dir * 512 + col8);
    const int t2 = tid >> 4, q4 = 4 * (tid & 15);
    r.l0 = *(const f32x4*)(rlogw + (m0 + t2) * 1024 + dir * 512 + head * 64 + q4); r.l1 = *(const f32x4*)(rlogw + (m0 + t2 + 32) * 1024 + dir * 512 + head * 64 + q4);
}
__device__ __forceinline__ void rwkv_a_unit(Frame& F, const Params& P, int u, int tid, int lane, const RwkvRaw& raw, int u_next, RwkvRaw& raw_next) {
    const int dir = u & 1, head = (u >> 1) & 7, c = (u >> 4) & 127, b = u >> 11, wave = F.wave, h5 = lane >> 5, l31 = lane & 31; const size_t m0 = (size_t)b * SEQ + c * 64;
    const size_t uu = (size_t)((b * 2 + dir) * 128 + (dir ? 127 - c : c)) * 8 + head;
    const bf16* rkv = (const bf16*)(P.ws + A_RKV); const bf16* rkk = (const bf16*)(P.ws + A_RKK); const float* rlogw = (const float*)(P.ws + A_RLOGW); const bf16* rkdir = (const bf16*)(P.ws + A_RKDIR); const bf16* rkka = (const bf16*)(P.ws + A_RKKA);
    LAS bf16* KAP = (LAS bf16*)(F.lds + RL_KAP); LAS bf16* KH = (LAS bf16*)(F.lds + RL_KH); LAS bf16* AH = (LAS bf16*)(F.lds + RL_AH); LAS bf16* RHO = (LAS bf16*)(F.lds + RL_RHO); LAS bf16* VV = (LAS bf16*)(F.lds + RL_V);
    LAS bf16* AKK = (LAS bf16*)(F.lds + RL_AKK); LAS bf16* BQK = (LAS bf16*)(F.lds + RL_BQK); LAS bf16* BQA = (LAS bf16*)(F.lds + RL_BQA); LAS bf16* Tm = (LAS bf16*)(F.lds + RL_T);
    LAS bf16* ZT = (LAS bf16*)(F.lds + RL_ZT); LAS bf16* NWT = (LAS bf16*)(F.lds + RL_NWT); LAS bf16* NU0T = (LAS bf16*)(F.lds + RL_NU0T); LAS bf16* Lb = (LAS bf16*)(F.lds + RL_LF);
    LAS float* PART = (LAS float*)(F.lds + RL_PART); LAS float* PC = (LAS float*)(F.lds + RL_PC);
    __syncthreads();
    LAS bf16* RAW = (LAS bf16*)(F.lds + RL_AKK); LAS float* RLW = (LAS float*)(F.lds + RL_AKK + 40960);
    { const int t = tid >> 3, q8 = 8 * (tid & 7); const int t2 = tid >> 4, q4 = 4 * (tid & 15);
      *(LAS u32x4*)(RAW + 0 * 4096 + t * 64 + q8) = raw.a0; *(LAS u32x4*)(RAW + 1 * 4096 + t * 64 + q8) = raw.a1; *(LAS u32x4*)(RAW + 2 * 4096 + t * 64 + q8) = raw.a2; *(LAS u32x4*)(RAW + 3 * 4096 + t * 64 + q8) = raw.a3; *(LAS u32x4*)(RAW + 4 * 4096 + t * 64 + q8) = raw.a4;
      *(LAS f32x4*)(RLW + t2 * 64 + q4) = raw.l0; *(LAS f32x4*)(RLW + (t2 + 32) * 64 + q4) = raw.l1; }
    if (u_next < 4096) rwkv_a_load(P, u_next, tid, raw_next);
    __syncthreads();
    { float lw[8], p[8];
#pragma unroll
      for (int j = 0; j < 8; ++j) lw[j] = RLW[(8 * wave + j) * 64 + lane];
      if (dir == 0) { float a = 0.f;
#pragma unroll
          for (int j = 0; j < 8; ++j) { a += lw[j]; p[j] = a; } PART[wave * 64 + lane] = a; }
      else { float a = 0.f;
#pragma unroll
          for (int j = 7; j >= 0; --j) { a += lw[j]; p[j] = a; } PART[wave * 64 + lane] = a; }
      __syncthreads();
      float off = 0.f, tot = 0.f;
#pragma unroll
      for (int w2 = 0; w2 < 8; ++w2) { const float t = PART[w2 * 64 + lane]; tot += t; if (dir == 0 ? (w2 < wave) : (w2 > wave)) off += t; }
      if (wave == 0) { const float pc = __expf(tot); PC[lane] = pc; ((float*)(P.ws + A_RPC))[uu * 64 + lane] = pc; }
#pragma unroll
      for (int j = 0; j < 8; ++j) { const int t = 8 * wave + j; const float lp = off + p[j], lpex = lp - lw[j];
          const float rr = bf2f(RAW[0 * 4096 + t * 64 + lane]), vv = bf2f(RAW[1 * 4096 + t * 64 + lane]), kk = bf2f(RAW[2 * 4096 + t * 64 + lane]), kd = bf2f(RAW[3 * 4096 + t * 64 + lane]), ka = bf2f(RAW[4 * 4096 + t * 64 + lane]);
          const float en = __expf(-lp);
          KAP[t * 72 + lane] = (bf16)f2bf(kk * __expf(lpex)); KH[t * 72 + lane] = (bf16)f2bf(kd * en); AH[t * 72 + lane] = (bf16)f2bf(ka * en); RHO[t * 72 + lane] = (bf16)f2bf(rr * __expf(lp)); VV[t * 72 + lane] = (bf16)f2bf(vv); } }
    __syncthreads();
    { const int mat = wave >> 1, tt = wave & 1; const LAS bf16* Xs = (mat == 0 || mat == 3) ? AH : KH; const LAS bf16* Ys = mat < 2 ? KAP : RHO; const int t = 32 * tt + l31;
#pragma unroll
      for (int st = 0; st < 2; ++st) { f32x16 acc = zero16();
        acc = mma_ks<4>(acc, [&](int ks) { return frag_l(Xs, 72, 32 * st, 16 * ks, lane); }, [&](int ks) { return frag_l(Ys, 72, 32 * tt, 16 * ks, lane); });
#pragma unroll
        for (int qd = 0; qd < 4; ++qd) { const int s0 = 32 * st + 8 * qd + 4 * h5; float v[4];
#pragma unroll
            for (int r = 0; r < 4; ++r) { const int sidx = s0 + r; const bool before = dir ? (sidx > t) : (sidx < t); v[r] = (before || (mat >= 2 && sidx == t)) ? acc[4 * qd + r] : 0.f; }
            { LAS bf16* O = mat == 0 ? Lb : (mat == 1 ? AKK : (mat == 2 ? BQK : BQA)); u32x2 w; w.x = pk2(v[0], v[1]); w.y = pk2(v[2], v[3]); *(LAS u32x2*)(O + t * 72 + s0) = w; } } } }
    __syncthreads();
    nilp_inverse(Lb, ZT, (LAS bf16*)(F.lds + RL_LF + 9216), NWT, NU0T, wave, lane,
        [&](const f32x16& acc, int it, int jt) { st_tile_tm(Tm, 32 * it + l31, 32 * jt, acc, h5, 1.f); },
        [&]() { const int tt = (wave >> 1) & 1, vt = wave & 1; f32x16 acc = zero16();
            acc = mma_ks<4>(acc, [&](int ks) { return frag_l(AKK, 72, 32 * tt, 16 * ks, lane); }, [&](int ks) { return frag_tr(VV, 72, 16 * ks, 32 * vt, lane); });
            st_tile_tm(ZT, 32 * vt + l31, 32 * tt, acc, h5, 1.f); });
    { const int which = wave >> 2, tt = (wave >> 1) & 1, ct = wave & 1; f32x16 acc = zero16();
      acc = mma_ks<4>(acc, [&](int ks) { return frag_l(Tm, 72, 32 * tt, 16 * ks, lane); }, [&](int ks) { return which ? frag_l(ZT, 72, 32 * ct, 16 * ks, lane) : frag_tr(KAP, 72, 16 * ks, 32 * ct, lane); });
      st_tile_tm(which ? NU0T : NWT, 32 * ct + l31, 32 * tt, acc, h5, -1.f); }
    __syncthreads();
    { bf16* gpsi = (bf16*)(P.ws + A_RPSI) + uu * 4096; bf16* glam = (bf16*)(P.ws + A_RLAM) + uu * 4096; bf16* grt = (bf16*)(P.ws + A_RRT) + uu * 4096; bf16* gy0 = (bf16*)(P.ws + A_RY0) + uu * 4096;
      const int a2 = (wave >> 1) & 1, b2 = wave & 1;
      if (wave < 4) {
        { const int tt = a2, ct = b2; f32x16 acc = zero16();
          acc = mma_ks<4>(acc, [&](int ks) { return frag_l(NWT, 72, 32 * ct, 16 * ks, lane); }, [&](int ks) { return frag_l(BQA, 72, 32 * tt, 16 * ks, lane); });
          const int t = 32 * tt + l31;
#pragma unroll
          for (int qd = 0; qd < 4; ++qd) { const u32x2 rw = *(const LAS u32x2*)(RHO + t * 72 + 32 * ct + 8 * qd + 4 * h5);
              acc[4 * qd] += bflo(rw.x); acc[4 * qd + 1] += bfhi(rw.x); acc[4 * qd + 2] += bflo(rw.y); acc[4 * qd + 3] += bfhi(rw.y); }
          st_frag2(grt + (tt * 4 + 2 * ct) * 512, acc, lane); }
        { const int tt = a2, vt = b2; f32x16 acc = zero16();
          acc = mma_ks<4>(acc, [&](int ks) { return frag_tr(VV, 72, 16 * ks, 32 * vt, lane); }, [&](int ks) { return frag_l(BQK, 72, 32 * tt, 16 * ks, lane); });
          acc = mma_ks<4>(acc, [&](int ks) { return frag_l(NU0T, 72, 32 * vt, 16 * ks, lane); }, [&](int ks) { return frag_l(BQA, 72, 32 * tt, 16 * ks, lane); });
          st_acc(gy0 + (vt * 2 + tt) * 1024, acc, lane); }
      } else {
        { const int ct = a2, cpt = b2; f32x16 acc = zero16();
          acc = mma_ks<4>(acc, [&](int ks) { return frag_l(NWT, 72, 32 * cpt, 16 * ks, lane); }, [&](int ks) { return frag_tr(AH, 72, 16 * ks, 32 * ct, lane); });
          const float pc = PC[32 * ct + l31];
#pragma unroll
          for (int r = 0; r < 16; ++r) acc[r] *= pc;
          st_frag2(glam + (ct * 4 + 2 * cpt) * 512, acc, lane); }
        { const int ct = a2, vt = b2; f32x16 acc = zero16();
          acc = mma_ks<4>(acc, [&](int ks) { return frag_tr(KH, 72, 16 * ks, 32 * ct, lane); }, [&](int ks) { return frag_tr(VV, 72, 16 * ks, 32 * vt, lane); });
          acc = mma_ks<4>(acc, [&](int ks) { return frag_tr(AH, 72, 16 * ks, 32 * ct, lane); }, [&](int ks) { return frag_l(NU0T, 72, 32 * vt, 16 * ks, lane); });
#pragma unroll
          for (int qd = 0; qd < 4; ++qd) { const f32x4 pc = *(const LAS f32x4*)(PC + 32 * ct + 8 * qd + 4 * h5);
#pragma unroll
              for (int r = 0; r < 4; ++r) acc[4 * qd + r] *= pc[r]; }
          st_acc(gpsi + (ct * 2 + vt) * 1024, acc, lane); }
      } }
}
__device__ __forceinline__ void phase_rwkv_a(Frame& F, const Params& P) {
    int lane = F.lane; asm volatile("" : "+v"(lane)); int tid = F.tid; asm volatile("" : "+v"(tid));
    RwkvRaw A, B; int u = F.vcu; if (u >= 4096) return;
    rwkv_a_load(P, u, tid, A);
    for (;;) { rwkv_a_unit(F, P, u, tid, lane, A, u + F.G, B); u += F.G; if (u >= 4096) break;
               rwkv_a_unit(F, P, u, tid, lane, B, u + F.G, A); u += F.G; if (u >= 4096) break; }
}
struct RwkvScanOps { bf16x8 lam[4]; u32x4 ps0, ps1; f32x4 pc[4]; };
__device__ __forceinline__ void rwkv_scan_unit(Frame& F, const Params& P, int unit, int lane) {
    const int wave = F.wave, chain = unit, ct = (wave >> 1) & 1, vt = wave & 1, bd = chain >> 3, head = chain & 7, h5 = lane >> 5;
    LAS bf16* Hf = (LAS bf16*)(F.lds);
    __syncthreads();
    if (wave >= 4) {
#pragma unroll 1
        for (int cq = 0; cq < 128; ++cq) { asm volatile("s_waitcnt lgkmcnt(0)" ::: "memory"); __builtin_amdgcn_s_barrier(); }
        return; }
    f32x16 Hm = zero16();
    const bf16* gpsi = (const bf16*)(P.ws + A_RPSI); const bf16* glam = (const bf16*)(P.ws + A_RLAM); bf16* gh = (bf16*)(P.ws + A_RH); const float* gpc = (const float*)(P.ws + A_RPC);
#define RS_LOAD(S, cqx) do { const size_t un_ = (size_t)(bd * 128 + ((cqx) < 128 ? (cqx) : 127)) * 8 + head; \
        _Pragma("unroll") for (int ks = 0; ks < 4; ++ks) S.lam[ks] = *(const bf16x8*)(glam + un_ * 4096 + (ct * 4 + ks) * 512 + lane * 8); \
        S.ps0 = *(const u32x4*)(gpsi + un_ * 4096 + (ct * 2 + vt) * 1024 + lane * 16); S.ps1 = *(const u32x4*)(gpsi + un_ * 4096 + (ct * 2 + vt) * 1024 + lane * 16 + 8); \
        _Pragma("unroll") for (int qd = 0; qd < 4; ++qd) S.pc[qd] = *(const f32x4*)(gpc + un_ * 64 + 32 * ct + 8 * qd + 4 * h5); } while (0)
#define RS_STEP(CUR, NXT, cqx) do { const size_t uu_ = (size_t)(bd * 128 + (cqx)) * 8 + head; const int par_ = (cqx) & 1; \
        { u32x4 w0, w1; w0.x = pk2(Hm[0], Hm[1]); w0.y = pk2(Hm[2], Hm[3]); w0.z = pk2(Hm[4], Hm[5]); w0.w = pk2(Hm[6], Hm[7]); w1.x = pk2(Hm[8], Hm[9]); w1.y = pk2(Hm[10], Hm[11]); w1.z = pk2(Hm[12], Hm[13]); w1.w = pk2(Hm[14], Hm[15]); \
          LAS bf16* lf = Hf + (((par_ * 2 + vt) * 4) + 2 * ct) * 512 + lane * 8; *(LAS u32x4*)lf = w0; *(LAS u32x4*)(lf + 512) = w1; \
          bf16* gf = gh + uu_ * 4096 + (vt * 4 + 2 * ct) * 512 + lane * 8; *(u32x4*)gf = w0; *(u32x4*)(gf + 512) = w1; } \
        RS_LOAD(NXT, (cqx) + 2); \
        asm volatile("s_waitcnt lgkmcnt(0)" ::: "memory"); __builtin_amdgcn_s_barrier(); asm volatile("" ::: "memory"); \
        bf16x8 hv[4]; const LAS bf16* hb = Hf + ((par_ * 2 + vt) * 4) * 512 + lane * 8; \
        _Pragma("unroll") for (int ks = 0; ks < 4; ++ks) hv[ks] = *(const LAS bf16x8*)(hb + ks * 512); \
        f32x16 acc; { float f[8]; unpack8(CUR.ps0, f); _Pragma("unroll") for (int j = 0; j < 4; ++j) { acc[j] = CUR.pc[0][j] * Hm[j] + f[j]; acc[4 + j] = CUR.pc[1][j] * Hm[4 + j] + f[4 + j]; } \
          unpack8(CUR.ps1, f); _Pragma("unroll") for (int j = 0; j < 4; ++j) { acc[8 + j] = CUR.pc[2][j] * Hm[8 + j] + f[j]; acc[12 + j] = CUR.pc[3][j] * Hm[12 + j] + f[4 + j]; } } \
        asm volatile("s_waitcnt lgkmcnt(0)" ::: "memory"); __builtin_amdgcn_sched_barrier(0); \
        _Pragma("unroll") for (int ks = 0; ks < 4; ++ks) acc = MFMA32(CUR.lam[ks], hv[ks], acc); \
        Hm = acc; } while (0)
    RwkvScanOps A, B, C;
    RS_LOAD(A, 0); RS_LOAD(B, 1);
#pragma unroll 1
    for (int cq = 0; cq < 126; cq += 3) { RS_STEP(A, C, cq); RS_STEP(B, A, cq + 1); RS_STEP(C, B, cq + 2); }
    RS_STEP(A, C, 126); RS_STEP(B, A, 127);
#undef RS_LOAD
#undef RS_STEP
}
__device__ __forceinline__ void rwkv_out_wave(Frame& F, const Params& P, int l_, int u, int lane) {
    const int head = u & 7, c = (u >> 3) & 127, b = u >> 10, h5 = lane >> 5, l31 = lane & 31; const size_t m0 = (size_t)b * SEQ + c * 64;
    const bf16* gh = (const bf16*)(P.ws + A_RH); const bf16* grt = (const bf16*)(P.ws + A_RRT); const bf16* gy0 = (const bf16*)(P.ws + A_RY0);
    const bf16* rkv = (const bf16*)(P.ws + A_RKV); const bf16* rkdir = (const bf16*)(P.ws + A_RKDIR); const bf16* rg = (const bf16*)(P.ws + A_RG); bf16* ymix = (bf16*)(P.ws + A_YMIX);
    const float* r_k = P.in[I_R_RK] + (size_t)l_ * 512; const float* lng = P.in[I_R_LNG] + (size_t)l_ * 512; const float* lnb = P.in[I_R_LNB] + (size_t)l_ * 512;
    LAS float* Yst = (LAS float*)(F.lds + F.wave * 17408);
    const size_t uf = (size_t)((b * 2 + 0) * 128 + c) * 8 + head, ub = (size_t)((b * 2 + 1) * 128 + (127 - c)) * 8 + head;
    bf16x8 hf[2][4], hb[2][4];
#pragma unroll
    for (int vt = 0; vt < 2; ++vt)
#pragma unroll
        for (int ks = 0; ks < 4; ++ks) { hf[vt][ks] = *(const bf16x8*)(gh + uf * 4096 + (vt * 4 + ks) * 512 + lane * 8); hb[vt][ks] = *(const bf16x8*)(gh + ub * 4096 + (vt * 4 + ks) * 512 + lane * 8); }
#pragma unroll
    for (int tt = 0; tt < 2; ++tt) { bf16x8 rf[4], rb[4];
#pragma unroll
        for (int ks = 0; ks < 4; ++ks) { rf[ks] = *(const bf16x8*)(grt + uf * 4096 + (tt * 4 + ks) * 512 + lane * 8); rb[ks] = *(const bf16x8*)(grt + ub * 4096 + (tt * 4 + ks) * 512 + lane * 8); }
#pragma unroll
        for (int vt = 0; vt < 2; ++vt) { f32x16 acc = zero16();
            ld_acc_add(gy0 + uf * 4096 + (vt * 2 + tt) * 1024, acc, lane); ld_acc_add(gy0 + ub * 4096 + (vt * 2 + tt) * 1024, acc, lane);
#pragma unroll
            for (int ks = 0; ks < 4; ++ks) { acc = MFMA32(hf[vt][ks], rf[ks], acc); acc = MFMA32(hb[vt][ks], rb[ks], acc); }
#pragma unroll
            for (int qd = 0; qd < 4; ++qd) *(LAS f32x4*)(Yst + (32 * tt + l31) * 68 + 32 * vt + 8 * qd + 4 * h5) = (f32x4){acc[4 * qd], acc[4 * qd + 1], acc[4 * qd + 2], acc[4 * qd + 3]}; } }
    const int v0 = 8 * (lane & 7), ch = head * 64 + v0;
    const f32x4 rk0 = *(const f32x4*)(r_k + ch), rk1 = *(const f32x4*)(r_k + ch + 4), g0 = *(const f32x4*)(lng + ch), g1 = *(const f32x4*)(lng + ch + 4), c0 = *(const f32x4*)(lnb + ch), c1 = *(const f32x4*)(lnb + ch + 4);
    u32x4 nr, nv, nk0, nk1, ng;
#define RO_LD(pass_) do { const size_t m_ = m0 + (pass_) * 8 + (lane >> 3); nr = *(const u32x4*)(rkv + m_ * 1536 + ch); nv = *(const u32x4*)(rkv + m_ * 1536 + 1024 + ch); \
        nk0 = *(const u32x4*)(rkdir + m_ * 1024 + ch); nk1 = *(const u32x4*)(rkdir + m_ * 1024 + 512 + ch); ng = *(const u32x4*)(rg + m_ * 512 + ch); } while (0)
    RO_LD(0);
    LDS_WAIT();
#pragma unroll 1
    for (int pass = 0; pass < 8; ++pass) { const int tok = pass * 8 + (lane >> 3); const size_t m = m0 + tok;
      const f32x4 a0 = *(const LAS f32x4*)(Yst + tok * 68 + v0), a1 = *(const LAS f32x4*)(Yst + tok * 68 + v0 + 4); float y[8] = {a0[0], a0[1], a0[2], a0[3], a1[0], a1[1], a1[2], a1[3]}, r[8], v[8], kd0[8], kd1[8], gg[8];
      unpack8(nr, r); unpack8(nv, v); unpack8(nk0, kd0); unpack8(nk1, kd1); unpack8(ng, gg);
      if (pass < 7) RO_LD(pass + 1);
      float sm = 0.f;
#pragma unroll
      for (int j = 0; j < 8; ++j) sm += y[j];
      sm += __shfl_xor(sm, 1); sm += __shfl_xor(sm, 2); sm += __shfl_xor(sm, 4);
      const float mu = sm * (1.f / 64.f); float q = 0.f;
#pragma unroll
      for (int j = 0; j < 8; ++j) { y[j] -= mu; q += y[j] * y[j]; }
      q += __shfl_xor(q, 1); q += __shfl_xor(q, 2); q += __shfl_xor(q, 4);
      const float rs = rsqrtf(q * (1.f / 64.f) + 64e-5f);
      float bo = 0.f;
#pragma unroll
      for (int j = 0; j < 8; ++j) bo += r[j] * (kd0[j] + kd1[j]) * (j < 4 ? rk0[j] : rk1[j - 4]);
      bo += __shfl_xor(bo, 1); bo += __shfl_xor(bo, 2); bo += __shfl_xor(bo, 4);
#pragma unroll
      for (int j = 0; j < 8; ++j) y[j] = (y[j] * rs * (j < 4 ? g0[j] : g1[j - 4]) + (j < 4 ? c0[j] : c1[j - 4]) + bo * v[j]) * gg[j];
      *(u32x4*)(ymix + m * 2048 + 512 + ch) = pack8(y); }
#undef RO_LD
    LDS_WAIT();
}
__device__ __forceinline__ void phase_rwkv_out(Frame& F, const Params& P, int l) {
    int lane = F.lane; asm volatile("" : "+v"(lane));
    for (int u = F.vcu * NWAVES + F.wave; u < 2048; u += F.G * NWAVES) rwkv_out_wave(F, P, l, u, lane);
}


__device__ __forceinline__ void phase_ln1_router(Frame& F, const Params& P, int l) {
    int lane = F.lane; asm volatile("" : "+v"(lane)); int tid = F.tid; asm volatile("" : "+v"(tid));
    const int gw = F.vcu * NWAVES + F.wave;
    const float* wr = P.in[I_W_RT] + (size_t)l * 1024 * 32; const float* br = P.in[I_B_RT] + (size_t)l * 32;
    const float* g1 = P.in[I_LN1G] + (size_t)l * DM; const float* b1 = P.in[I_LN1B] + (size_t)l * DM;
    LAS int* hist = (LAS int*)(F.lds + L_EXTRA); LAS int* base = hist + 32; LAS float* gb = (LAS float*)(F.lds + L_EXTRA + 512);
    for (int f = tid; f < 4096; f += NTHR) { const int fl = f & 63, st = f >> 6, e = 16 * (st & 1) + (fl & 15), d0 = 32 * (st >> 1) + 8 * (fl >> 4);
        float w[8];
#pragma unroll
        for (int i = 0; i < 8; ++i) w[i] = wr[(size_t)(d0 + i) * 32 + e];
        u32x4 hi, lo; hi.x = pk2(w[0], w[1]); hi.y = pk2(w[2], w[3]); hi.z = pk2(w[4], w[5]); hi.w = pk2(w[6], w[7]);
        lo.x = pk2(w[0] - bflo(hi.x), w[1] - bfhi(hi.x)); lo.y = pk2(w[2] - bflo(hi.y), w[3] - bfhi(hi.y)); lo.z = pk2(w[4] - bflo(hi.z), w[5] - bfhi(hi.z)); lo.w = pk2(w[6] - bflo(hi.w), w[7] - bfhi(hi.w));
        *(LAS u32x4*)(F.lds + f * 16) = hi; *(LAS u32x4*)(F.lds + 65536 + f * 16) = lo; }
    if (tid < 256) *(LAS f32x4*)(gb + 4 * tid) = *(const f32x4*)(g1 + 4 * tid); else *(LAS f32x4*)(gb + 4 * tid) = *(const f32x4*)(b1 + 4 * (tid - 256));
    if (tid < 32) hist[tid] = 0;
    __syncthreads();
    const float* pre = (const float*)(P.ws + A_PRE); float* x1f = (float*)(P.ws + A_X1F); bf16* x1b = (bf16*)(P.ws + A_X1B);
    int* tope = (int*)(P.ws + A_TOPE); float* topg = (float*)(P.ws + A_TOPG); int* topr = (int*)(P.ws + A_TOPR);
    const int q = lane >> 4, m = gw * 8 + (lane & 7); const bool real = !(lane & 8) && m < MTOK;
    int my_e = 0, my_r = 0;
    if (gw * 8 < MTOK) {
        const float* prow = pre + (size_t)m * DM + 8 * q;
        float s1 = 0.f, s2 = 0.f;
        { f32x4 vq[16];
#pragma unroll
          for (int u = 0; u < 8; ++u) { vq[2 * u] = *(const f32x4*)(prow + 32 * u); vq[2 * u + 1] = *(const f32x4*)(prow + 32 * u + 4); }
#pragma unroll 1
          for (int sb = 0; sb < 32; sb += 8) { f32x4 v[16];
#pragma unroll
            for (int u = 0; u < 16; ++u) v[u] = vq[u];
            if (sb + 8 < 32) {
#pragma unroll
                for (int u = 0; u < 8; ++u) { vq[2 * u] = *(const f32x4*)(prow + 32 * (sb + 8 + u)); vq[2 * u + 1] = *(const f32x4*)(prow + 32 * (sb + 8 + u) + 4); } }
#pragma unroll
            for (int u = 0; u < 16; ++u) { s1 += (v[u].x + v[u].y) + (v[u].z + v[u].w); s2 += (v[u].x * v[u].x + v[u].y * v[u].y) + (v[u].z * v[u].z + v[u].w * v[u].w); } } }
        f32x4 vn[8];
#pragma unroll
        for (int u = 0; u < 4; ++u) { vn[2 * u] = *(const f32x4*)(prow + 32 * u); vn[2 * u + 1] = *(const f32x4*)(prow + 32 * u + 4); }
        s1 += __shfl_xor(s1, 16); s1 += __shfl_xor(s1, 32); s2 += __shfl_xor(s2, 16); s2 += __shfl_xor(s2, 32);
        const float mean = s1 * (1.f / DM); const float var = fmaxf(s2 * (1.f / DM) - mean * mean, 0.f); const float rstd = 1.f / sqrtf(var + LN_EPS);
        f32x4 acc0 = {0.f, 0.f, 0.f, 0.f}, acc1 = {0.f, 0.f, 0.f, 0.f};
        float* of = x1f + (size_t)m * DM + 8 * q; bf16* ob = x1b + (size_t)m * DM + 8 * q;
#pragma unroll 1
        for (int sb = 0; sb < 32; sb += 4) { f32x4 v[8];
#pragma unroll
            for (int u = 0; u < 8; ++u) v[u] = vn[u];
            if (sb + 4 < 32) {
#pragma unroll
                for (int u = 0; u < 4; ++u) { vn[2 * u] = *(const f32x4*)(prow + 32 * (sb + 4 + u)); vn[2 * u + 1] = *(const f32x4*)(prow + 32 * (sb + 4 + u) + 4); } }
#pragma unroll
            for (int u = 0; u < 4; ++u) { const int s = sb + u;
                const f32x4 gA = *(const LAS f32x4*)(gb + 32 * s + 8 * q), gB = *(const LAS f32x4*)(gb + 32 * s + 8 * q + 4), bA = *(const LAS f32x4*)(gb + 1024 + 32 * s + 8 * q), bB = *(const LAS f32x4*)(gb + 1024 + 32 * s + 8 * q + 4);
                const f32x4 xa = (v[2 * u] - mean) * rstd * gA + bA, xb = (v[2 * u + 1] - mean) * rstd * gB + bB;
                u32x4 H; H.x = pk2(xa.x, xa.y); H.y = pk2(xa.z, xa.w); H.z = pk2(xb.x, xb.y); H.w = pk2(xb.z, xb.w);
                if (real) { *(f32x4*)(of + 32 * s) = xa; *(f32x4*)(of + 32 * s + 4) = xb; *(u32x4*)(ob + 32 * s) = H; }
                u32x4 L; L.x = pk2(xa.x - bflo(H.x), xa.y - bfhi(H.x)); L.y = pk2(xa.z - bflo(H.y), xa.w - bfhi(H.y)); L.z = pk2(xb.x - bflo(H.z), xb.y - bfhi(H.z)); L.w = pk2(xb.z - bflo(H.w), xb.w - bfhi(H.w));
                const bf16x8 Hh = __builtin_bit_cast(bf16x8, H), Ll = __builtin_bit_cast(bf16x8, L);
                const bf16x8 Wh0 = *(const LAS bf16x8*)(F.lds + ((2 * s) * 64 + lane) * 16), Wh1 = *(const LAS bf16x8*)(F.lds + ((2 * s + 1) * 64 + lane) * 16);
                const bf16x8 Wl0 = *(const LAS bf16x8*)(F.lds + 65536 + ((2 * s) * 64 + lane) * 16), Wl1 = *(const LAS bf16x8*)(F.lds + 65536 + ((2 * s + 1) * 64 + lane) * 16);
                acc0 = __builtin_amdgcn_mfma_f32_16x16x32_bf16(Wh0, Hh, acc0, 0, 0, 0); acc1 = __builtin_amdgcn_mfma_f32_16x16x32_bf16(Wh1, Hh, acc1, 0, 0, 0);
                acc0 = __builtin_amdgcn_mfma_f32_16x16x32_bf16(Wl0, Hh, acc0, 0, 0, 0); acc1 = __builtin_amdgcn_mfma_f32_16x16x32_bf16(Wl1, Hh, acc1, 0, 0, 0);
                acc0 = __builtin_amdgcn_mfma_f32_16x16x32_bf16(Wh0, Ll, acc0, 0, 0, 0); acc1 = __builtin_amdgcn_mfma_f32_16x16x32_bf16(Wh1, Ll, acc1, 0, 0, 0); } }
        unsigned key[8];
#pragma unroll
        for (int j = 0; j < 8; ++j) { const int e = 16 * (j >> 2) + 4 * q + (j & 3); const float lg = (j < 4 ? acc0[j & 3] : acc1[j & 3]) + br[e];
            unsigned u = __builtin_bit_cast(unsigned, lg); u = (u & 0x80000000u) ? ~u : (u | 0x80000000u); key[j] = (u & ~31u) | (unsigned)(31 - e); }
        unsigned M[4];
#pragma unroll
        for (int r = 0; r < 4; ++r) { unsigned mx = max(max(max(key[0], key[1]), max(key[2], key[3])), max(max(key[4], key[5]), max(key[6], key[7])));
            mx = max(mx, (unsigned)__shfl_xor((int)mx, 16)); mx = max(mx, (unsigned)__shfl_xor((int)mx, 32)); M[r] = mx;
#pragma unroll
            for (int j = 0; j < 8; ++j) key[j] = key[j] == mx ? 0u : key[j]; }
        float tv[4];
#pragma unroll
        for (int r = 0; r < 4; ++r) { const unsigned ub = M[r] & ~31u; tv[r] = __builtin_bit_cast(float, (ub & 0x80000000u) ? (ub & 0x7fffffffu) : ~ub); }
        const float e1 = __expf(tv[1] - tv[0]), e2 = __expf(tv[2] - tv[0]), e3 = __expf(tv[3] - tv[0]), inv = 1.f / (1.f + e1 + e2 + e3);
        if (real) { const unsigned mk = q == 0 ? M[0] : q == 1 ? M[1] : q == 2 ? M[2] : M[3]; const int e = 31 - (int)(mk & 31u); const float gt = (q == 0 ? 1.f : q == 1 ? e1 : q == 2 ? e2 : e3) * inv;
            my_e = e; my_r = __hip_atomic_fetch_add(hist + e, 1, __ATOMIC_RELAXED, __HIP_MEMORY_SCOPE_WORKGROUP);
            tope[(size_t)m * 4 + q] = e; topg[(size_t)m * 4 + q] = gt; }
    }
    __syncthreads();
    if (tid < 32) base[tid] = (int)__hip_atomic_fetch_add((unsigned*)(F.ctl + CW_GCNT + l * 32 + tid), (unsigned)hist[tid], RLX_AGENT);
    __syncthreads();
    if (real) topr[(size_t)m * 4 + q] = base[my_e] + my_r;
    __syncthreads();
}
constexpr int L_MOE = L_MISC - 2048;
__device__ __forceinline__ MoeTab moe_tables(Frame& F, int l) {
    LAS int* ps = (LAS int*)(F.lds + L_MOE); LAS int* pe = ps + 64;
    __syncthreads();
    if (F.tid < 32) { const int e = F.tid;
        const int c = (int)__hip_atomic_load((unsigned*)(F.ctl + CW_GCNT + l * 32 + e), RLX_AGENT); const int np = (c + 255) >> 8;
        int incl = np;
#pragma unroll
        for (int o = 1; o < 32; o <<= 1) { const int t = __shfl_up(incl, o, 32); if (e >= o) incl += t; }
        const int st = incl - np < 288 ? incl - np : 288, en = incl < 288 ? incl : 288;
        ps[e] = st; for (int p = st; p < en; ++p) pe[p] = e;
        if (e == 31) ps[32] = en; }
    __syncthreads();
    MoeTab T; T.pstart = ps; T.panel_e = pe; T.npanels = ps[32]; return T;
}
__device__ __forceinline__ void phase_dispatch(Frame& F, const Params& P, const MoeTab& T) {
    const int* tope = (const int*)(P.ws + A_TOPE); const int* topr = (const int*)(P.ws + A_TOPR); int* rowtok = (int*)(P.ws + A_ROWTOK);
    int tid = F.tid; asm volatile("" : "+v"(tid));
    for (int s = F.vcu * NTHR + tid; s < MTOK * 4; s += F.G * NTHR) { const int e = tope[s], r = topr[s]; const int pos = T.pstart[e] * 256 + r; if (pos < MPAD) rowtok[pos] = s >> 2; }
    for (int s = F.vcu * NTHR + tid; s < MTOK; s += F.G * NTHR) rowtok[MPAD + s] = s;
}
__device__ __forceinline__ void phase_ln2(Frame& F, const Params& P, int l, const MoeTab& T, float* outf, bf16* outb) {
    int lane = F.lane; asm volatile("" : "+v"(lane));
    const int gw = F.vcu * NWAVES + F.wave, NGW = F.G * NWAVES;
    const float* x1f = (const float*)(P.ws + A_X1F); const bf16* ye = (const bf16*)(P.ws + A_YE); const bf16* pleb = (const bf16*)(P.ws + A_PLEB);
    const int* tope = (const int*)(P.ws + A_TOPE); const float* topg = (const float*)(P.ws + A_TOPG); const int* topr = (const int*)(P.ws + A_TOPR);
    const float* g2 = P.in[I_LN2G] + (size_t)l * DM; const float* b2 = P.in[I_LN2B] + (size_t)l * DM;
    f32x4 gq_[2][2], bq_[2][2];
#pragma unroll
    for (int q = 0; q < 2; ++q) { const int ch = 8 * lane + 512 * q; gq_[q][0] = *(const f32x4*)(g2 + ch); gq_[q][1] = *(const f32x4*)(g2 + ch + 4); bq_[q][0] = *(const f32x4*)(b2 + ch); bq_[q][1] = *(const f32x4*)(b2 + ch + 4); }
    for (int m = gw; m < MTOK; m += NGW) {
        float v[16];
#pragma unroll
        for (int q = 0; q < 2; ++q) { const int ch = 8 * lane + 512 * q; const f32x4 a0 = *(const f32x4*)(x1f + (size_t)m * DM + ch), a1 = *(const f32x4*)(x1f + (size_t)m * DM + ch + 4);
            float pl[8]; unpack8(*(const u32x4*)(pleb + (size_t)m * DM + ch), pl);
#pragma unroll
            for (int j = 0; j < 8; ++j) v[8 * q + j] = DN_ALPHA * (j < 4 ? a0[j] : a1[j - 4]) + pl[j]; }
#pragma unroll
        for (int k = 0; k < 4; ++k) { const int e = tope[(size_t)m * 4 + k], r = topr[(size_t)m * 4 + k]; const float gt = topg[(size_t)m * 4 + k]; int pos = T.pstart[e] * 256 + r; pos = pos < MPAD ? pos : MPAD - 1;
#pragma unroll
            for (int q = 0; q < 2; ++q) { float y[8]; unpack8(*(const u32x4*)(ye + (size_t)pos * DM + 8 * lane + 512 * q), y);
#pragma unroll
                for (int j = 0; j < 8; ++j) v[8 * q + j] += gt * y[j]; } }
        float s = 0.f;
#pragma unroll
        for (int j = 0; j < 16; ++j) s += v[j];
        const float mean = wave_sum(s) * (1.f / DM); float s2 = 0.f;
#pragma unroll
        for (int j = 0; j < 16; ++j) { v[j] -= mean; s2 += v[j] * v[j]; }
        const float rstd = 1.f / sqrtf(wave_sum(s2) * (1.f / DM) + LN_EPS);
#pragma unroll
        for (int q = 0; q < 2; ++q) { const int ch = 8 * lane + 512 * q; const f32x4 ga = gq_[q][0], gb = gq_[q][1], ba = bq_[q][0], bb = bq_[q][1];
            float o[8];
#pragma unroll
            for (int j = 0; j < 8; ++j) o[j] = v[8 * q + j] * rstd * (j < 4 ? ga[j] : gb[j - 4]) + (j < 4 ? ba[j] : bb[j - 4]);
            *(f32x4*)(outf + (size_t)m * DM + ch) = (f32x4){o[0], o[1], o[2], o[3]}; *(f32x4*)(outf + (size_t)m * DM + ch + 4) = (f32x4){o[4], o[5], o[6], o[7]};
            if (outb) *(u32x4*)(outb + (size_t)m * DM + ch) = pack8(o); }
    }
}

#ifndef STOP_AT
#define STOP_AT 1000
#endif
#define GRID_BAR() xcd_barrier(bar)
#define CKPT(n) do { if (l * 100 + (n) >= STOP_AT) return; } while (0)
template <int l> __device__ __forceinline__ void layer_body(Frame& F, const Params& P, const XcdBarrier& bar) {
    const int c = (int)blockIdx.x, G = F.G;
    { SchedPlain S{(const char*)(P.ws + A_XB), (const char*)(P.ws + WS_W_IN + l * W_IN_SZ), 2048, 2048, 16, 64, NPN_IN, G, c};
      EpiInproj E{(bf16*)(P.ws + A_COLS), (float*)(P.ws + A_SIDE)};
      pg8::gemm_phase<false>(F.lds + L_STAGE, S, E, 2048, 2048, nullptr); }
    GRID_BAR(); CKPT(1);
    phase_prep(F, P, l);
    GRID_BAR(); CKPT(2);
    { SchedPlain S{(const char*)(P.ws + A_LIN), (const char*)(P.ws + WS_W_LORA + l * W_LORA_SZ), 768, 768, 6, 64, 10, G, c};
      EpiLora E{(float*)(P.ws + A_RLOGW), (bf16*)(P.ws + A_RKDIR), (bf16*)(P.ws + A_RKKA), (bf16*)(P.ws + A_RG), (const bf16*)(P.ws + A_RKV), (const bf16*)(P.ws + A_RKK),
                P.in[I_R_W0] + (size_t)l * 1024, P.in[I_R_A0] + (size_t)l * 1024, P.in[I_R_KA] + (size_t)l * 512};
      pg8::gemm_phase<false>(F.lds + L_STAGE, S, E, 768, 768, nullptr); }
    phase_ssd_states(F, P);
    GRID_BAR(); CKPT(3);
    phase_gdn_a(F, P);
    phase_rwkv_a(F, P);
    { int lane2 = F.lane; asm volatile("" : "+v"(lane2)); for (int item = (F.vcu * NWAVES + F.wave) * 64 + lane2; item < 64 * 2048; item += F.G * NTHR) ssd_scan_item(P, item); }
    GRID_BAR();
    phase_scan_seq(F, P, l);
    GRID_BAR(); CKPT(4);
    phase_gdn_out(F, P, l);
    phase_rwkv_out(F, P, l);
    GRID_BAR(); CKPT(5);
    { SchedBranch S{(const char*)(P.ws + A_YMIX), (const char*)(P.ws + WS_W_BR + l * W_BR_SZ), G, c};
      EpiBranch E{(const bf16*)(P.ws + A_COLS), (bf16*)(P.ws + A_MERGED)};
      pg8::gemm_phase<false>(F.lds + L_STAGE, S, E, 4096, 4096, nullptr); }
    GRID_BAR(); CKPT(6);
    { SchedPlain S{(const char*)(P.ws + A_MERGED), (const char*)(P.ws + WS_W_O + l * W_SQ_SZ), 2048, 2048, 16, 64, 4, G, c};
      EpiWo E{(const float*)(P.ws + A_XF), (float*)(P.ws + A_PRE)};
      pg8::gemm_phase<false>(F.lds + L_STAGE, S, E, 2048, 2048, nullptr); }
    GRID_BAR(); CKPT(7);
    phase_ln1_router(F, P, l);
    GRID_BAR(); CKPT(8);
    MoeTab T = moe_tables(F, l);
    phase_dispatch(F, P, T);
    GRID_BAR(); CKPT(9);
    { SchedGu S{(const char*)(P.ws + A_X1B), (const char*)(P.ws + WS_W_GU + (size_t)l * 32 * W_GU_SZ), (const char*)(P.ws + WS_W_PLG + l * W_SQ_SZ), T, G, c};
      EpiGuPlg E{EpiGu{(bf16*)(P.ws + A_ACT), P.in[I_B_GU] + (size_t)l * 32 * 2048}, EpiPlg{(bf16*)(P.ws + A_SG)}};
      pg8::gemm_phase<true>(F.lds + L_STAGE, S, E, 2048, 2048, (const int*)(P.ws + A_ROWTOK)); }
    GRID_BAR(); CKPT(10);
    { SchedDnPle S{(const char*)(P.ws + A_ACT), (const char*)(P.ws + WS_W_DN + (size_t)l * 32 * W_SQ_SZ), (const char*)(P.ws + A_PB + (size_t)l * MTOK * 2048), (const char*)(P.ws + WS_W_PL + l * W_PL_SZ), (const char*)(P.ws + A_X1B), (const char*)(P.ws + WS_W_PLG + l * W_SQ_SZ), T, G, c};
      EpiDnPle E{(bf16*)(P.ws + A_YE), P.in[I_B_DN] + (size_t)l * 32 * 1024, (bf16*)(P.ws + A_PLEB), (const bf16*)(P.ws + A_SG), (bf16*)(P.ws + A_SG)};
      pg8::gemm_phase<false>(F.lds + L_STAGE, S, E, 2048, 2048, nullptr); }
    GRID_BAR(); CKPT(11);
    if (l + 1 < DEPTH) phase_ln2(F, P, l, T, (float*)(P.ws + A_XF), (bf16*)(P.ws + A_XB));
    else phase_ln2(F, P, l, T, P.out, nullptr);
    if (l + 1 < DEPTH) GRID_BAR(); CKPT(12);
}

__global__ void __launch_bounds__(NTHR, 2) fwd_kernel(Params P) {
    extern __shared__ __attribute__((aligned(16))) unsigned char lds_raw[];
    Frame F;
    F.lds = (LAS unsigned char*)lds_raw; F.MISC = (volatile LAS unsigned*)(F.lds + L_MISC);
    F.tid = threadIdx.x; F.lane = F.tid & 63; F.wave = __builtin_amdgcn_readfirstlane(F.tid >> 6);
    F.G = gridDim.x; { const int bx = blockIdx.x; F.vcu = (bx % 8) * (F.G / 8) + bx / 8; }
    F.ws = P.ws; F.ctl = (gu32*)(P.ws + WS_CTL);
    if (F.tid < 64) F.MISC[F.tid] = 0u;
    __syncthreads();
    XcdBarrier bar = xcd_barrier_post((unsigned*)(F.ctl + CW_BAR), F.MISC + 8);

    phase_prologue(F, P);
    GRID_BAR();
    if (STOP_AT <= 0) return;
    layer_body<0>(F, P, bar);
    if (STOP_AT < 100) return;
    layer_body<1>(F, P, bar);
}

extern "C" void kernel_launch(void* const* d_in, const int* in_sizes, int n_in, void* d_out, int out_size, void* d_ws, size_t ws_size, hipStream_t stream) {
    static int grid = 0;
    if (grid == 0) {
        if (n_in != 41 || out_size != MTOK * DM || ws_size < WS_END) { fprintf(stderr, "kernel_launch: unexpected shapes (n_in %d, out %d, ws %zu < %zu)\n", n_in, out_size, ws_size, (size_t)WS_END); grid = -1; return; }
        static const int exp_sizes[41] = {16777216, 8388608, 1024, 1024, 19759104, 15360, 16, 16, 256, 3840, 3840, 2048, 131072, 2048, 131072, 131072, 1024, 1024, 1024, 1024, 1024,
            15360, 3072, 64, 64, 32, 2048, 4194304, 2097152, 2048, 2048, 65536, 64, 134217728, 131072, 67108864, 65536, 524288, 2097152, 2048, 2048};
        for (int i = 0; i < 41; ++i) if (in_sizes[i] != exp_sizes[i]) { fprintf(stderr, "kernel_launch: input %d has %d elements, expected %d\n", i, in_sizes[i], exp_sizes[i]); grid = -1; return; }
        int dev = 0, cus = 0, per_cu = 0;
        if (hipGetDevice(&dev) != hipSuccess || hipDeviceGetAttribute(&cus, hipDeviceAttributeMultiprocessorCount, dev) != hipSuccess) { grid = -1; return; }
        if (hipFuncSetAttribute((const void*)fwd_kernel, hipFuncAttributeMaxDynamicSharedMemorySize, LDS_BYTES) != hipSuccess) { fprintf(stderr, "kernel_launch: hipFuncSetAttribute failed\n"); grid = -1; return; }
        if (hipOccupancyMaxActiveBlocksPerMultiprocessor(&per_cu, (const void*)fwd_kernel, NTHR, LDS_BYTES) != hipSuccess || per_cu < 1) { fprintf(stderr, "kernel_launch: occupancy query says %d\n", per_cu); }
        (void)hipGetLastError();
        grid = cus;
        if (grid != 256) { fprintf(stderr, "kernel_launch: built for 256 CUs, device has %d\n", cus); grid = -1; return; }
    }
    if (grid < 0) return;
    (void)hipMemsetAsync((char*)d_ws + WS_CTL, 0, CTL_ZERO_BYTES, stream);
    Params p{};
    for (int i = 0; i < 41; ++i) p.in[i] = (const float*)d_in[i];
    p.out = (float*)d_out; p.ws = (unsigned char*)d_ws;
    hipLaunchKernelGGL(fwd_kernel, dim3(grid), dim3(NTHR), LDS_BYTES, stream, p);
}
```

```cpp
#include <hip/hip_runtime.h>
#include <cstdio>
#include <cstdint>

#define GAS __attribute__((address_space(1)))
#define LAS __attribute__((address_space(3)))
typedef unsigned short bf16;
typedef unsigned u32x4 __attribute__((ext_vector_type(4)));
typedef unsigned u32x2 __attribute__((ext_vector_type(2)));
typedef float f32x4 __attribute__((ext_vector_type(4)));
typedef float f32x2 __attribute__((ext_vector_type(2)));
typedef short bf16x8 __attribute__((ext_vector_type(8)));
typedef GAS unsigned gu32;
#define RLX_AGENT __ATOMIC_RELAXED, __HIP_MEMORY_SCOPE_AGENT

constexpr int DM = 1024, SEQ = 8192, NB = 2, MTOK = NB * SEQ, DEPTH = 2, PLE = 256, NEXP = 32, TOPK = 4, DEXP = 1024;
constexpr int NCB = 9472;
constexpr int NPN_IN = 38;
constexpr int MPAD = 73728;
constexpr float LN_EPS = 1e-5f;
constexpr float DN_ALPHA = 1.4142135623730951f;
constexpr int C_GQKV = 0, C_GZ = 1536, C_RRKV = 2048, C_RAL = 3584, C_RGL = 3712, C_SZ = 3840, C_SXBC = 4864, C_GATE = 6400;

constexpr size_t MiB = 1u << 20;
constexpr size_t WS_CTL = 0, CTL_ZERO_BYTES = 1 * MiB;
constexpr size_t W_IN_SZ = (size_t)9728 * 1024 * 2, W_BR_SZ = (size_t)1024 * 2048 * 2, W_SQ_SZ = (size_t)1024 * 1024 * 2, W_GU_SZ = (size_t)2048 * 1024 * 2,
                 W_PL_SZ = (size_t)1024 * 1024 * 2, W_LORA_SZ = (size_t)2560 * 384 * 2;
constexpr size_t WS_W_IN = 1 * MiB;
constexpr size_t WS_W_BR = WS_W_IN + 2 * W_IN_SZ;
constexpr size_t WS_W_O = WS_W_BR + 2 * W_BR_SZ;
constexpr size_t WS_W_PLG = WS_W_O + 2 * W_SQ_SZ;
constexpr size_t WS_W_PL = WS_W_PLG + 2 * W_SQ_SZ;
constexpr size_t WS_W_LORA = WS_W_PL + 2 * W_PL_SZ;
constexpr size_t WS_W_GU = ((WS_W_LORA + 2 * W_LORA_SZ + MiB - 1) / MiB) * MiB;
constexpr size_t WS_W_DN = WS_W_GU + 64 * W_GU_SZ;
constexpr size_t WS_ACT0 = WS_W_DN + 64 * W_SQ_SZ;
constexpr size_t A_XF = WS_ACT0;
constexpr size_t A_XB = A_XF + 64 * MiB;
constexpr size_t A_COLS = A_XB + 32 * MiB;
constexpr size_t A_ACT = A_COLS;
constexpr size_t A_YE = A_COLS + 144 * MiB;
constexpr size_t A_SIDE = A_COLS + 296 * MiB;
constexpr size_t A_PB = A_SIDE + 16 * MiB;
constexpr size_t A_GQKV = A_PB + 64 * MiB;
constexpr size_t A_GSC = A_GQKV + 48 * MiB;
constexpr size_t A_SXBC = A_GSC + 1 * MiB;
constexpr size_t A_SSC = A_SXBC + 48 * MiB;
constexpr size_t A_RKV = A_SSC + 4 * MiB;
constexpr size_t A_RKK = A_RKV + 48 * MiB;
constexpr size_t A_LIN = A_RKK + 16 * MiB;
constexpr size_t A_RLOGW = A_LIN + 12 * MiB;
constexpr size_t A_RKDIR = A_RLOGW + 64 * MiB;
constexpr size_t A_RKKA = A_RKDIR + 32 * MiB;
constexpr size_t A_RG = A_RKKA + 32 * MiB;
constexpr size_t A_OG = A_RG + 16 * MiB;
constexpr size_t A_OR = A_OG + 64 * MiB;
constexpr size_t A_OS = A_OR + 64 * MiB;
constexpr size_t A_HS = A_OS;
constexpr size_t A_SDEC = A_OS + 64 * MiB;
constexpr size_t A_YMIX = A_OS + 128 * MiB;
constexpr size_t A_MPART = A_YMIX + 64 * MiB;
constexpr size_t A_MERGED = A_MPART + 64 * MiB;
constexpr size_t A_PRE = A_OG;
constexpr size_t A_X1F = A_OR;
constexpr size_t A_X1B = A_OS;
constexpr size_t A_SG = A_OS + 32 * MiB;
constexpr size_t A_PLEB = A_OS + 64 * MiB;
constexpr size_t A_TOPE = A_RKK;
constexpr size_t A_TOPG = A_TOPE + 256 * 1024;
constexpr size_t A_TOPR = A_TOPG + 256 * 1024;
constexpr size_t A_ROWTOK = A_TOPR + 256 * 1024;
constexpr size_t A_WRT = A_MERGED + 32 * MiB;
constexpr size_t A_GPSI = A_WRT + 1 * MiB;
constexpr size_t A_GLAM = A_GPSI + 64 * MiB;
constexpr size_t A_GQT = A_GLAM + 64 * MiB;
constexpr size_t A_GO0 = A_GQT + 32 * MiB;
constexpr size_t A_GH = A_GO0 + 32 * MiB;
constexpr size_t A_GD = A_GH + 64 * MiB;
constexpr size_t A_RPSI = A_OG;
constexpr size_t A_RLAM = A_OG + 32 * MiB;
constexpr size_t A_RRT = A_OR;
constexpr size_t A_RY0 = A_OR + 32 * MiB;
constexpr size_t A_RH = A_MPART;
constexpr size_t A_RPC = A_MPART + 32 * MiB;
constexpr size_t WS_END = A_GD + 1 * MiB;
static_assert(WS_END <= (size_t)2040 * MiB, "d_ws map");
constexpr int CW_BAR = 4096;
constexpr int CW_GCNT = 16384;

constexpr int LDS_BYTES = 163840;
constexpr int L_STAGE = 0;
constexpr int L_EXTRA = 131072;
constexpr int L_MISC = LDS_BYTES - 256;
constexpr int NWAVES = 8, NTHR = 512;

#define LDS_WAIT() asm volatile("s_waitcnt lgkmcnt(0)" ::: "memory")
#define VM_WAIT() asm volatile("s_waitcnt vmcnt(0)" ::: "memory")
__device__ __forceinline__ unsigned f2bf(float f) { unsigned u = __builtin_bit_cast(unsigned, f); return (u + 0x7fffu + ((u >> 16) & 1u)) >> 16; }
typedef __bf16 bf16x2_t __attribute__((ext_vector_type(2)));
__device__ __forceinline__ unsigned pk2(float lo, float hi) { const f32x2 v = {lo, hi}; return __builtin_bit_cast(unsigned, __builtin_convertvector(v, bf16x2_t)); }
__device__ __forceinline__ float bf2f(unsigned h) { return __builtin_bit_cast(float, h << 16); }
__device__ __forceinline__ float bflo(unsigned w) { return __builtin_bit_cast(float, w << 16); }
__device__ __forceinline__ float bfhi(unsigned w) { return __builtin_bit_cast(float, w & 0xffff0000u); }
__device__ __forceinline__ float sigmoidf_(float x) { return __builtin_amdgcn_rcpf(1.0f + __expf(-x)); }
__device__ __forceinline__ float siluf_(float x) { return x * __builtin_amdgcn_rcpf(1.0f + __expf(-x)); }
__device__ __forceinline__ float softplusf_(float x) { return x > 20.f ? x : log1pf(__expf(x)); }
__device__ __forceinline__ float wave_sum(float v) {
#pragma unroll
    for (int o = 1; o < 64; o <<= 1) v += __shfl_xor(v, o);
    return v;
}
__device__ __forceinline__ void unpack8(u32x4 w, float (&f)[8]) {
    f[0] = bflo(w.x); f[1] = bfhi(w.x); f[2] = bflo(w.y); f[3] = bfhi(w.y); f[4] = bflo(w.z); f[5] = bfhi(w.z); f[6] = bflo(w.w); f[7] = bfhi(w.w);
}
__device__ __forceinline__ u32x4 pack8(const float (&f)[8]) { u32x4 w; w.x = pk2(f[0], f[1]); w.y = pk2(f[2], f[3]); w.z = pk2(f[4], f[5]); w.w = pk2(f[6], f[7]); return w; }

#define XB_TMO      128
#define XB_XCNT(j)  (256  + 64 * (j))
#define XB_XSUB(j)  (1280 + 64 * (j))
#define XB_XGEN(j)  (2304 + 64 * (j))
#define XB_TOP      3328
#define XB_TOPGEN   3392
#define XCD_BAR_WORDS 3456
#define XB_SPIN_CAP (1u << 22)
__device__ __forceinline__ unsigned xb_ld(unsigned* p)              { return __hip_atomic_load(p, __ATOMIC_RELAXED, __HIP_MEMORY_SCOPE_AGENT); }
__device__ __forceinline__ unsigned xb_add(unsigned* p, unsigned v) { return __hip_atomic_fetch_add(p, v, __ATOMIC_RELAXED, __HIP_MEMORY_SCOPE_AGENT); }
__device__ __forceinline__ unsigned xb_xcc_id() { return (unsigned)__builtin_amdgcn_s_getreg((3 << 11) | 20) & 0xFu; }
#define XB_SPIN(cond, bar) do { unsigned _sp = 0; while (cond) { __builtin_amdgcn_s_sleep(1); \
    if ((++_sp & 255u) == 0u) { if (xb_ld(&(bar)[XB_TMO])) break; if (_sp > XB_SPIN_CAP) { atomicAdd(&(bar)[XB_TMO], 1u); break; } } } } while (0)
struct XcdBarrier { unsigned* bar; unsigned x; volatile LAS unsigned* st; };
__device__ __forceinline__ XcdBarrier xcd_barrier_post(unsigned* bar, volatile LAS unsigned* st) {
    XcdBarrier b; b.bar = bar; b.x = xb_xcc_id(); b.st = st;
    if (threadIdx.x == 0) (void)xb_add(&bar[XB_XCNT(b.x)], 1u);
    return b;
}
__device__ __forceinline__ void xcd_barrier_complete(unsigned* bar, unsigned x, unsigned& nloc, unsigned& nx) {
    const unsigned G = gridDim.x * gridDim.y * gridDim.z;
    unsigned sum, cnt, mine, sp = 0u;
    for (;;) {
        sum = 0u; cnt = 0u; mine = 0u;
#pragma unroll
        for (unsigned j = 0; j < 16; ++j) { const unsigned c = xb_ld(&bar[XB_XCNT(j)]); sum += c; cnt += (c > 0u) ? 1u : 0u; mine = (j == x) ? c : mine; }
        if (sum == G) break;
        __builtin_amdgcn_s_sleep(1);
        if ((++sp & 255u) == 0u) { if (xb_ld(&bar[XB_TMO])) break; if (sp > XB_SPIN_CAP) { atomicAdd(&bar[XB_TMO], 1u); break; } }
    }
    nloc = mine > 0u ? mine : 1u; nx = cnt > 0u ? cnt : 1u;
}
__device__ __forceinline__ void xcd_barrier(const XcdBarrier& b) {
    asm volatile("s_waitcnt vmcnt(0)" ::: "memory");
    __syncthreads();
    if (threadIdx.x == 0) {
        unsigned* bar = b.bar;
        __builtin_amdgcn_s_waitcnt(0);
        unsigned nloc = b.st[0], nx = b.st[1];
        if (nloc == 0u) { xcd_barrier_complete(bar, b.x, nloc, nx); b.st[0] = nloc; b.st[1] = nx; }
        const unsigned old = xb_add(&bar[XB_XSUB(b.x)], 1u);
        const unsigned gen = old / nloc;
        if (old + 1u == (gen + 1u) * nloc) {
            __builtin_amdgcn_fence(__ATOMIC_RELEASE, "agent");
            asm volatile("s_waitcnt vmcnt(0)" ::: "memory");
            const unsigned og = xb_add(&bar[XB_TOP], 1u);
            const unsigned tg = og / nx;
            if (og + 1u == (tg + 1u) * nx) xb_add(&bar[XB_TOPGEN], 1u);
            else XB_SPIN(xb_ld(&bar[XB_TOPGEN]) == tg, bar);
            __builtin_amdgcn_fence(__ATOMIC_ACQUIRE, "agent");
            xb_add(&bar[XB_XGEN(b.x)], 1u);
            asm volatile("s_waitcnt vmcnt(0)" ::: "memory");
        } else {
            XB_SPIN(xb_ld(&bar[XB_XGEN(b.x)]) == gen, bar);
            __builtin_amdgcn_fence(__ATOMIC_ACQUIRE, "agent");
            asm volatile("s_waitcnt vmcnt(0)" ::: "memory");
        }
    }
    __syncthreads();
}

struct Params {
    const float* in[41];
    float* out;
    unsigned char* ws;
};
enum { I_X = 0, I_P, I_LNIN_G, I_LNIN_B, I_W_IN, I_GDN_CONV, I_GDN_ALOG, I_GDN_DTB, I_GDN_NORM, I_R_MUP, I_R_MUN, I_R_W0, I_R_WUP, I_R_A0, I_R_AUP, I_R_GUP,
       I_R_KK, I_R_KA, I_R_RK, I_R_LNG, I_R_LNB, I_S_CONV, I_S_CONVB, I_S_ALOG, I_S_DTB, I_S_D, I_S_NORM, I_W_BR, I_W_O, I_LN1G, I_LN1B, I_W_RT, I_B_RT,
       I_W_GU, I_B_GU, I_W_DN, I_B_DN, I_W_PL, I_W_PLG, I_LN2G, I_LN2B };

struct Frame {
    LAS unsigned char* lds;
    volatile LAS unsigned* MISC;
    gu32* ctl;
    unsigned char* ws;
    int tid, lane, wave, vcu, G;
};
#define WSP(T, off) ((T*)(F.ws + (off)))

namespace pg8 {
constexpr int BM = 256, BK = 64, HALF = 128, HTB = HALF * BK * 2, STAGE_BYTES = 8 * HTB, NXCD = 8, WGM = 8;
__host__ __device__ __forceinline__ int lds_byte(int r, int c) { const int st = (r >> 4) * 2 + (c >> 5), rr = r & 15, cc = c & 31, ob = rr * 64 + cc * 2; return st * 1024 + (ob ^ (((ob >> 9) & 1) << 5)); }
__host__ __device__ __forceinline__ void stage_rc(int b, int& R, int& C) { const int st = b / 1024, sb = b % 1024, swz = sb ^ (((sb >> 9) & 1) << 5); R = (st >> 1) * 16 + swz / 64; C = (st & 1) * 32 + (swz % 64) / 2; }
__host__ __device__ __forceinline__ int perm32(int rho) { const int n = rho >> 4, i = rho & 15; return 8 * (i >> 2) + 4 * n + (i & 3); }

struct GUnit {
    const char* A; const char* B;
    int nt;
    int arow0;
    int kind, pm, pn, aux;
};
__device__ __forceinline__ void tile_order(int L, int nM, int nN, int& pm, int& pn) {
    const int nwg = nM * nN; int wgid = L;
    { const int q = nwg / NXCD, r = nwg % NXCD, xcd = wgid % NXCD, off = wgid / NXCD; wgid = (xcd < r ? xcd * (q + 1) : r * (q + 1) + (xcd - r) * q) + off; }
    const int nig = WGM * nN, gid = wgid / nig, fm = gid * WGM, gsz = (nM - fm) < WGM ? (nM - fm) : WGM;
    pm = fm + ((wgid % nig) % gsz); pn = (wgid % nig) / gsz;
}

template <bool GATHER, class Sched, class Epi>
__device__ __forceinline__ void gemm_phase(LAS unsigned char* lds, const Sched& S, const Epi& E, const int lda, const int ldb, const int* gather) {
    int tid = threadIdx.x; asm volatile("" : "+v"(tid));
    const int wid = __builtin_amdgcn_readfirstlane(tid >> 6), lane = tid & 63, wr = wid >> 2, wc = wid & 3, fr = lane & 15, fq = lane >> 4;
    unsigned voffA[2], voffB[2], gA1[2]; int gR[2], gC[2];
#pragma unroll
    for (int i = 0; i < 2; ++i) { int R, C; stage_rc(tid * 16 + i * 8192, R, C); const int Rb = (R & ~31) + perm32(R & 31);
        voffA[i] = (unsigned)(R * lda + C * 2); voffB[i] = (unsigned)(Rb * ldb + C * 2); gR[i] = R; gC[i] = C * 2; gA1[i] = 0u; }
    const size_t kstep = (size_t)(BK * 2);
    const size_t hstepA = GATHER ? 0 : (size_t)HALF * lda, hstepB = (size_t)HALF * ldb;
    const unsigned ldsw = (unsigned)wid * 1024u;
    const int aoff = lds_byte(wr * 64 + fr, fq * 8), boff = lds_byte(wc * 32 + fr, fq * 8);
#define PG8_SA(b, h) (((b) * 2 + (h)) * HTB)
#define PG8_SB(b, h) ((4 + (b) * 2 + (h)) * HTB)
#define PG8_STAGE(bufoff, gbase, voff) do { _Pragma("unroll") for (int _i = 0; _i < 2; ++_i) \
        __builtin_amdgcn_global_load_lds((const unsigned*)((const char*)(gbase) + (voff)[_i]), (LAS unsigned*)(lds + (bufoff) + ldsw + _i * 8192), 16, 0, 0); } while (0)
#define PG8_LDA(dst, b, h) do { _Pragma("unroll") for (int m = 0; m < 4; ++m) _Pragma("unroll") for (int k = 0; k < 2; ++k) dst[m][k] = *(const LAS bf16x8*)(lds + PG8_SA(b, h) + aoff + m * 2048 + k * 1024); } while (0)
#define PG8_LDB(dst, b, h) do { _Pragma("unroll") for (int n = 0; n < 2; ++n) _Pragma("unroll") for (int k = 0; k < 2; ++k) dst[n][k] = *(const LAS bf16x8*)(lds + PG8_SB(b, h) + boff + n * 2048 + k * 1024); } while (0)
#define PG8_MMA(ai, bj, At, Bt) do { __builtin_amdgcn_s_setprio(1); _Pragma("unroll") for (int m = 0; m < 4; ++m) _Pragma("unroll") for (int n = 0; n < 2; ++n) _Pragma("unroll") for (int k = 0; k < 2; ++k) \
        acc[ai][bj][m][n] = __builtin_amdgcn_mfma_f32_16x16x32_bf16(Bt[n][k], At[m][k], acc[ai][bj][m][n], 0, 0, 0); __builtin_amdgcn_s_setprio(0); } while (0)
#define PG8_WAIT_V(n) asm volatile("s_waitcnt vmcnt(" #n ")" ::: "memory")
#define PG8_WAIT_L(n) asm volatile("s_waitcnt lgkmcnt(" #n ")" ::: "memory")
#define PG8_BAR __builtin_amdgcn_s_barrier()
#define PG8_SCHED __builtin_amdgcn_sched_barrier(0)
#define PG8_GOFFS(slot, o0, o1) do { _Pragma("unroll") for (int _i = 0; _i < 2; ++_i) { \
        unsigned r0 = (unsigned)gidx[(slot) * 256 + gR[_i]], r1 = (unsigned)gidx[(slot) * 256 + HALF + gR[_i]]; \
        r0 = r0 < (unsigned)MTOK ? r0 : (unsigned)(MTOK - 1); r1 = r1 < (unsigned)MTOK ? r1 : (unsigned)(MTOK - 1); \
        o0[_i] = r0 * (unsigned)lda + (unsigned)gC[_i]; o1[_i] = r1 * (unsigned)lda + (unsigned)gC[_i]; } } while (0)
    GUnit cur, nxt; int ui = 0;
    LAS int* gidx = (LAS int*)(lds + STAGE_BYTES);
    if constexpr (GATHER) {
#pragma unroll 1
        for (int i = 0; i < 16; ++i) { GUnit t; if (!S.next(i, t)) break; if (tid < 256) gidx[i * 256 + tid] = gather[t.arow0 + tid]; }
        __syncthreads(); }
    if (!S.next(0, cur)) return;
    f32x4 acc[2][2][4][2];
#pragma unroll
    for (int a = 0; a < 2; ++a)
#pragma unroll
        for (int b = 0; b < 2; ++b)
#pragma unroll
            for (int m = 0; m < 4; ++m)
#pragma unroll
                for (int n = 0; n < 2; ++n) acc[a][b][m][n] = (f32x4){0.f, 0.f, 0.f, 0.f};
    bf16x8 At[4][2], B0[2][2], B1[2][2];
    if constexpr (GATHER) { PG8_GOFFS(0, voffA, gA1); }
    const char* cA = cur.A; const char* cB = cur.B;
#define PG8_A1(off) (GATHER ? gA1 : voffA)
    PG8_STAGE(PG8_SB(0, 0), cB, voffB); PG8_STAGE(PG8_SB(0, 1), cB + hstepB, voffB); PG8_STAGE(PG8_SA(0, 0), cA, voffA);
    if constexpr (GATHER) { PG8_STAGE(PG8_SA(0, 1), cA, gA1); } else { PG8_STAGE(PG8_SA(0, 1), cA + hstepA, voffA); }
    if (wr == 1) PG8_BAR;
    PG8_WAIT_V(2); PG8_BAR;
    PG8_STAGE(PG8_SB(1, 0), cB + kstep, voffB); PG8_STAGE(PG8_SA(1, 0), cA + kstep, voffA); PG8_STAGE(PG8_SB(1, 1), cB + hstepB + kstep, voffB);
    PG8_WAIT_V(6); PG8_BAR;
    for (;;) {
        const bool has_next = S.next(ui + 1, nxt);
        const int nt = cur.nt;
        const char* nA = has_next ? nxt.A : cA; const char* nB = has_next ? nxt.B : cB;
        for (int t = 0; t < nt; t += 2) {
            const bool last = (t == nt - 2);
            const char* a1 = cA + (size_t)(t + 1) * kstep;
            const char* a2 = last ? nA : cA + (size_t)(t + 2) * kstep; const char* b2 = last ? nB : cB + (size_t)(t + 2) * kstep;
            const char* a3 = a2 + kstep; const char* b3 = b2 + kstep;
            unsigned pA0[2], pA1[2];
            if constexpr (GATHER) {
                if (last && has_next) { PG8_GOFFS(ui + 1, pA0, pA1); }
                else {
#pragma unroll
                    for (int i = 0; i < 2; ++i) { pA0[i] = voffA[i]; pA1[i] = gA1[i]; } }
            }
            PG8_LDB(B0, 0, 0); PG8_LDB(B1, 0, 1); PG8_SCHED; PG8_LDA(At, 0, 0);
            if constexpr (GATHER) { PG8_STAGE(PG8_SA(1, 1), a1, gA1); } else { PG8_STAGE(PG8_SA(1, 1), a1 + hstepA, voffA); }
            PG8_WAIT_V(8); PG8_WAIT_L(0); PG8_BAR; PG8_MMA(0, 0, At, B0); PG8_MMA(0, 1, At, B1); PG8_BAR; PG8_SCHED;
            PG8_LDA(At, 0, 1); PG8_STAGE(PG8_SB(0, 0), b2, voffB); PG8_STAGE(PG8_SB(0, 1), b2 + hstepB, voffB);
            if constexpr (GATHER) { PG8_STAGE(PG8_SA(0, 0), a2, pA0); } else { PG8_STAGE(PG8_SA(0, 0), a2, voffA); }
            PG8_WAIT_V(8); PG8_WAIT_L(0); PG8_BAR; PG8_MMA(1, 0, At, B0); PG8_MMA(1, 1, At, B1); PG8_BAR; PG8_SCHED;
            PG8_LDB(B0, 1, 0); PG8_LDB(B1, 1, 1); PG8_SCHED; PG8_LDA(At, 1, 0);
            if constexpr (GATHER) { PG8_STAGE(PG8_SA(0, 1), a2, pA1); } else { PG8_STAGE(PG8_SA(0, 1), a2 + hstepA, voffA); }
            PG8_WAIT_V(8); PG8_WAIT_L(0); PG8_BAR; PG8_MMA(0, 0, At, B0); PG8_MMA(0, 1, At, B1); PG8_BAR; PG8_SCHED;
            PG8_LDA(At, 1, 1); PG8_STAGE(PG8_SB(1, 0), b3, voffB); PG8_STAGE(PG8_SB(1, 1), b3 + hstepB, voffB);
            if constexpr (GATHER) { PG8_STAGE(PG8_SA(1, 0), a3, pA0); } else { PG8_STAGE(PG8_SA(1, 0), a3, voffA); }
            PG8_WAIT_V(8); PG8_WAIT_L(0); PG8_BAR; PG8_MMA(1, 0, At, B0); PG8_MMA(1, 1, At, B1); PG8_BAR; PG8_SCHED;
            if constexpr (GATHER) { if (last) {
#pragma unroll
                for (int i = 0; i < 2; ++i) { voffA[i] = pA0[i]; gA1[i] = pA1[i]; } } }
        }
        if (wr == 0) PG8_BAR;
        bool keep = false;
        if constexpr (Epi::CHAIN) { keep = E.chain(acc, cur, wr, wc, fr, fq); }
        if (!keep) E(acc, cur, wr, wc, fr, fq);
        if (!has_next) break;
        if (!keep) {
#pragma unroll
        for (int a = 0; a < 2; ++a)
#pragma unroll
            for (int b = 0; b < 2; ++b)
#pragma unroll
                for (int m = 0; m < 4; ++m)
#pragma unroll
                    for (int n = 0; n < 2; ++n) acc[a][b][m][n] = (f32x4){0.f, 0.f, 0.f, 0.f}; }
        cur = nxt; cA = nA; cB = nB; ++ui;
        if (wr == 1) PG8_BAR;
    }
    PG8_WAIT_V(0);
    PG8_BAR;
#undef PG8_SA
#undef PG8_SB
#undef PG8_STAGE
#undef PG8_LDA
#undef PG8_LDB
#undef PG8_MMA
#undef PG8_WAIT_V
#undef PG8_WAIT_L
#undef PG8_BAR
#undef PG8_SCHED
#undef PG8_GOFFS
#undef PG8_A1
}
}

using pg8::GUnit;
#define EPI_LOOP for (int ai = 0; ai < 2; ++ai) _Pragma("unroll") for (int m = 0; m < 4; ++m) _Pragma("unroll") for (int bj = 0; bj < 2; ++bj)
#define EPI_ARGS const f32x4 (&acc)[2][2][4][2], const GUnit& u, int wr, int wc, int fr, int fq

struct EpiInproj {
    static constexpr bool CHAIN = false;
    bf16* cols; float* side;
    __device__ __forceinline__ void operator()(EPI_ARGS) const {
        const int row0 = u.pm * 256 + wr * 64 + fr, cw = wc * 32 + 8 * fq;
        if (u.pn < 37) {
            const bool sg = u.pn >= 25;
#pragma unroll
            EPI_LOOP { f32x4 v0 = acc[ai][bj][m][0], v1 = acc[ai][bj][m][1];
                if (sg) {
#pragma unroll
                    for (int j = 0; j < 4; ++j) { v0[j] = sigmoidf_(v0[j]); v1[j] = sigmoidf_(v1[j]); } }
                u32x4 w; w.x = pk2(v0[0], v0[1]); w.y = pk2(v0[2], v0[3]); w.z = pk2(v1[0], v1[1]); w.w = pk2(v1[2], v1[3]);
                *(u32x4*)(cols + (size_t)(row0 + ai * 128 + m * 16) * NCB + u.pn * 256 + bj * 128 + cw) = w; }
        } else {
#pragma unroll
            EPI_LOOP { float* p = side + (size_t)(row0 + ai * 128 + m * 16) * 256 + bj * 128 + cw;
                *(f32x4*)p = acc[ai][bj][m][0]; *(f32x4*)(p + 4) = acc[ai][bj][m][1]; }
        }
    }
};
struct EpiLora {
    static constexpr bool CHAIN = false;
    float* rlogw; bf16* rkdir; bf16* rkka; bf16* rg; const bf16* rkv; const bf16* rkk; const float* w0; const float* a0; const float* k_a;
    __device__ __forceinline__ void operator()(EPI_ARGS) const {
        const int row0 = u.pm * 256 + wr * 64 + fr, cw = wc * 32 + 8 * fq;
        if (u.pn < 4) {
            f32x4 wb[2][2];
#pragma unroll
            for (int bj = 0; bj < 2; ++bj) { wb[bj][0] = *(const f32x4*)(w0 + u.pn * 256 + bj * 128 + cw); wb[bj][1] = *(const f32x4*)(w0 + u.pn * 256 + bj * 128 + cw + 4); }
#pragma unroll
            EPI_LOOP { const int col = u.pn * 256 + bj * 128 + cw; const size_t row = (size_t)(row0 + ai * 128 + m * 16);
                f32x4 v0 = acc[ai][bj][m][0] + wb[bj][0], v1 = acc[ai][bj][m][1] + wb[bj][1];
#pragma unroll
                for (int j = 0; j < 4; ++j) { v0[j] = -__expf(-softplusf_(-v0[j]) - 0.5f); v1[j] = -__expf(-softplusf_(-v1[j]) - 0.5f); }
                *(f32x4*)(rlogw + row * 1024 + col) = v0; *(f32x4*)(rlogw + row * 1024 + col + 4) = v1; }
        } else if (u.pn < 8) {
            f32x4 pb0[2], pb1[2], pk0[2], pk1[2];
#pragma unroll
            for (int bj = 0; bj < 2; ++bj) { const int col = (u.pn - 4) * 256 + bj * 128 + cw, ch = col & 511;
                pb0[bj] = *(const f32x4*)(a0 + col); pb1[bj] = *(const f32x4*)(a0 + col + 4); pk0[bj] = *(const f32x4*)(k_a + ch); pk1[bj] = *(const f32x4*)(k_a + ch + 4); }
#pragma unroll
            EPI_LOOP { const int col = (u.pn - 4) * 256 + bj * 128 + cw, ch = col & 511; const size_t row = (size_t)(row0 + ai * 128 + m * 16);
                const f32x4 b0 = pb0[bj], b1 = pb1[bj], ka0 = pk0[bj], ka1 = pk1[bj];
                float a[8], kv[8], kkv[8], kd[8], ka[8];
#pragma unroll
                for (int j = 0; j < 4; ++j) { a[j] = sigmoidf_(acc[ai][bj][m][0][j] + b0[j]); a[4 + j] = sigmoidf_(acc[ai][bj][m][1][j] + b1[j]); }
                unpack8(*(const u32x4*)(rkv + row * 1536 + 512 + ch), kv); unpack8(*(const u32x4*)(rkk + row * 512 + ch), kkv);
#pragma unroll
                for (int j = 0; j < 8; ++j) { const float kaj = j < 4 ? ka0[j] : ka1[j - 4]; kd[j] = kv[j] * (1.f + (a[j] - 1.f) * kaj); ka[j] = kkv[j] * a[j]; }
                *(u32x4*)(rkdir + row * 1024 + col) = pack8(kd); *(u32x4*)(rkka + row * 1024 + col) = pack8(ka); }
        } else {
#pragma unroll
            EPI_LOOP { const int col = (u.pn - 8) * 256 + bj * 128 + cw; const size_t row = (size_t)(row0 + ai * 128 + m * 16);
                const f32x4 v0 = acc[ai][bj][m][0], v1 = acc[ai][bj][m][1]; u32x4 w; w.x = pk2(v0[0], v0[1]); w.y = pk2(v0[2], v0[3]); w.z = pk2(v1[0], v1[1]); w.w = pk2(v1[2], v1[3]);
                *(u32x4*)(rg + row * 512 + col) = w; }
        }
    }
};
struct EpiBranch {
    static constexpr bool CHAIN = true;
    const bf16* cols; bf16* merged;
    __device__ __forceinline__ bool chain(f32x4 (&acc)[2][2][4][2], const GUnit& u, int wr, int wc, int fr, int fq) const {
        const int br = u.aux; if (br >= 2) return false;
        const int row0 = u.pm * 256 + wr * 64 + fr, cw = wc * 32 + 8 * fq;
#pragma unroll
        EPI_LOOP { const int col = u.pn * 256 + bj * 128 + cw; const size_t row = (size_t)(row0 + ai * 128 + m * 16);
            float g[8], gn[8]; unpack8(*(const u32x4*)(cols + row * NCB + C_GATE + br * 1024 + col), g); unpack8(*(const u32x4*)(cols + row * NCB + C_GATE + (br + 1) * 1024 + col), gn);
#pragma unroll
            for (int j = 0; j < 4; ++j) { acc[ai][bj][m][0][j] *= g[j] * __builtin_amdgcn_rcpf(fmaxf(gn[j], 1e-20f)); acc[ai][bj][m][1][j] *= g[4 + j] * __builtin_amdgcn_rcpf(fmaxf(gn[4 + j], 1e-20f)); } }
        return true;
    }
    __device__ __forceinline__ void operator()(EPI_ARGS) const {
        const int row0 = u.pm * 256 + wr * 64 + fr, cw = wc * 32 + 8 * fq;
#pragma unroll
        EPI_LOOP { const int col = u.pn * 256 + bj * 128 + cw; const size_t row = (size_t)(row0 + ai * 128 + m * 16);
            float g[8]; unpack8(*(const u32x4*)(cols + row * NCB + C_GATE + 2 * 1024 + col), g);
            const f32x4 v0 = acc[ai][bj][m][0], v1 = acc[ai][bj][m][1];
            u32x4 w; w.x = pk2(v0[0] * fmaxf(g[0], 1e-20f), v0[1] * fmaxf(g[1], 1e-20f)); w.y = pk2(v0[2] * fmaxf(g[2], 1e-20f), v0[3] * fmaxf(g[3], 1e-20f));
            w.z = pk2(v1[0] * fmaxf(g[4], 1e-20f), v1[1] * fmaxf(g[5], 1e-20f)); w.w = pk2(v1[2] * fmaxf(g[6], 1e-20f), v1[3] * fmaxf(g[7], 1e-20f)); *(u32x4*)(merged + row * 1024 + col) = w; }
    }
};
struct EpiWo {
    static constexpr bool CHAIN = false;
    const float* xf; float* pre;
    __device__ __forceinline__ void operator()(EPI_ARGS) const {
        const int row0 = u.pm * 256 + wr * 64 + fr, cw = wc * 32 + 8 * fq;
        f32x4 nx[2][2];
#define EW_LD(ai_, m_) do { _Pragma("unroll") for (int bj = 0; bj < 2; ++bj) { const size_t o_ = (size_t)(row0 + (ai_) * 128 + (m_) * 16) * 1024 + u.pn * 256 + bj * 128 + cw; \
            nx[bj][0] = *(const f32x4*)(xf + o_); nx[bj][1] = *(const f32x4*)(xf + o_ + 4); } } while (0)
        EW_LD(0, 0);
#pragma unroll
        for (int ai = 0; ai < 2; ++ai)
#pragma unroll
        for (int m = 0; m < 4; ++m) { const f32x4 c00 = nx[0][0], c01 = nx[0][1], c10 = nx[1][0], c11 = nx[1][1];
            if (!(ai == 1 && m == 3)) { if (m < 3) EW_LD(ai, m + 1); else EW_LD(ai + 1, 0); }
#pragma unroll
            for (int bj = 0; bj < 2; ++bj) { const size_t o = (size_t)(row0 + ai * 128 + m * 16) * 1024 + u.pn * 256 + bj * 128 + cw;
                *(f32x4*)(pre + o) = (bj ? c10 : c00) * DN_ALPHA + acc[ai][bj][m][0]; *(f32x4*)(pre + o + 4) = (bj ? c11 : c01) * DN_ALPHA + acc[ai][bj][m][1]; } }
#undef EW_LD
    }
};
struct EpiPlg {
    static constexpr bool CHAIN = false;
    bf16* sg;
    __device__ __forceinline__ void operator()(EPI_ARGS) const {
        const int row0 = u.pm * 256 + wr * 64 + fr, cw = wc * 32 + 8 * fq;
#pragma unroll
        EPI_LOOP { const size_t o = (size_t)(row0 + ai * 128 + m * 16) * 1024 + u.pn * 256 + bj * 128 + cw; const f32x4 v0 = acc[ai][bj][m][0], v1 = acc[ai][bj][m][1];
            u32x4 w; w.x = pk2(sigmoidf_(v0[0]), sigmoidf_(v0[1])); w.y = pk2(sigmoidf_(v0[2]), sigmoidf_(v0[3])); w.z = pk2(sigmoidf_(v1[0]), sigmoidf_(v1[1])); w.w = pk2(sigmoidf_(v1[2]), sigmoidf_(v1[3]));
            *(u32x4*)(sg + o) = w; }
    }
};
struct EpiGu {
    static constexpr bool CHAIN = false;
    bf16* act; const float* b_gu;
    __device__ __forceinline__ void operator()(EPI_ARGS) const {
        const int row0 = u.pm * 256 + wr * 64 + fr, cw = wc * 32 + 8 * fq, c0 = u.pn * 128 + cw; const float* bg = b_gu + (size_t)u.aux * 2048;
        const f32x4 bg0 = *(const f32x4*)(bg + c0), bg1 = *(const f32x4*)(bg + c0 + 4), bu0 = *(const f32x4*)(bg + 1024 + c0), bu1 = *(const f32x4*)(bg + 1024 + c0 + 4);
#pragma unroll
        for (int ai = 0; ai < 2; ++ai)
#pragma unroll
            for (int m = 0; m < 4; ++m) { float o[8];
#pragma unroll
                for (int j = 0; j < 8; ++j) { float gl = (j < 4 ? acc[ai][0][m][0][j] + bg0[j] : acc[ai][0][m][1][j - 4] + bg1[j - 4]), up = (j < 4 ? acc[ai][1][m][0][j] + bu0[j] : acc[ai][1][m][1][j - 4] + bu1[j - 4]);
                    gl = fminf(gl, 7.0f); up = fminf(fmaxf(up, -7.0f), 7.0f); o[j] = (up + 1.0f) * gl * sigmoidf_(1.702f * gl); }
                *(u32x4*)(act + (size_t)(row0 + ai * 128 + m * 16) * 1024 + c0) = pack8(o); }
    }
};
enum { K_DN = 0, K_PLE = 1, K_PLG = 2 };
struct EpiGuPlg {
    static constexpr bool CHAIN = false;
    EpiGu gu; EpiPlg plg;
    __device__ __forceinline__ void operator()(EPI_ARGS) const { if (u.kind == K_PLG) plg(acc, u, wr, wc, fr, fq); else gu(acc, u, wr, wc, fr, fq); }
};
struct EpiDnPle {
    static constexpr bool CHAIN = false;
    bf16* ye; const float* b_dn; bf16* pleb; const bf16* sg; bf16* sgw;
    __device__ __forceinline__ void operator()(EPI_ARGS) const {
        const int row0 = u.pm * 256 + wr * 64 + fr, cw = wc * 32 + 8 * fq;
        if (u.kind == K_DN) { const float* bd = b_dn + (size_t)u.aux * 1024;
            f32x4 bb[2][2];
#pragma unroll
            for (int bj = 0; bj < 2; ++bj) { bb[bj][0] = *(const f32x4*)(bd + u.pn * 256 + bj * 128 + cw); bb[bj][1] = *(const f32x4*)(bd + u.pn * 256 + bj * 128 + cw + 4); }
#pragma unroll
            EPI_LOOP { const int col = u.pn * 256 + bj * 128 + cw; const f32x4 v0 = acc[ai][bj][m][0] + bb[bj][0], v1 = acc[ai][bj][m][1] + bb[bj][1];
                u32x4 w; w.x = pk2(v0[0], v0[1]); w.y = pk2(v0[2], v0[3]); w.z = pk2(v1[0], v1[1]); w.w = pk2(v1[2], v1[3]);
                *(u32x4*)(ye + (size_t)(row0 + ai * 128 + m * 16) * 1024 + col) = w; }
        } else if (u.kind == K_PLG) { EpiPlg{sgw}(acc, u, wr, wc, fr, fq);
        } else {
            u32x4 ng[2];
#define EP_LD(ai_, m_) do { _Pragma("unroll") for (int bj = 0; bj < 2; ++bj) ng[bj] = *(const u32x4*)(sg + (size_t)(row0 + (ai_) * 128 + (m_) * 16) * 1024 + u.pn * 256 + bj * 128 + cw); } while (0)
            EP_LD(0, 0);
#pragma unroll
            for (int ai = 0; ai < 2; ++ai)
#pragma unroll
            for (int m = 0; m < 4; ++m) { const u32x4 cg0 = ng[0], cg1 = ng[1];
                if (!(ai == 1 && m == 3)) { if (m < 3) EP_LD(ai, m + 1); else EP_LD(ai + 1, 0); }
#pragma unroll
              for (int bj = 0; bj < 2; ++bj) { const size_t o = (size_t)(row0 + ai * 128 + m * 16) * 1024 + u.pn * 256 + bj * 128 + cw; float s[8]; unpack8(bj ? cg1 : cg0, s);
                const f32x4 v0 = acc[ai][bj][m][0], v1 = acc[ai][bj][m][1];
                u32x4 w; w.x = pk2(v0[0] * s[0], v0[1] * s[1]); w.y = pk2(v0[2] * s[2], v0[3] * s[3]); w.z = pk2(v1[0] * s[4], v1[1] * s[5]); w.w = pk2(v1[2] * s[6], v1[3] * s[7]);
                *(u32x4*)(pleb + o) = w; } }
#undef EP_LD
        }
    }
};

struct SchedPlain {
    const char* A; const char* B; int lda, ldb, nt, nM, nN, G, c;
    __device__ __forceinline__ bool next(int i, GUnit& u) const {
        const int L = i * G + c; if (L >= nM * nN) return false;
        pg8::tile_order(L, nM, nN, u.pm, u.pn);
        u.A = A + (size_t)u.pm * 256 * lda; u.B = B + (size_t)u.pn * 256 * ldb; u.nt = nt; u.arow0 = 0; u.kind = 0; u.aux = 0; return true;
    }
};
struct SchedBranch {
    const char* ymix; const char* wbr; int G, c;
    __device__ __forceinline__ bool next(int i, GUnit& u) const {
        const int tile = (i / 3) * G + c, br = i % 3; if (tile >= 256) return false;
        pg8::tile_order(tile, 64, 4, u.pm, u.pn);
        const int k0 = br == 0 ? 0 : (br == 1 ? 512 : 1024);
        u.A = ymix + (size_t)u.pm * 256 * 4096 + k0 * 2; u.B = wbr + (size_t)u.pn * 256 * 4096 + k0 * 2; u.nt = br == 2 ? 16 : 8; u.arow0 = 0; u.kind = 0; u.aux = br; return true;
    }
};
struct MoeTab { const LAS int* pstart; const LAS int* panel_e; int npanels; };
struct SchedGu {
    const char* x1b; const char* wgu; const char* wplg; MoeTab T; int G, c;
    static __device__ __forceinline__ int plg_in_gu(int npanels, int G) { const int r = (npanels * 8) % G; const int x = r ? G - r : 0; return x < 256 ? x : 256; }
    __device__ __forceinline__ bool next(int i, GUnit& u) const {
        const int L = i * G + c, n1 = T.npanels * 8;
        if (L >= n1) { const int x = L - n1; if (x >= plg_in_gu(T.npanels, G)) return false;
            pg8::tile_order(x, 64, 4, u.pm, u.pn);
            u.A = x1b; u.B = wplg + (size_t)u.pn * 256 * 2048; u.nt = 16; u.arow0 = MPAD + u.pm * 256; u.kind = K_PLG; u.aux = 0; return true; }
        pg8::tile_order(L, T.npanels, 8, u.pm, u.pn);
        const int e = T.panel_e[u.pm];
        u.A = x1b; u.B = wgu + (size_t)e * W_GU_SZ + (size_t)u.pn * 256 * 2048; u.nt = 16; u.arow0 = u.pm * 256; u.kind = 0; u.aux = e; return true;
    }
};
struct SchedDnPle {
    const char* act; const char* wdn; const char* pb; const char* wpl; const char* x1b; const char* wplg; MoeTab T; int G, c;
    __device__ __forceinline__ bool next(int i, GUnit& u) const {
        const int L = i * G + c, n1 = T.npanels * 4;
        if (L < n1) { pg8::tile_order(L, T.npanels, 4, u.pm, u.pn); const int e = T.panel_e[u.pm];
            u.A = act + (size_t)u.pm * 256 * 2048; u.B = wdn + (size_t)e * W_SQ_SZ + (size_t)u.pn * 256 * 2048; u.nt = 16; u.arow0 = 0; u.kind = K_DN; u.aux = e; return true; }
        const int nmine = c < n1 ? (n1 - c + G - 1) / G : 0, j = i - nmine, r = n1 % G, rho = (c - r + G) % G, XG = SchedGu::plg_in_gu(T.npanels, G), NP = 256 - XG;
        int x; bool plg;
        if (rho < NP) { if (j > 1) return false; x = XG + rho; plg = (j == 0); } else { if (j > 0) return false; x = rho - NP; plg = false; }
        pg8::tile_order(x, 64, 4, u.pm, u.pn);
        if (plg) { u.A = x1b + (size_t)u.pm * 256 * 2048; u.B = wplg + (size_t)u.pn * 256 * 2048; u.nt = 16; u.arow0 = 0; u.kind = K_PLG; u.aux = 0; return true; }
        u.A = pb + (size_t)u.pm * 256 * 2048; u.B = wpl + (size_t)u.pn * 256 * 2048; u.nt = 4; u.arow0 = 0; u.kind = K_PLE; u.aux = 0; return true;
    }
};

struct TrDesc { const float* W; bf16* WT; int Nsrc, k0, srccol, dstK, n0, dk0; };
__device__ __forceinline__ void tr_load(const TrDesc& d, f32x4 (&v)[16], int lane) {
    const int kr = lane >> 4; const float* p = d.W + (size_t)(d.k0 + kr) * d.Nsrc + (d.srccol >= 0 ? d.srccol : 0);
#pragma unroll
    for (int t = 0; t < 16; ++t) v[t] = d.srccol >= 0 ? __builtin_nontemporal_load((const f32x4*)(p + (size_t)(4 * t) * d.Nsrc)) : (f32x4){0.f, 0.f, 0.f, 0.f};
}
__device__ __forceinline__ void tr_proc(const TrDesc& d, const f32x4 (&v)[16], LAS float* scr, int lane) {
    const int q = lane & 15, kr = lane >> 4;
#pragma unroll
    for (int t = 0; t < 16; ++t) { const int kk = 4 * t + kr; *(LAS f32x4*)(scr + kk * 64 + ((q ^ ((kk >> 3) & 7)) << 2)) = v[t]; }
    LDS_WAIT(); asm volatile("" ::: "memory");
    const int c = lane & 7;
#pragma unroll
    for (int jj = 0; jj < 8; ++jj) { const int n = (lane >> 3) + 8 * jj; const LAS float* sp = scr + (8 * c) * 64 + ((((n >> 2) ^ c) & 15) << 2) + (n & 3);
        u32x4 o; o.x = pk2(sp[0], sp[64]); o.y = pk2(sp[2 * 64], sp[3 * 64]); o.z = pk2(sp[4 * 64], sp[5 * 64]); o.w = pk2(sp[6 * 64], sp[7 * 64]);
        __builtin_nontemporal_store(o, (u32x4*)(d.WT + (size_t)(d.n0 + n) * d.dstK + d.dk0 + 8 * c)); }
    LDS_WAIT(); asm volatile("" ::: "memory");
}
template <class DescFn> __device__ __forceinline__ void tr_run(int n, int first, int stride, const DescFn& fn, LAS float* scr, int lane) {
    int it = first; if (it >= n) return;
    TrDesc dA = fn(it), dB = dA; f32x4 vA[16], vB[16]; tr_load(dA, vA, lane);
    for (;;) {
        const int it2 = it + stride; const bool has2 = it2 < n; if (has2) { dB = fn(it2); tr_load(dB, vB, lane); }
        tr_proc(dA, vA, scr, lane); if (!has2) break;
        const int it3 = it2 + stride; const bool has3 = it3 < n; if (has3) { dA = fn(it3); tr_load(dA, vA, lane); }
        tr_proc(dB, vB, scr, lane); if (!has3) break;
        it = it3;
    }
}
__device__ __forceinline__ int win_src(int n) {
    if (n < 2048) return n;
    if (n < 3584) return n - 2048 + 2064;
    if (n < 3712) return n - 3584 + 3728;
    if (n < 3840) return n - 3712 + 3856;
    if (n < 4864) return n - 3840 + 3984;
    if (n < 6400) return n - 4864 + 5008;
    if (n < 9472) return n - 6400 + 6576;
    if (n < 9488) return n - 9472 + 2048;
    if (n < 9520) return n - 9488 + 6544;
    if (n < 9648) return n - 9520 + 3600;
    return -1;
}
__device__ __forceinline__ void ln_row(f32x4 (&v)[4], const f32x4 (&gg)[4], const f32x4 (&bb)[4], float* of, bf16* ob, int lane) {
    float s = 0.f;
#pragma unroll
    for (int j = 0; j < 4; ++j) s += (v[j].x + v[j].y) + (v[j].z + v[j].w);
    const float mean = wave_sum(s) * (1.f / DM); float s2 = 0.f;
#pragma unroll
    for (int j = 0; j < 4; ++j) { v[j] = v[j] - mean; s2 += (v[j].x * v[j].x + v[j].y * v[j].y) + (v[j].z * v[j].z + v[j].w * v[j].w); }
    const float rstd = 1.f / sqrtf(wave_sum(s2) * (1.f / DM) + LN_EPS);
#pragma unroll
    for (int j = 0; j < 4; ++j) { const f32x4 o = v[j] * rstd * gg[j] + bb[j];
        *(f32x4*)(of + 256 * j + 4 * lane) = o; u32x2 w; w.x = pk2(o.x, o.y); w.y = pk2(o.z, o.w); *(u32x2*)(ob + 256 * j + 4 * lane) = w; }
}
__device__ __forceinline__ void phase_prologue(Frame& F, const Params& P) {
    LAS float* scr = (LAS float*)(F.lds + F.wave * 16384);
    const int gw = F.vcu * NWAVES + F.wave, NGW = F.G * NWAVES; int lane = F.lane; asm volatile("" : "+v"(lane)); const int q4 = 4 * (lane & 15);
    int rot = 0;
#define ITEMS(n, ...) do { const int _n = (n); tr_run(_n, (gw + NGW - rot) % NGW, NGW, [&](int it) -> TrDesc { __VA_ARGS__ }, scr, lane); rot = (rot + _n) % NGW; } while (0)
    for (int l = 0; l < DEPTH; ++l) {
        { const float* W = P.in[I_W_IN] + (size_t)l * 1024 * 9648; bf16* D = (bf16*)(P.ws + WS_W_IN + l * W_IN_SZ);
          ITEMS(16 * 152, const int kb = it / 152, nb = it % 152; return TrDesc{W, D, 9648, kb * 64, win_src(nb * 64 + q4), 1024, nb * 64, kb * 64};); }
        { const float* W = P.in[I_W_BR] + (size_t)l * 2048 * 1024; bf16* D = (bf16*)(P.ws + WS_W_BR + l * W_BR_SZ);
          ITEMS(32 * 16, const int kb = it / 16, nb = it % 16; return TrDesc{W, D, 1024, kb * 64, nb * 64 + q4, 2048, nb * 64, kb * 64};); }
        { const float* W = P.in[I_W_O] + (size_t)l * 1024 * 1024; bf16* D = (bf16*)(P.ws + WS_W_O + l * W_SQ_SZ);
          ITEMS(16 * 16, const int kb = it / 16, nb = it % 16; return TrDesc{W, D, 1024, kb * 64, nb * 64 + q4, 1024, nb * 64, kb * 64};); }
        { const float* W = P.in[I_W_PLG] + (size_t)l * 1024 * 1024; bf16* D = (bf16*)(P.ws + WS_W_PLG + l * W_SQ_SZ);
          ITEMS(16 * 16, const int kb = it / 16, nb = it % 16; return TrDesc{W, D, 1024, kb * 64, nb * 64 + q4, 1024, nb * 64, kb * 64};); }
        { const float* W = P.in[I_W_PL] + (size_t)l * 256 * 1024; bf16* D = (bf16*)(P.ws + WS_W_PL + l * W_PL_SZ);
          ITEMS(4 * 16, const int kb = it / 16, nb = it % 16; return TrDesc{W, D, 1024, kb * 64, nb * 64 + q4, 1024, nb * 64, kb * 64};); }
        { bf16* D = (bf16*)(P.ws + WS_W_LORA + l * W_LORA_SZ); const float* wup = P.in[I_R_WUP]; const float* aup = P.in[I_R_AUP]; const float* gup = P.in[I_R_GUP];
          ITEMS(6 * 40, const int kb = it / 40, nb = it % 40; const int rb = nb / 8;
              const float* W = nullptr; int kl = 0;
              if (rb < 4) { if (kb == rb) { W = (rb < 2 ? wup : aup) + ((size_t)l * 2 + (rb & 1)) * 64 * 512; kl = 0; } }
              else if (kb >= 4) { W = gup + (size_t)l * 128 * 512; kl = (kb - 4) * 64; }
              return TrDesc{W ? W : gup, D, 512, kl, W ? (nb % 8) * 64 + q4 : -1, 384, nb * 64, kb * 64};); }
        { const float* W = P.in[I_W_GU] + (size_t)l * 32 * 1024 * 2048; bf16* D = (bf16*)(P.ws + WS_W_GU + (size_t)l * 32 * W_GU_SZ);
          ITEMS(32 * 16 * 32, const int e = it / 512, r = it % 512, kb = r / 32, nb = r % 32; const int n0 = nb * 64, pn = n0 >> 8, bj = (n0 >> 7) & 1, j0 = n0 & 127;
              return TrDesc{W + (size_t)e * 1024 * 2048, D + (size_t)e * 2048 * 1024, 2048, kb * 64, bj * 1024 + pn * 128 + j0 + q4, 1024, n0, kb * 64};); }
        { const float* W = P.in[I_W_DN] + (size_t)l * 32 * 1024 * 1024; bf16* D = (bf16*)(P.ws + WS_W_DN + (size_t)l * 32 * W_SQ_SZ);
          ITEMS(32 * 16 * 16, const int e = it / 256, r = it % 256, kb = r / 16, nb = r % 16;
              return TrDesc{W + (size_t)e * 1024 * 1024, D + (size_t)e * 1024 * 1024, 1024, kb * 64, nb * 64 + q4, 1024, nb * 64, kb * 64};); }
    }
#undef ITEMS
    { f32x4 gg[4], bb[4], vn[4];
#pragma unroll
      for (int j = 0; j < 4; ++j) { gg[j] = *(const f32x4*)(P.in[I_LNIN_G] + 256 * j + 4 * lane); bb[j] = *(const f32x4*)(P.in[I_LNIN_B] + 256 * j + 4 * lane); vn[j] = (f32x4){0.f, 0.f, 0.f, 0.f}; }
      if (gw < MTOK) {
#pragma unroll
          for (int j = 0; j < 4; ++j) vn[j] = *(const f32x4*)(P.in[I_X] + (size_t)gw * DM + 256 * j + 4 * lane); }
      for (int m = gw; m < MTOK; m += NGW) { f32x4 v[4];
#pragma unroll
          for (int j = 0; j < 4; ++j) v[j] = vn[j];
          if (m + NGW < MTOK) {
#pragma unroll
              for (int j = 0; j < 4; ++j) vn[j] = *(const f32x4*)(P.in[I_X] + (size_t)(m + NGW) * DM + 256 * j + 4 * lane); }
          ln_row(v, gg, bb, (float*)(P.ws + A_XF) + (size_t)m * DM, (bf16*)(P.ws + A_XB) + (size_t)m * DM, lane); } }
    for (int r0 = gw; r0 < DEPTH * MTOK; r0 += 4 * NGW) { f32x4 v[4];
#pragma unroll
        for (int k = 0; k < 4; ++k) v[k] = *(const f32x4*)(P.in[I_P] + (size_t)(r0 + k * NGW) * PLE + 4 * lane);
#pragma unroll
        for (int k = 0; k < 4; ++k) { u32x2 w; w.x = pk2(v[k].x, v[k].y); w.y = pk2(v[k].z, v[k].w); *(u32x2*)((bf16*)(P.ws + A_PB) + (size_t)(r0 + k * NGW) * 1024 + 4 * lane) = w; } }
}

__device__ __forceinline__ void phase_prep(Frame& F, const Params& P, int l) {
    const int gw = F.vcu * NWAVES + F.wave, NGW = F.G * NWAVES; int lane = F.lane; asm volatile("" : "+v"(lane));
    const bf16* cols = (const bf16*)(P.ws + A_COLS); const float* side = (const float*)(P.ws + A_SIDE);
    bf16* gqkv = (bf16*)(P.ws + A_GQKV); float* gsc = (float*)(P.ws + A_GSC); bf16* sxbc = (bf16*)(P.ws + A_SXBC); float* ssc = (float*)(P.ws + A_SSC);
    bf16* rkv = (bf16*)(P.ws + A_RKV); bf16* rkk = (bf16*)(P.ws + A_RKK); bf16* lin = (bf16*)(P.ws + A_LIN);
    const float* gconv = P.in[I_GDN_CONV] + (size_t)l * 5 * 1536; const float* sconv = P.in[I_S_CONV] + (size_t)l * 5 * 1536; const float* sconvb = P.in[I_S_CONVB] + (size_t)l * 1536;
    const float* mup = P.in[I_R_MUP] + (size_t)l * 1920; const float* mun = P.in[I_R_MUN] + (size_t)l * 1920; const float* k_k = P.in[I_R_KK] + (size_t)l * 512;
    for (int g8 = gw; g8 < MTOK / 8; g8 += NGW) {
        const int m0 = g8 * 8, t0 = m0 % SEQ; const bf16* crow = cols + (size_t)m0 * NCB;
        u32x4 xn[12];
#define PREP_LD(part_) do { const int p_ = (part_); const bf16* src_ = crow + (p_ < 3 ? C_GQKV + p_ * 512 : C_SXBC + (p_ - 3) * 512) + 8 * lane; \
            _Pragma("unroll") for (int rr = 0; rr < 12; ++rr) { const int tt = t0 - 2 + rr; xn[rr] = (tt >= 0 && tt < SEQ) ? *(const u32x4*)(src_ + (ptrdiff_t)(rr - 2) * NCB) : (u32x4){0u, 0u, 0u, 0u}; } } while (0)
        PREP_LD(0);
#pragma unroll 1
        for (int part = 0; part < 6; ++part) { const bool isg = part < 3; const int pp = isg ? part : part - 3, ch = pp * 512 + 8 * lane; const float* cw = (isg ? gconv : sconv) + ch;
            u32x4 xr[12];
#pragma unroll
            for (int rr = 0; rr < 12; ++rr) xr[rr] = xn[rr];
            if (part < 5) PREP_LD(part + 1);
            float w[5][8];
#pragma unroll
            for (int tap = 0; tap < 5; ++tap) { const f32x4 w0 = *(const f32x4*)(cw + tap * 1536), w1 = *(const f32x4*)(cw + tap * 1536 + 4);
#pragma unroll
                for (int j = 0; j < 4; ++j) { w[tap][j] = w0[j]; w[tap][4 + j] = w1[j]; } }
            float bias[8];
#pragma unroll
            for (int j = 0; j < 8; ++j) bias[j] = 0.f;
            if (!isg) { const f32x4 b0 = *(const f32x4*)(sconvb + ch), b1 = *(const f32x4*)(sconvb + ch + 4);
#pragma unroll
                for (int j = 0; j < 4; ++j) { bias[j] = b0[j]; bias[4 + j] = b1[j]; } }
#pragma unroll
            for (int tk = 0; tk < 8; ++tk) { float o[8];
#pragma unroll
                for (int j = 0; j < 8; ++j) o[j] = bias[j];
#pragma unroll
                for (int tap = 0; tap < 5; ++tap) { float x[8]; unpack8(xr[tk + tap], x);
#pragma unroll
                    for (int j = 0; j < 8; ++j) o[j] += x[j] * w[tap][j]; }
                float ss = 0.f;
#pragma unroll
                for (int j = 0; j < 8; ++j) { o[j] = siluf_(o[j]); ss += o[j] * o[j]; }
                if (isg && pp < 2) { ss += __shfl_xor(ss, 1); ss += __shfl_xor(ss, 2); ss += __shfl_xor(ss, 4); ss += __shfl_xor(ss, 8);
                    const float sc = rsqrtf(ss + 1e-6f) * (pp == 0 ? 0.08838834764831845f : 1.0f);
#pragma unroll
                    for (int j = 0; j < 8; ++j) o[j] *= sc; }
                *(u32x4*)((isg ? gqkv : sxbc) + (size_t)(m0 + tk) * 1536 + ch) = pack8(o); } }
#undef PREP_LD
        { const int tk = lane >> 3, i8 = lane & 7; const size_t m = (size_t)m0 + tk;
          { const float r0 = side[m * 256 + i8], r1 = side[m * 256 + 8 + i8];
            gsc[m * 16 + i8] = sigmoidf_(r0); gsc[m * 16 + 8 + i8] = -__expf(P.in[I_GDN_ALOG][l * 8 + i8]) * softplusf_(r1 + P.in[I_GDN_DTB][l * 8 + i8]); }
#pragma unroll
          for (int q = 0; q < 4; ++q) { const int i = i8 + 8 * q; const float dt = softplusf_(side[m * 256 + 16 + i] + P.in[I_S_DTB][l * 32 + i]);
              ssc[m * 64 + i] = dt; ssc[m * 64 + 32 + i] = -__expf(P.in[I_S_ALOG][l * 32 + i]) * dt; } }
        f32x2 lw[10]; unsigned la[10], lg[10];
#pragma unroll
        for (int rr = 0; rr < 10; ++rr) { const int tt = t0 - 1 + rr; const bool ok = tt >= 0 && tt < SEQ; const ptrdiff_t mr = (ptrdiff_t)m0 - 1 + rr;
            lw[rr] = ok ? *(const f32x2*)(side + mr * 256 + 48 + 2 * lane) : (f32x2){0.f, 0.f};
            la[rr] = ok ? *(const unsigned*)(cols + mr * NCB + C_RAL + 2 * lane) : 0u; lg[rr] = ok ? *(const unsigned*)(cols + mr * NCB + C_RAL + 128 + 2 * lane) : 0u; }
        u32x4 yn[10];
#define PREP_LR(part_) do { const bf16* src_ = crow + C_RRKV + (part_) * 512 + 8 * lane; \
            _Pragma("unroll") for (int rr = 0; rr < 10; ++rr) { const int tt = t0 - 1 + rr; yn[rr] = (tt >= 0 && tt < SEQ) ? *(const u32x4*)(src_ + (ptrdiff_t)(rr - 1) * NCB) : (u32x4){0u, 0u, 0u, 0u}; } } while (0)
        PREP_LR(0);
#pragma unroll 1
        for (int part = 0; part < 3; ++part) { const int ch = part * 512 + 8 * lane;
            u32x4 xr[10];
#pragma unroll
            for (int rr = 0; rr < 10; ++rr) xr[rr] = yn[rr];
            if (part < 2) PREP_LR(part + 1);
            const f32x4 mp0 = *(const f32x4*)(mup + ch), mp1 = *(const f32x4*)(mup + ch + 4), mn0 = *(const f32x4*)(mun + ch), mn1 = *(const f32x4*)(mun + ch + 4);
            const f32x4 kk0 = *(const f32x4*)(k_k + 8 * lane), kk1 = *(const f32x4*)(k_k + 8 * lane + 4);
#pragma unroll
            for (int tk = 0; tk < 8; ++tk) { float c[8], p[8], n[8], o[8]; unpack8(xr[tk], p); unpack8(xr[tk + 1], c); unpack8(xr[tk + 2], n);
#pragma unroll
                for (int j = 0; j < 8; ++j) o[j] = c[j] + (j < 4 ? mp0[j] : mp1[j - 4]) * (p[j] - c[j]) + (j < 4 ? mn0[j] : mn1[j - 4]) * (n[j] - c[j]);
                *(u32x4*)(rkv + (size_t)(m0 + tk) * 1536 + ch) = pack8(o);
                if (part == 1) { float ss = 0.f;
#pragma unroll
                    for (int j = 0; j < 8; ++j) { o[j] *= (j < 4 ? kk0[j] : kk1[j - 4]); ss += o[j] * o[j]; }
                    ss += __shfl_xor(ss, 1); ss += __shfl_xor(ss, 2); ss += __shfl_xor(ss, 4);
                    const float sc = rsqrtf(ss + 1e-6f);
#pragma unroll
                    for (int j = 0; j < 8; ++j) o[j] *= sc;
                    *(u32x4*)(rkk + (size_t)(m0 + tk) * 512 + 8 * lane) = pack8(o); } } }
#undef PREP_LR
        { const f32x2 mp0 = *(const f32x2*)(mup + 1536 + 2 * lane), mn0 = *(const f32x2*)(mun + 1536 + 2 * lane), mp1 = *(const f32x2*)(mup + 1664 + 2 * lane), mn1 = *(const f32x2*)(mun + 1664 + 2 * lane),
                      mp2 = *(const f32x2*)(mup + 1792 + 2 * lane), mn2 = *(const f32x2*)(mun + 1792 + 2 * lane);
#pragma unroll
          for (int tk = 0; tk < 8; ++tk) { const size_t m = (size_t)m0 + tk;
              { const f32x2 c = lw[tk + 1], p = lw[tk], n = lw[tk + 2]; const float o0 = c.x + mp0.x * (p.x - c.x) + mn0.x * (n.x - c.x), o1 = c.y + mp0.y * (p.y - c.y) + mn0.y * (n.y - c.y);
                *(unsigned*)(lin + m * 384 + 2 * lane) = pk2(tanhf(o0), tanhf(o1)); }
              { const float c0 = bflo(la[tk + 1]), c1 = bfhi(la[tk + 1]), p0 = bflo(la[tk]), p1 = bfhi(la[tk]), n0 = bflo(la[tk + 2]), n1 = bfhi(la[tk + 2]);
                *(unsigned*)(lin + m * 384 + 128 + 2 * lane) = pk2(c0 + mp1.x * (p0 - c0) + mn1.x * (n0 - c0), c1 + mp1.y * (p1 - c1) + mn1.y * (n1 - c1)); }
              { const float c0 = bflo(lg[tk + 1]), c1 = bfhi(lg[tk + 1]), p0 = bflo(lg[tk]), p1 = bfhi(lg[tk]), n0 = bflo(lg[tk + 2]), n1 = bfhi(lg[tk + 2]);
                *(unsigned*)(lin + m * 384 + 256 + 2 * lane) = pk2(sigmoidf_(c0 + mp2.x * (p0 - c0) + mn2.x * (n0 - c0)), sigmoidf_(c1 + mp2.y * (p1 - c1) + mn2.y * (n1 - c1))); } } }
    }
}

__device__ __forceinline__ void ssd_scan_item(const Params& P, int item);
__device__ __forceinline__ void gdn_scan_unit(Frame& F, const Params& P, int unit, int lane);
__device__ __forceinline__ void rwkv_scan_unit(Frame& F, const Params& P, int unit, int lane);
__device__ __forceinline__ void ssd_out_unit(Frame& F, const Params& P, int l_, int u, int tid, int lane);
__device__ __forceinline__ void phase_scan_seq(Frame& F, const Params& P, int l_) {
    int lane = F.lane; asm volatile("" : "+v"(lane));
    const int xg = F.vcu >> 5, xi = F.vcu & 31;
    if (xi < 8) { const int chain = xg + 8 * (xi >> 2); gdn_scan_unit(F, P, chain * 4 + (xi & 3), lane); return; }
    if (xi < 12) { rwkv_scan_unit(F, P, xg + 8 * (xi - 8), lane); return; }
    { int tid2 = F.tid; asm volatile("" : "+v"(tid2)); for (int u = xg * 20 + (xi - 12); u < 256; u += 160) ssd_out_unit(F, P, l_, u, tid2, lane); }
}

typedef float f32x16 __attribute__((ext_vector_type(16)));
typedef short s16x4 __attribute__((ext_vector_type(4)));
#define MFMA32(X, Y, C) __builtin_amdgcn_mfma_f32_32x32x16_bf16((X), (Y), (C), 0, 0, 0)
__device__ __forceinline__ bf16x8 frag_g(const bf16* M, int ld, int row0, int k0, int lane) { return *(const bf16x8*)(M + (size_t)(row0 + (lane & 31)) * ld + k0 + 8 * (lane >> 5)); }
__device__ __forceinline__ bf16x8 frag_l(const LAS bf16* M, int ld, int row0, int k0, int lane) { return *(const LAS bf16x8*)(M + (row0 + (lane & 31)) * ld + k0 + 8 * (lane >> 5)); }
__device__ __forceinline__ bf16x8 frag_tr(const LAS bf16* T, int ld, int k0, int n0, int lane) {
    const int h = lane >> 5, blk = (lane >> 4) & 1, q = (lane & 15) >> 2, p = lane & 3;
    const LAS bf16* a = T + (k0 + 8 * h + q) * ld + n0 + 16 * blk + 4 * p;
    const s16x4 lo = __builtin_bit_cast(s16x4, __builtin_amdgcn_ds_read_tr16_b64_v4i16((LAS s16x4*)a)), hi = __builtin_bit_cast(s16x4, __builtin_amdgcn_ds_read_tr16_b64_v4i16((LAS s16x4*)(a + 4 * ld)));
    return (bf16x8){lo[0], lo[1], lo[2], lo[3], hi[0], hi[1], hi[2], hi[3]};
}
template <int KS, class FX, class FY> __device__ __forceinline__ f32x16 mma_ks(f32x16 acc, const FX& fx, const FY& fy) {
    bf16x8 xa[KS], ya[KS];
#pragma unroll
    for (int ks = 0; ks < KS; ++ks) { xa[ks] = fx(ks); ya[ks] = fy(ks); }
    __builtin_amdgcn_sched_barrier(0);
#pragma unroll
    for (int ks = 0; ks < KS; ++ks) acc = MFMA32(xa[ks], ya[ks], acc);
    return acc;
}
__device__ __forceinline__ float scan_incl(float v, int lane) {
#pragma unroll
    for (int o = 1; o < 64; o <<= 1) { const float t = __shfl_up(v, o); v += lane >= o ? t : 0.f; }
    return v;
}
__device__ __forceinline__ float scan_incl_rev(float v, int lane) {
#pragma unroll
    for (int o = 1; o < 64; o <<= 1) { const float t = __shfl_down(v, o); v += lane + o < 64 ? t : 0.f; }
    return v;
}
__device__ __forceinline__ f32x16 zero16() { f32x16 z; for (int i = 0; i < 16; ++i) z[i] = 0.f; return z; }

__device__ __forceinline__ void st_frag2(bf16* f0, const f32x16& a, int lane);
constexpr int SSD_LDB = 136, SSD_LDX = 264;
__device__ __forceinline__ void ssd_states_unit(Frame& F, const Params& P, int u, int tid, int lane) {
    const int b = u >> 8, c = (u >> 2) & 63, g = (u >> 1) & 1, hh = u & 1, wave = F.wave; const size_t m0 = (size_t)b * SEQ + c * 128;
    const bf16* sx = (const bf16*)(P.ws + A_SXBC); const float* ssc = (const float*)(P.ws + A_SSC);
    LAS bf16* Bl = (LAS bf16*)(F.lds); LAS bf16* Xl = (LAS bf16*)(F.lds + 34816); LAS float* wS = (LAS float*)(F.lds + 102400) + wave * 128;
    __syncthreads();
    for (int i = tid; i < 2048; i += NTHR) { const int row = i >> 4, ch = i & 15; *(LAS u32x4*)(Bl + row * SSD_LDB + ch * 8) = *(const u32x4*)(sx + (m0 + row) * 1536 + 1024 + g * 128 + ch * 8); }
    for (int i = tid; i < 4096; i += NTHR) { const int row = i >> 5, ch = i & 31; *(LAS u32x4*)(Xl + row * SSD_LDX + ch * 8) = *(const u32x4*)(sx + (m0 + row) * 1536 + g * 512 + hh * 256 + ch * 8); }
    const int hq = wave & 3, dir = wave >> 2, head = g * 8 + hh * 4 + hq;
    { const float a0 = ssc[(m0 + lane) * 64 + 32 + dir * 16 + head], a1 = ssc[(m0 + lane + 64) * 64 + 32 + dir * 16 + head];
      const float d0 = ssc[(m0 + lane) * 64 + dir * 16 + head], d1 = ssc[(m0 + lane + 64) * 64 + dir * 16 + head];
      float p0, p1, tot;
      if (dir == 0) { p0 = scan_incl(a0, lane); const float t0 = __shfl(p0, 63); p1 = scan_incl(a1, lane) + t0; tot = __shfl(p1, 63); }
      else { p1 = scan_incl_rev(a1, lane); const float t1 = __shfl(p1, 0); p0 = scan_incl_rev(a0, lane) + t1; tot = __shfl(p0, 0); }
      wS[lane] = d0 * __expf(tot - p0); wS[lane + 64] = d1 * __expf(tot - p1);
      if (lane == 0) ((float*)(P.ws + A_SDEC))[((b * 2 + dir) * 64 + (dir ? 63 - c : c)) * 16 + head] = __expf(tot); }
    __syncthreads();
    bf16* hs = (bf16*)(P.ws + A_HS) + ((size_t)(((b * 2 + dir) * 64 + (dir ? 63 - c : c)) * 16 + head)) * 8192;
#pragma unroll 1
    for (int pt = 0; pt < 2; ++pt) {
        bf16x8 Yf[8];
#pragma unroll
        for (int ks = 0; ks < 8; ++ks) { const bf16x8 raw = frag_tr(Xl, SSD_LDX, 16 * ks, hq * 64 + 32 * pt, lane);
            const f32x4 w0 = *(const LAS f32x4*)(wS + 16 * ks + 8 * (lane >> 5)), w1 = *(const LAS f32x4*)(wS + 16 * ks + 8 * (lane >> 5) + 4);
            float f[8];
#pragma unroll
            for (int j = 0; j < 8; ++j) f[j] = bf2f((unsigned short)raw[j]) * (j < 4 ? w0[j] : w1[j - 4]);
            const u32x4 pk = pack8(f); Yf[ks] = __builtin_bit_cast(bf16x8, pk); }
#pragma unroll 1
        for (int nt = 0; nt < 4; ++nt) { f32x16 acc = zero16();
            acc = mma_ks<8>(acc, [&](int ks) { return frag_tr(Bl, SSD_LDB, 16 * ks, 32 * nt, lane); }, [&](int ks) { return Yf[ks]; });
            st_frag2(hs + (pt * 8 + 2 * nt) * 512, acc, lane); }
    }
}
__device__ __forceinline__ void phase_ssd_states(Frame& F, const Params& P) {
    int lane = F.lane; asm volatile("" : "+v"(lane)); int tid = F.tid; asm volatile("" : "+v"(tid));
    for (int u = F.vcu; u < 512; u += F.G) ssd_states_unit(F, P, u, tid, lane);
}
__device__ __forceinline__ void ssd_scan_item(const Params& P, int item) {
    const int bdh = item >> 11, e4 = item & 2047, bd = bdh >> 4, h = bdh & 15;
    bf16* base = (bf16*)(P.ws + A_HS) + ((size_t)(bd * 64) * 16 + h) * 8192 + e4 * 4; const float* dec = (const float*)(P.ws + A_SDEC) + (bd * 64) * 16 + h;
    float run[4] = {0.f, 0.f, 0.f, 0.f};
#pragma unroll 1
    for (int c0 = 0; c0 < 64; c0 += 32) { u32x2 v[32]; float d[32];
#pragma unroll
        for (int j = 0; j < 32; ++j) { v[j] = *(const u32x2*)(base + (size_t)(c0 + j) * 16 * 8192); d[j] = dec[(c0 + j) * 16]; }
#pragma unroll
        for (int j = 0; j < 32; ++j) { u32x2 o; o.x = pk2(run[0], run[1]); o.y = pk2(run[2], run[3]); *(u32x2*)(base + (size_t)(c0 + j) * 16 * 8192) = o;
            run[0] = run[0] * d[j] + bflo(v[j].x); run[1] = run[1] * d[j] + bfhi(v[j].x); run[2] = run[2] * d[j] + bflo(v[j].y); run[3] = run[3] * d[j] + bfhi(v[j].y); } }
}
__device__ __forceinline__ bf16x8 frag_l_perm(const LAS bf16* M, int ld, int row0, int k0, int lane) {
    const LAS bf16* p = M + (row0 + (lane & 31)) * ld + k0 + 4 * (lane >> 5); const s16x4 lo = *(const LAS s16x4*)p, hi = *(const LAS s16x4*)(p + 8);
    return (bf16x8){lo[0], lo[1], lo[2], lo[3], hi[0], hi[1], hi[2], hi[3]};
}
constexpr int SO_G = 0, SO_C = 34816, SO_X = 69632, SO_Y = 104448, SO_SC = 141312, SO_SQ = 145408;
__device__ __forceinline__ void ssd_out_unit(Frame& F, const Params& P, int l_, int u, int tid, int lane) {
    const int b = u >> 7, c = (u >> 1) & 63, g = u & 1, wave = F.wave, h5 = lane >> 5, l31 = lane & 31; const size_t m0 = (size_t)b * SEQ + c * 128;
    const bf16* sx = (const bf16*)(P.ws + A_SXBC); const float* ssc = (const float*)(P.ws + A_SSC); const bf16* cols = (const bf16*)(P.ws + A_COLS); bf16* ymix = (bf16*)(P.ws + A_YMIX);
    LAS bf16* Gl = (LAS bf16*)(F.lds + SO_G); LAS bf16* Cl = (LAS bf16*)(F.lds + SO_C); LAS bf16* Xl = (LAS bf16*)(F.lds + SO_X); LAS bf16* Yst = (LAS bf16*)(F.lds + SO_Y + wave * 4608);
    LAS float* sumsq = (LAS float*)(F.lds + SO_SQ);
    const float* sd = P.in[I_S_D] + (size_t)l_ * 16; const float* snorm = P.in[I_S_NORM] + (size_t)l_ * 1024;
    __syncthreads();
    for (int i = tid; i < 2048; i += NTHR) { const int row = i >> 4, ch = i & 15; const bf16* src = sx + (m0 + row) * 1536 + 1024 + g * 128 + ch * 8;
        *(LAS u32x4*)(Xl + row * SSD_LDB + ch * 8) = *(const u32x4*)src; *(LAS u32x4*)(Cl + row * SSD_LDB + ch * 8) = *(const u32x4*)(src + 256); }
    __syncthreads();
    { const int lt = wave >> 1;
#pragma unroll 1
      for (int k2 = 0; k2 < 2; ++k2) { const int st = (wave & 1) * 2 + k2; f32x16 acc = zero16();
        acc = mma_ks<8>(acc, [&](int ks) { return frag_l(Xl, SSD_LDB, 32 * st, 16 * ks, lane); }, [&](int ks) { return frag_l(Cl, SSD_LDB, 32 * lt, 16 * ks, lane); });
        LAS bf16* o = Gl + (32 * lt + l31) * SSD_LDB + 32 * st + 4 * h5;
#pragma unroll
        for (int qd = 0; qd < 4; ++qd) { u32x2 w; w.x = pk2(acc[4 * qd], acc[4 * qd + 1]); w.y = pk2(acc[4 * qd + 2], acc[4 * qd + 3]); *(LAS u32x2*)(o + 8 * qd) = w; } } }
    const int hq = wave >> 2, lt = wave & 3, l = 32 * lt + l31;
    u32x4 xr[4]; float sv[8];
#define SO_PF(rr) do { _Pragma("unroll") for (int k = 0; k < 4; ++k) { const int i = tid + NTHR * k, row = i >> 4, ch = i & 15; xr[k] = *(const u32x4*)(sx + (m0 + row) * 1536 + g * 512 + (rr) * 128 + ch * 8); } \
        if (lt == 0) { const int hd_ = g * 8 + (rr) * 2 + hq; const float* s0_ = ssc + (m0 + lane) * 64 + hd_; const float* s1_ = s0_ + 64 * 64; \
            sv[0] = s0_[32]; sv[1] = s1_[32]; sv[2] = s0_[48]; sv[3] = s1_[48]; sv[4] = s0_[0]; sv[5] = s1_[0]; sv[6] = s0_[16]; sv[7] = s1_[16]; } } while (0)
#pragma unroll
    for (int k = 0; k < 8; ++k) sv[k] = 0.f;
    SO_PF(0);
#pragma unroll 1
    for (int r = 0; r < 4; ++r) {
        const int head = g * 8 + r * 2 + hq;
        LAS float* sc = (LAS float*)(F.lds + SO_SC + hq * 2048); LAS float* af = sc, *ab = sc + 128, *dtf = sc + 256, *dtb = sc + 384;
        __syncthreads();
#pragma unroll
        for (int k = 0; k < 4; ++k) { const int i = tid + NTHR * k, row = i >> 4, ch = i & 15; *(LAS u32x4*)(Xl + row * SSD_LDB + ch * 8) = xr[k]; }
        if (lt == 0) { const float a0 = sv[0], a1 = sv[1], c0 = sv[2], c1 = sv[3];
          const float p0 = scan_incl(a0, lane), t0 = __shfl(p0, 63), p1 = scan_incl(a1, lane) + t0;
          const float q1 = scan_incl_rev(c1, lane), t1 = __shfl(q1, 0), q0 = scan_incl_rev(c0, lane) + t1;
          af[lane] = p0; af[lane + 64] = p1; ab[lane] = q0; ab[lane + 64] = q1;
          dtf[lane] = sv[4]; dtf[lane + 64] = sv[5]; dtb[lane] = sv[6]; dtb[lane + 64] = sv[7]; }
        __syncthreads();
        const bf16* hf = (const bf16*)(P.ws + A_HS) + ((size_t)(((b * 2 + 0) * 64 + c) * 16 + head)) * 8192;
        const bf16* hb = (const bf16*)(P.ws + A_HS) + ((size_t)(((b * 2 + 1) * 64 + (63 - c)) * 16 + head)) * 8192;
        const float dskip = sd[head], afl = af[l], abl = ab[l];
        f32x16 acc0 = zero16(), acc1 = zero16();
        acc0 = mma_ks<8>(acc0, [&](int ks) { return *(const bf16x8*)(hf + (0 * 8 + ks) * 512 + lane * 8); }, [&](int ks) { return frag_l_perm(Cl, SSD_LDB, 32 * lt, 16 * ks, lane); });
        acc1 = mma_ks<8>(acc1, [&](int ks) { return *(const bf16x8*)(hf + (1 * 8 + ks) * 512 + lane * 8); }, [&](int ks) { return frag_l_perm(Cl, SSD_LDB, 32 * lt, 16 * ks, lane); });
        { const float e = __expf(afl);
#pragma unroll
          for (int i = 0; i < 16; ++i) { acc0[i] *= e; acc1[i] *= e; } }
        { f32x16 t0 = zero16(), t1 = zero16();
          t0 = mma_ks<8>(t0, [&](int ks) { return *(const bf16x8*)(hb + (0 * 8 + ks) * 512 + lane * 8); }, [&](int ks) { return frag_l_perm(Cl, SSD_LDB, 32 * lt, 16 * ks, lane); });
          t1 = mma_ks<8>(t1, [&](int ks) { return *(const bf16x8*)(hb + (1 * 8 + ks) * 512 + lane * 8); }, [&](int ks) { return frag_l_perm(Cl, SSD_LDB, 32 * lt, 16 * ks, lane); });
          const float e = __expf(abl);
#pragma unroll
          for (int i = 0; i < 16; ++i) { acc0[i] += t0[i] * e; acc1[i] += t1[i] * e; } }
        if (r < 3) SO_PF(r + 1);
#pragma unroll 1
        for (int kh = 0; kh < 2; ++kh) {
            bf16x8 xx0[4], xx1[4], grw[4];
#pragma unroll
            for (int k4 = 0; k4 < 4; ++k4) { const int ks = 4 * kh + k4, s0 = 16 * ks + 8 * h5; xx0[k4] = frag_tr(Xl, SSD_LDB, 16 * ks, hq * 64, lane); xx1[k4] = frag_tr(Xl, SSD_LDB, 16 * ks, hq * 64 + 32, lane); grw[k4] = *(const LAS bf16x8*)(Gl + l * SSD_LDB + s0); }
#pragma unroll
            for (int k4 = 0; k4 < 4; ++k4) { const int ks = 4 * kh + k4, s0 = 16 * ks + 8 * h5; float f[8];
                f32x4 afs[2], abs_[2], dfs[2], dbs[2];
#pragma unroll
                for (int q = 0; q < 2; ++q) { afs[q] = *(const LAS f32x4*)(af + s0 + 4 * q); abs_[q] = *(const LAS f32x4*)(ab + s0 + 4 * q); dfs[q] = *(const LAS f32x4*)(dtf + s0 + 4 * q); dbs[q] = *(const LAS f32x4*)(dtb + s0 + 4 * q); }
#pragma unroll
                for (int j = 0; j < 8; ++j) { const int s = s0 + j; const float gv = bf2f((unsigned short)grw[k4][j]);
                    const float afv = afs[j >> 2][j & 3], abv = abs_[j >> 2][j & 3], dfv = dfs[j >> 2][j & 3], dbv = dbs[j >> 2][j & 3];
                    const float e = __expf(s < l ? afl - afv : abl - abv);
                    const float w = s < l ? e * dfv : (s > l ? e * dbv : dfv + dbv);
                    f[j] = gv * w + (s == l ? dskip : 0.f); }
                const u32x4 pk = pack8(f); const bf16x8 mf = __builtin_bit_cast(bf16x8, pk);
                acc0 = MFMA32(xx0[k4], mf, acc0); acc1 = MFMA32(xx1[k4], mf, acc1); } }
        { LAS bf16* o = Yst + l31 * 72 + 4 * h5;
#pragma unroll
          for (int qd = 0; qd < 4; ++qd) { u32x2 w; w.x = pk2(acc0[4 * qd], acc0[4 * qd + 1]); w.y = pk2(acc0[4 * qd + 2], acc0[4 * qd + 3]); *(LAS u32x2*)(o + 8 * qd) = w;
              w.x = pk2(acc1[4 * qd], acc1[4 * qd + 1]); w.y = pk2(acc1[4 * qd + 2], acc1[4 * qd + 3]); *(LAS u32x2*)(o + 32 + 8 * qd) = w; } }
        u32x4 zr[4];
#pragma unroll
        for (int k = 0; k < 4; ++k) { const int it = lane + 64 * k, tl = it >> 3, cg = it & 7; zr[k] = *(const u32x4*)(cols + (m0 + 32 * lt + tl) * NCB + C_SZ + head * 64 + 8 * cg); }
        LDS_WAIT();
#pragma unroll
        for (int k = 0; k < 4; ++k) { const int it = lane + 64 * k, tl = it >> 3, cg = it & 7; const size_t m = m0 + 32 * lt + tl;
            float y[8], z[8]; unpack8(*(const LAS u32x4*)(Yst + tl * 72 + 8 * cg), y); unpack8(zr[k], z);
            float ss = 0.f;
#pragma unroll
            for (int j = 0; j < 8; ++j) { y[j] *= siluf_(z[j]); ss += y[j] * y[j]; }
            ss += __shfl_xor(ss, 1); ss += __shfl_xor(ss, 2); ss += __shfl_xor(ss, 4);
            if (cg == 0) sumsq[(r * 2 + hq) * 128 + 32 * lt + tl] = ss;
            *(u32x4*)(ymix + m * 2048 + 1024 + head * 64 + 8 * cg) = pack8(y); }
        LDS_WAIT();
    }
#undef SO_PF
    __syncthreads();
    { u32x4 yv[4][4];
#pragma unroll
      for (int r = 0; r < 4; ++r) { const int head = g * 8 + r * 2 + hq;
#pragma unroll
          for (int k = 0; k < 4; ++k) { const int it = lane + 64 * k, tl = it >> 3, cg = it & 7; yv[r][k] = *(const u32x4*)(ymix + (m0 + 32 * lt + tl) * 2048 + 1024 + head * 64 + 8 * cg); } }
      float rs4[4];
#pragma unroll
      for (int k = 0; k < 4; ++k) { const int it = lane + 64 * k, tl = it >> 3; float sq = 0.f;
#pragma unroll
          for (int q8 = 0; q8 < 8; ++q8) sq += sumsq[q8 * 128 + 32 * lt + tl];
          rs4[k] = rsqrtf(sq * (1.f / 512.f) + 1e-5f); }
#pragma unroll
      for (int r = 0; r < 4; ++r) { const int head = g * 8 + r * 2 + hq; const int cg = lane & 7;
          const f32x4 w0 = *(const f32x4*)(snorm + head * 64 + 8 * cg), w1 = *(const f32x4*)(snorm + head * 64 + 8 * cg + 4);
#pragma unroll
          for (int k = 0; k < 4; ++k) { const int it = lane + 64 * k, tl = it >> 3; float y[8]; unpack8(yv[r][k], y);
#pragma unroll
              for (int j = 0; j < 8; ++j) y[j] = y[j] * rs4[k] * (j < 4 ? w0[j] : w1[j - 4]);
              *(u32x4*)(ymix + (m0 + 32 * lt + tl) * 2048 + 1024 + head * 64 + 8 * cg) = pack8(y); } } }
}

__device__ __forceinline__ void st_tile_tm(LAS bf16* M, int row, int col0, const f32x16& a, int h5, float sgn) {
#pragma unroll
    for (int qd = 0; qd < 4; ++qd) { u32x2 w; w.x = pk2(sgn * a[4 * qd], sgn * a[4 * qd + 1]); w.y = pk2(sgn * a[4 * qd + 2], sgn * a[4 * qd + 3]); *(LAS u32x2*)(M + row * 72 + col0 + 8 * qd + 4 * h5) = w; }
}
__device__ __forceinline__ f32x16 mm_tile(const LAS bf16* A, const LAS bf16* B, int it, int jt, int lane, f32x16 acc) {
    return mma_ks<4>(acc, [&](int ks) { return frag_tr(B, 72, 16 * ks, 32 * jt, lane); }, [&](int ks) { return frag_l(A, 72, 32 * it, 16 * ks, lane); });
}
__device__ __forceinline__ f32x16 ld_tile_tm(const LAS bf16* M, int row, int col0, int h5) {
    f32x16 a;
#pragma unroll
    for (int qd = 0; qd < 4; ++qd) { const u32x2 w = *(const LAS u32x2*)(M + row * 72 + col0 + 8 * qd + 4 * h5); a[4 * qd] = bflo(w.x); a[4 * qd + 1] = bfhi(w.x); a[4 * qd + 2] = bflo(w.y); a[4 * qd + 3] = bfhi(w.y); }
    return a;
}
template <class Fin, class Extra>
__device__ __forceinline__ void nilp_inverse(const LAS bf16* L, LAS bf16* Sb0, LAS bf16* Sb1, LAS bf16* Tb0, LAS bf16* Tb1, int wave, int lane, const Fin& fin, const Extra& extra) {
    const int it = (wave >> 1) & 1, jt = wave & 1, h5 = lane >> 5, row = 32 * it + (lane & 31);
    LAS bf16* Sb[2] = {Sb0, Sb1}; LAS bf16* Tb[2] = {Tb0, Tb1};
    if (wave < 4) st_tile_tm(Sb[1], row, 32 * jt, mm_tile(L, L, it, jt, lane, zero16()), h5, 1.f);
    else { f32x16 a = ld_tile_tm(L, row, 32 * jt, h5);
#pragma unroll
        for (int r = 0; r < 16; ++r) { const int j = 32 * jt + 8 * (r >> 2) + 4 * h5 + (r & 3); a[r] = (j == row ? 1.f : 0.f) - a[r]; }
        st_tile_tm(Tb[1], row, 32 * jt, a, h5, 1.f); }
    __syncthreads();
#pragma unroll
    for (int k = 1; k <= 5; ++k) {
        if (wave < 4) { const f32x16 acc = mm_tile(Tb[k & 1], Sb[k & 1], it, jt, lane, ld_tile_tm(Tb[k & 1], row, 32 * jt, h5));
            if (k < 5) st_tile_tm(Tb[(k + 1) & 1], row, 32 * jt, acc, h5, 1.f); else fin(acc, it, jt); }
        else { if (k < 5) st_tile_tm(Sb[(k + 1) & 1], row, 32 * jt, mm_tile(Sb[k & 1], Sb[k & 1], it, jt, lane, zero16()), h5, 1.f); else extra(); }
        __syncthreads();
    }
}
__device__ __forceinline__ void st_acc(bf16* tile, const f32x16& a, int lane) {
    u32x4 w0, w1; w0.x = pk2(a[0], a[1]); w0.y = pk2(a[2], a[3]); w0.z = pk2(a[4], a[5]); w0.w = pk2(a[6], a[7]); w1.x = pk2(a[8], a[9]); w1.y = pk2(a[10], a[11]); w1.z = pk2(a[12], a[13]); w1.w = pk2(a[14], a[15]);
    *(u32x4*)(tile + lane * 16) = w0; *(u32x4*)(tile + lane * 16 + 8) = w1; }
__device__ __forceinline__ void ld_acc_add(const bf16* tile, f32x16& a, int lane) {
    float f[8]; unpack8(*(const u32x4*)(tile + lane * 16), f);
#pragma unroll
    for (int j = 0; j < 8; ++j) a[j] += f[j];
    unpack8(*(const u32x4*)(tile + lane * 16 + 8), f);
#pragma unroll
    for (int j = 0; j < 8; ++j) a[8 + j] += f[j]; }
__device__ __forceinline__ void st_frag2(bf16* f0  , const f32x16& a, int lane) {
    u32x4 w0, w1; w0.x = pk2(a[0], a[1]); w0.y = pk2(a[2], a[3]); w0.z = pk2(a[4], a[5]); w0.w = pk2(a[6], a[7]); w1.x = pk2(a[8], a[9]); w1.y = pk2(a[10], a[11]); w1.z = pk2(a[12], a[13]); w1.w = pk2(a[14], a[15]);
    *(u32x4*)(f0 + lane * 8) = w0; *(u32x4*)(f0 + 512 + lane * 8) = w1; }
constexpr int GL_KN = 0, GL_QN = 17408, GL_V = 34816, GL_QK = 52224, GL_TU = 61440, GL_TW = 70656, GL_LF = 79872, GL_UT = 79872, GL_UST = 98304, GL_WT = 116736, GL_WST = 135168, GL_SC = 153600;
struct GdnRaw { u32x4 q[2], k[2], v[2]; float g, bt; };
__device__ __forceinline__ void gdn_a_load(const Params& P, int u, int tid, GdnRaw& r) {
    const int head = (u >> 1) & 3, c = (u >> 3) & 127, b = u >> 10; const size_t m0 = (size_t)b * SEQ + c * 64; const bf16* gq = (const bf16*)(P.ws + A_GQKV);
#pragma unroll
    for (int k = 0; k < 2; ++k) { const int i = tid + k * NTHR, row = i >> 4, ch = i & 15; const bf16* src = gq + (m0 + row) * 1536 + head * 128 + ch * 8;
        r.q[k] = *(const u32x4*)src; r.k[k] = *(const u32x4*)(src + 512); r.v[k] = *(const u32x4*)(src + 1024); }
    r.g = 0.f; r.bt = 0.f;
    if (tid < 64) { const float* gsc = (const float*)(P.ws + A_GSC); const int dir = u & 1; r.g = gsc[(m0 + tid) * 16 + 8 + dir * 4 + head]; r.bt = gsc[(m0 + tid) * 16 + dir * 4 + head]; }
}
__device__ __forceinline__ void gdn_a_unit(Frame& F, const Params& P, int u, int tid, int lane, const GdnRaw& raw, int u_next, GdnRaw& raw_next) {
    const int dir = u & 1, head = (u >> 1) & 3, c = (u >> 3) & 127, b = u >> 10, wave = F.wave, h5 = lane >> 5, l31 = lane & 31; const size_t m0 = (size_t)b * SEQ + c * 64;
    const int uu = ((b * 2 + dir) * 128 + (dir ? 127 - c : c)) * 4 + head;
    const bf16* gq = (const bf16*)(P.ws + A_GQKV); const float* gsc = (const float*)(P.ws + A_GSC);
    LAS bf16* Kn = (LAS bf16*)(F.lds + GL_KN); LAS bf16* Qn = (LAS bf16*)(F.lds + GL_QN); LAS bf16* Vv = (LAS bf16*)(F.lds + GL_V); LAS bf16* QK = (LAS bf16*)(F.lds + GL_QK);
    LAS bf16* Tu = (LAS bf16*)(F.lds + GL_TU); LAS bf16* Tw = (LAS bf16*)(F.lds + GL_TW); LAS bf16* Lb = (LAS bf16*)(F.lds + GL_LF);
    LAS bf16* Ut = (LAS bf16*)(F.lds + GL_UT); LAS bf16* Ust = (LAS bf16*)(F.lds + GL_UST); LAS bf16* Wt = (LAS bf16*)(F.lds + GL_WT); LAS bf16* Wst = (LAS bf16*)(F.lds + GL_WST);
    LAS float* GC = (LAS float*)(F.lds + GL_SC); LAS float* BT = GC + 64; LAS float* EG = GC + 128; LAS float* SV = GC + 192;
    __syncthreads();
#pragma unroll
    for (int k = 0; k < 2; ++k) { const int i = tid + k * NTHR, row = i >> 4, ch = i & 15;
        *(LAS u32x4*)(Qn + row * 136 + ch * 8) = raw.q[k]; *(LAS u32x4*)(Kn + row * 136 + ch * 8) = raw.k[k]; *(LAS u32x4*)(Vv + row * 136 + ch * 8) = raw.v[k]; }
    if (u_next < 2048) gdn_a_load(P, u_next, tid, raw_next);
    if (wave == 0) { const float g = raw.g, bt = raw.bt;
        const float gc = dir ? scan_incl_rev(g, lane) : scan_incl(g, lane), tot = __shfl(gc, dir ? 0 : 63);
        GC[lane] = gc; BT[lane] = bt; EG[lane] = __expf(gc); SV[lane] = __expf(tot - gc);
        if (lane == 0) ((float*)(P.ws + A_GD))[uu] = __expf(tot); }
    __syncthreads();
    { const int kind = wave >> 2, it = (wave >> 1) & 1, jt = wave & 1; f32x16 acc = zero16();
      acc = mma_ks<8>(acc, [&](int ks) { return frag_l(Kn, 136, 32 * jt, 16 * ks, lane); }, [&](int ks) { return frag_l(kind ? Qn : Kn, 136, 32 * it, 16 * ks, lane); });
      const int i = 32 * it + l31; const float gci = GC[i], bi = BT[i];
#pragma unroll
      for (int qd = 0; qd < 4; ++qd) { const int j0 = 32 * jt + 8 * qd + 4 * h5; float v[4];
#pragma unroll
          for (int r = 0; r < 4; ++r) { const int j = j0 + r; const bool before = dir ? (j > i) : (j < i); const float e = __expf(fminf(gci - GC[j], 0.f));
              v[r] = kind == 0 ? (before ? bi * acc[4 * qd + r] * e : 0.f) : ((before || j == i) ? acc[4 * qd + r] * e : 0.f); }
          { u32x2 w; w.x = pk2(v[0], v[1]); w.y = pk2(v[2], v[3]); *(LAS u32x2*)((kind == 0 ? Lb : QK) + i * 72 + j0) = w; } } }
    __syncthreads();
    nilp_inverse(Lb, (LAS bf16*)(F.lds + GL_UST), (LAS bf16*)(F.lds + GL_UST + 9216), (LAS bf16*)(F.lds + GL_WT), (LAS bf16*)(F.lds + GL_WT + 9216), wave, lane,
        [&](const f32x16& acc, int it, int jt) { const int row = 32 * it + l31;
#pragma unroll
            for (int qd = 0; qd < 4; ++qd) { const int j0 = 32 * jt + 8 * qd + 4 * h5; const f32x4 bt = *(const LAS f32x4*)(BT + j0), eg = *(const LAS f32x4*)(EG + j0); u32x2 w;
                w.x = pk2(acc[4 * qd] * bt[0], acc[4 * qd + 1] * bt[1]); w.y = pk2(acc[4 * qd + 2] * bt[2], acc[4 * qd + 3] * bt[3]); *(LAS u32x2*)(Tu + row * 72 + j0) = w;
                w.x = pk2(acc[4 * qd] * bt[0] * eg[0], acc[4 * qd + 1] * bt[1] * eg[1]); w.y = pk2(acc[4 * qd + 2] * bt[2] * eg[2], acc[4 * qd + 3] * bt[3] * eg[3]); *(LAS u32x2*)(Tw + row * 72 + j0) = w; } },
        [&]() {});
    { const int it = wave >> 2, et = wave & 3;
#pragma unroll
      for (int k2 = 0; k2 < 2; ++k2) { f32x16 acc = zero16(); const LAS bf16* Tm = k2 ? Tw : Tu; const LAS bf16* Src = k2 ? Kn : Vv; LAS bf16* O1 = k2 ? Wt : Ut; LAS bf16* O2 = k2 ? Wst : Ust;
        acc = mma_ks<4>(acc, [&](int ks) { return frag_l(Tm, 72, 32 * it, 16 * ks, lane); }, [&](int ks) { return frag_tr(Src, 136, 16 * ks, 32 * et, lane); });
#pragma unroll
        for (int qd = 0; qd < 4; ++qd) { const int i0 = 32 * it + 8 * qd + 4 * h5; const f32x4 sv = *(const LAS f32x4*)(SV + i0); u32x2 w;
            w.x = pk2(acc[4 * qd], acc[4 * qd + 1]); w.y = pk2(acc[4 * qd + 2], acc[4 * qd + 3]); *(LAS u32x2*)(O1 + (32 * et + l31) * 72 + i0) = w;
            w.x = pk2(acc[4 * qd] * sv[0], acc[4 * qd + 1] * sv[1]); w.y = pk2(acc[4 * qd + 2] * sv[2], acc[4 * qd + 3] * sv[3]); *(LAS u32x2*)(O2 + (32 * et + l31) * 72 + i0) = w; } } }
    __syncthreads();
    { bf16* gpsi = (bf16*)(P.ws + A_GPSI) + (size_t)uu * 16384; bf16* glam = (bf16*)(P.ws + A_GLAM) + (size_t)uu * 16384; bf16* gqt = (bf16*)(P.ws + A_GQT) + (size_t)uu * 8192; bf16* go0 = (bf16*)(P.ws + A_GO0) + (size_t)uu * 8192;
      const int dt = wave & 3, hi2 = wave >> 2;
#pragma unroll
      for (int k2 = 0; k2 < 2; ++k2) { const int et = 2 * hi2 + k2; f32x16 acc = zero16();
        acc = mma_ks<4>(acc, [&](int ks) { return frag_tr(Kn, 136, 16 * ks, 32 * dt, lane); }, [&](int ks) { return frag_l(Ust, 72, 32 * et, 16 * ks, lane); });
        st_acc(gpsi + (dt * 4 + et) * 1024, acc, lane); }
#pragma unroll
      for (int k2 = 0; k2 < 2; ++k2) { const int dpt = 2 * hi2 + k2; f32x16 acc = zero16();
        acc = mma_ks<4>(acc, [&](int ks) { return frag_l(Wst, 72, 32 * dpt, 16 * ks, lane); }, [&](int ks) { return frag_tr(Kn, 136, 16 * ks, 32 * dt, lane); });
#pragma unroll
        for (int r = 0; r < 16; ++r) acc[r] = -acc[r];
        st_frag2(glam + (dt * 8 + 2 * dpt) * 512, acc, lane); }
      { const int it = hi2, dpt = dt; f32x16 acc = zero16();
        acc = mma_ks<4>(acc, [&](int ks) { return frag_l(Wt, 72, 32 * dpt, 16 * ks, lane); }, [&](int ks) { return frag_l(QK, 72, 32 * it, 16 * ks, lane); });
        const int i = 32 * it + l31; const float eg = EG[i];
#pragma unroll
        for (int qd = 0; qd < 4; ++qd) { const u32x2 qw = *(const LAS u32x2*)(Qn + i * 136 + 32 * dpt + 8 * qd + 4 * h5);
            acc[4 * qd] = eg * bflo(qw.x) - acc[4 * qd]; acc[4 * qd + 1] = eg * bfhi(qw.x) - acc[4 * qd + 1]; acc[4 * qd + 2] = eg * bflo(qw.y) - acc[4 * qd + 2]; acc[4 * qd + 3] = eg * bfhi(qw.y) - acc[4 * qd + 3]; }
        st_frag2(gqt + (it * 8 + 2 * dpt) * 512, acc, lane); }
      { const int it = hi2, et = dt; f32x16 acc = zero16();
        acc = mma_ks<4>(acc, [&](int ks) { return frag_l(Ut, 72, 32 * et, 16 * ks, lane); }, [&](int ks) { return frag_l(QK, 72, 32 * it, 16 * ks, lane); });
        st_acc(go0 + (et * 2 + it) * 1024, acc, lane); } }
}
__device__ __forceinline__ void phase_gdn_a(Frame& F, const Params& P) {
    int lane = F.lane; asm volatile("" : "+v"(lane)); int tid = F.tid; asm volatile("" : "+v"(tid));
    GdnRaw A, B; int u = F.vcu; if (u >= 2048) return;
    gdn_a_load(P, u, tid, A);
    for (;;) { gdn_a_unit(F, P, u, tid, lane, A, u + F.G, B); u += F.G; if (u >= 2048) break;
               gdn_a_unit(F, P, u, tid, lane, B, u + F.G, A); u += F.G; if (u >= 2048) break; }
}
struct GdnScanOps { bf16x8 lam[8]; u32x4 ps0, ps1; float d; };
__device__ __forceinline__ void gdn_scan_unit(Frame& F, const Params& P, int unit, int lane) {
    const int eq = unit & 3, chain = unit >> 2, wave = F.wave, dt = wave & 3, et = eq, bd = chain >> 2, head = chain & 3;
    LAS bf16* Hf = (LAS bf16*)(F.lds);
    __syncthreads();
    if (wave >= 4) {
        const bf16* glam_ = (const bf16*)(P.ws + A_GLAM); const bf16* gpsi_ = (const bf16*)(P.ws + A_GPSI); const int w4 = wave - 4;
        u32x4 pa[4], pb[4];
#pragma unroll
        for (int j = 0; j < 4; ++j) { pa[j] = (u32x4){0u, 0u, 0u, 0u}; pb[j] = pa[j]; }
#define GS_PF(cqx, J) do { const size_t un_ = (size_t)(bd * 128 + ((cqx) < 128 ? (cqx) : 127)) * 4 + head; \
            pa[J] = *(const u32x4*)(glam_ + un_ * 16384 + (eq * 8 + 2 * w4) * 512 + lane * 16); pb[J] = *(const u32x4*)(gpsi_ + un_ * 16384 + (w4 * 4 + et) * 1024 + lane * 16); } while (0)
#pragma unroll 1
        for (int cq = 0; cq < 128; cq += 4) {
#pragma unroll
            for (int j = 0; j < 4; ++j) { asm volatile("" :: "v"(pa[j]), "v"(pb[j])); GS_PF(cq + j + 5, j);
                asm volatile("s_waitcnt lgkmcnt(0)" ::: "memory"); __builtin_amdgcn_s_barrier(); } }
#pragma unroll
        for (int j = 0; j < 4; ++j) asm volatile("" :: "v"(pa[j]), "v"(pb[j]));
#undef GS_PF
        return; }
    __builtin_amdgcn_s_setprio(3);
    f32x16 Hm = zero16();
    const bf16* gpsi = (const bf16*)(P.ws + A_GPSI); const bf16* glam = (const bf16*)(P.ws + A_GLAM); bf16* gh = (bf16*)(P.ws + A_GH); const float* gd = (const float*)(P.ws + A_GD);
#define GS_LOAD(S, cqx) do { const size_t un_ = (size_t)(bd * 128 + ((cqx) < 128 ? (cqx) : 127)) * 4 + head; \
        _Pragma("unroll") for (int ks = 0; ks < 8; ++ks) S.lam[ks] = *(const bf16x8*)(glam + un_ * 16384 + (dt * 8 + ks) * 512 + lane * 8); \
        S.ps0 = *(const u32x4*)(gpsi + un_ * 16384 + (dt * 4 + et) * 1024 + lane * 16); S.ps1 = *(const u32x4*)(gpsi + un_ * 16384 + (dt * 4 + et) * 1024 + lane * 16 + 8); S.d = gd[un_]; } while (0)
#define GS_STEP(CUR, NXT, cqx) do { const size_t uu_ = (size_t)(bd * 128 + (cqx)) * 4 + head; const int par_ = (cqx) & 1; \
        { u32x4 w0, w1; w0.x = pk2(Hm[0], Hm[1]); w0.y = pk2(Hm[2], Hm[3]); w0.z = pk2(Hm[4], Hm[5]); w0.w = pk2(Hm[6], Hm[7]); w1.x = pk2(Hm[8], Hm[9]); w1.y = pk2(Hm[10], Hm[11]); w1.z = pk2(Hm[12], Hm[13]); w1.w = pk2(Hm[14], Hm[15]); \
          LAS bf16* lf = Hf + (par_ * 8 + 2 * dt) * 512 + lane * 8; *(LAS u32x4*)lf = w0; *(LAS u32x4*)(lf + 512) = w1; \
          bf16* gf = gh + uu_ * 16384 + (et * 8 + 2 * dt) * 512 + lane * 8; *(u32x4*)gf = w0; *(u32x4*)(gf + 512) = w1; } \
        GS_LOAD(NXT, (cqx) + 3); \
        asm volatile("s_waitcnt lgkmcnt(0)" ::: "memory"); __builtin_amdgcn_s_barrier(); asm volatile("" ::: "memory"); \
        bf16x8 hv[8]; const LAS bf16* hb = Hf + (par_ * 8) * 512 + lane * 8; \
        _Pragma("unroll") for (int ks = 0; ks < 8; ++ks) hv[ks] = *(const LAS bf16x8*)(hb + ks * 512); \
        f32x16 acc; { float f[8]; unpack8(CUR.ps0, f); _Pragma("unroll") for (int j = 0; j < 8; ++j) acc[j] = CUR.d * Hm[j] + f[j]; \
          unpack8(CUR.ps1, f); _Pragma("unroll") for (int j = 0; j < 8; ++j) acc[8 + j] = CUR.d * Hm[8 + j] + f[j]; } \
        asm volatile("s_waitcnt lgkmcnt(0)" ::: "memory"); __builtin_amdgcn_sched_barrier(0); \
        _Pragma("unroll") for (int ks = 0; ks < 8; ++ks) acc = MFMA32(CUR.lam[ks], hv[ks], acc); \
        Hm = acc; } while (0)
    GdnScanOps A, B, C, D;
    GS_LOAD(A, 0); GS_LOAD(B, 1); GS_LOAD(C, 2);
#pragma unroll 1
    for (int cq = 0; cq < 128; cq += 4) { GS_STEP(A, D, cq); GS_STEP(B, A, cq + 1); GS_STEP(C, B, cq + 2); GS_STEP(D, C, cq + 3); }
    __builtin_amdgcn_s_setprio(0);
#undef GS_LOAD
#undef GS_STEP
}
__device__ __forceinline__ void gdn_out_wave(Frame& F, const Params& P, int l_, int u, int lane) {
    const int it = u & 1, head = (u >> 1) & 3, c = (u >> 3) & 127, b = u >> 10, h5 = lane >> 5, l31 = lane & 31; const size_t m0 = (size_t)b * SEQ + c * 64 + 32 * it;
    const bf16* gh = (const bf16*)(P.ws + A_GH); const bf16* gqt = (const bf16*)(P.ws + A_GQT); const bf16* go0 = (const bf16*)(P.ws + A_GO0);
    const bf16* cols = (const bf16*)(P.ws + A_COLS); bf16* ymix = (bf16*)(P.ws + A_YMIX); const float* gnorm = P.in[I_GDN_NORM] + (size_t)l_ * 128;
    LAS float* Ost = (LAS float*)(F.lds + F.wave * 17408);
    const size_t uf = (size_t)((b * 2 + 0) * 128 + c) * 4 + head, ub = (size_t)((b * 2 + 1) * 128 + (127 - c)) * 4 + head;
    u32x4 zr[8];
#pragma unroll
    for (int pass = 0; pass < 8; ++pass) zr[pass] = *(const u32x4*)(cols + (m0 + pass * 4 + (lane >> 4)) * NCB + C_GZ + head * 128 + 8 * (lane & 15));
    const f32x4 w0 = *(const f32x4*)(gnorm + 8 * (lane & 15)), w1 = *(const f32x4*)(gnorm + 8 * (lane & 15) + 4);
    f32x16 acc[4];
#pragma unroll
    for (int et = 0; et < 4; ++et) { acc[et] = zero16(); ld_acc_add(go0 + uf * 8192 + (et * 2 + it) * 1024, acc[et], lane); ld_acc_add(go0 + ub * 8192 + (et * 2 + it) * 1024, acc[et], lane); }
    bf16x8 nq[2], nh[2][4];
#define GO_LD(ks_) do { nq[0] = *(const bf16x8*)(gqt + uf * 8192 + (it * 8 + (ks_)) * 512 + lane * 8); nq[1] = *(const bf16x8*)(gqt + ub * 8192 + (it * 8 + (ks_)) * 512 + lane * 8); \
        _Pragma("unroll") for (int et = 0; et < 4; ++et) { nh[0][et] = *(const bf16x8*)(gh + uf * 16384 + (et * 8 + (ks_)) * 512 + lane * 8); nh[1][et] = *(const bf16x8*)(gh + ub * 16384 + (et * 8 + (ks_)) * 512 + lane * 8); } } while (0)
    GO_LD(0);
#pragma unroll 1
    for (int ks = 0; ks < 8; ++ks) { const bf16x8 cq0 = nq[0], cq1 = nq[1]; bf16x8 ch0[4], ch1[4];
#pragma unroll
        for (int et = 0; et < 4; ++et) { ch0[et] = nh[0][et]; ch1[et] = nh[1][et]; }
        if (ks < 7) GO_LD(ks + 1);
#pragma unroll
        for (int et = 0; et < 4; ++et) { acc[et] = MFMA32(ch0[et], cq0, acc[et]); acc[et] = MFMA32(ch1[et], cq1, acc[et]); } }
#undef GO_LD
#pragma unroll
    for (int et = 0; et < 4; ++et) {
#pragma unroll
        for (int qd = 0; qd < 4; ++qd) *(LAS f32x4*)(Ost + l31 * 132 + 32 * et + 8 * qd + 4 * h5) = (f32x4){acc[et][4 * qd], acc[et][4 * qd + 1], acc[et][4 * qd + 2], acc[et][4 * qd + 3]}; }
    LDS_WAIT();
#pragma unroll
    for (int pass = 0; pass < 8; ++pass) { const int tok = pass * 4 + (lane >> 4), e0 = 8 * (lane & 15); const size_t m = m0 + tok;
        const f32x4 a0 = *(const LAS f32x4*)(Ost + tok * 132 + e0), a1 = *(const LAS f32x4*)(Ost + tok * 132 + e0 + 4); float o[8] = {a0[0], a0[1], a0[2], a0[3], a1[0], a1[1], a1[2], a1[3]}, z[8];
        float ss = 0.f;
#pragma unroll
        for (int j = 0; j < 8; ++j) ss += o[j] * o[j];
        ss += __shfl_xor(ss, 1); ss += __shfl_xor(ss, 2); ss += __shfl_xor(ss, 4); ss += __shfl_xor(ss, 8);
        const float sc = rsqrtf(ss * (1.f / 128.f) + 1e-6f); unpack8(zr[pass], z);
#pragma unroll
        for (int j = 0; j < 8; ++j) o[j] = o[j] * sc * (j < 4 ? w0[j] : w1[j - 4]) * siluf_(z[j]);
        *(u32x4*)(ymix + m * 2048 + head * 128 + e0) = pack8(o); }
    LDS_WAIT();
}
__device__ __forceinline__ void phase_gdn_out(Frame& F, const Params& P, int l) {
    int lane = F.lane; asm volatile("" : "+v"(lane));
    for (int u = F.vcu * NWAVES + F.wave; u < 2048; u += F.G * NWAVES) gdn_out_wave(F, P, l, u, lane);
}

constexpr int RL_KAP = 0, RL_KH = 9216, RL_AH = 18432, RL_RHO = 27648, RL_V = 36864, RL_AKK = 46080, RL_BQK = 55296, RL_BQA = 64512, RL_T = 73728, RL_ZT = 82944, RL_NWT = 92160, RL_NU0T = 101376,
              RL_LF = 110592, RL_PART = 128000, RL_PC = 130048;
struct RwkvRaw { u32x4 a0, a1, a2, a3, a4; f32x4 l0, l1; };
__device__ __forceinline__ void rwkv_a_load(const Params& P, int u, int tid, RwkvRaw& r) {
    const int dir = u & 1, head = (u >> 1) & 7, c = (u >> 4) & 127, b = u >> 11; const size_t m0 = (size_t)b * SEQ + c * 64;
    const bf16* rkv = (const bf16*)(P.ws + A_RKV); const bf16* rkk = (const bf16*)(P.ws + A_RKK); const float* rlogw = (const float*)(P.ws + A_RLOGW); const bf16* rkdir = (const bf16*)(P.ws + A_RKDIR); const bf16* rkka = (const bf16*)(P.ws + A_RKKA);
    const int t = tid >> 3, col8 = head * 64 + 8 * (tid & 7); const size_t m = m0 + t;
    r.a0 = *(const u32x4*)(rkv + m * 1536 + col8); r.a1 = *(const u32x4*)(rkv + m * 1536 + 1024 + col8); r.a2 = *(const u32x4*)(rkk + m * 512 + col8);
    r.a3 = *(const u32x4*)(rkdir + m * 1024 + dir * 512 + col8); r.a4 = *(const u32x4*)(rkka + m * 1024 + dir * 512 + col8);
    const int t2 = tid >> 4, q4 = 4 * (tid & 15);
    r.l0 = *(const f32x4*)(rlogw + (m0 + t2) * 1024 + dir * 512 + head * 64 + q4); r.l1 = *(const f32x4*)(rlogw + (m0 + t2 + 32) * 1024 + dir * 512 + head * 64 + q4);
}
__device__ __forceinline__ void rwkv_a_unit(Frame& F, const Params& P, int u, int tid, int lane, const RwkvRaw& raw, int u_next, RwkvRaw& raw_next) {
    const int dir = u & 1, head = (u >> 1) & 7, c = (u >> 4) & 127, b = u >> 11, wave = F.wave, h5 = lane >> 5, l31 = lane & 31; const size_t m0 = (size_t)b * SEQ + c * 64;
    const size_t uu = (size_t)((b * 2 + dir) * 128 + (dir ? 127 - c : c)) * 8 + head;
    const bf16* rkv = (const bf16*)(P.ws + A_RKV); const bf16* rkk = (const bf16*)(P.ws + A_RKK); const float* rlogw = (const float*)(P.ws + A_RLOGW); const bf16* rkdir = (const bf16*)(P.ws + A_RKDIR); const bf16* rkka = (const bf16*)(P.ws + A_RKKA);
    LAS bf16* KAP = (LAS bf16*)(F.lds + RL_KAP); LAS bf16* KH = (LAS bf16*)(F.lds + RL_KH); LAS bf16* AH = (LAS bf16*)(F.lds + RL_AH); LAS bf16* RHO = (LAS bf16*)(F.lds + RL_RHO); LAS bf16* VV = (LAS bf16*)(F.lds + RL_V);
    LAS bf16* AKK = (LAS bf16*)(F.lds + RL_AKK); LAS bf16* BQK = (LAS bf16*)(F.lds + RL_BQK); LAS bf16* BQA = (LAS bf16*)(F.lds + RL_BQA); LAS bf16* Tm = (LAS bf16*)(F.lds + RL_T);
    LAS bf16* ZT = (LAS bf16*)(F.lds + RL_ZT); LAS bf16* NWT = (LAS bf16*)(F.lds + RL_NWT); LAS bf16* NU0T = (LAS bf16*)(F.lds + RL_NU0T); LAS bf16* Lb = (LAS bf16*)(F.lds + RL_LF);
    LAS float* PART = (LAS float*)(F.lds + RL_PART); LAS float* PC = (LAS float*)(F.lds + RL_PC);
    __syncthreads();
    LAS bf16* RAW = (LAS bf16*)(F.lds + RL_AKK); LAS float* RLW = (LAS float*)(F.lds + RL_AKK + 40960);
    { const int t = tid >> 3, q8 = 8 * (tid & 7); const int t2 = tid >> 4, q4 = 4 * (tid & 15);
      *(LAS u32x4*)(RAW + 0 * 4096 + t * 64 + q8) = raw.a0; *(LAS u32x4*)(RAW + 1 * 4096 + t * 64 + q8) = raw.a1; *(LAS u32x4*)(RAW + 2 * 4096 + t * 64 + q8) = raw.a2; *(LAS u32x4*)(RAW + 3 * 4096 + t * 64 + q8) = raw.a3; *(LAS u32x4*)(RAW + 4 * 4096 + t * 64 + q8) = raw.a4;
      *(LAS f32x4*)(RLW + t2 * 64 + q4) = raw.l0; *(LAS f32x4*)(RLW + (t2 + 32) * 64 + q4) = raw.l1; }
    if (u_next < 4096) rwkv_a_load(P, u_next, tid, raw_next);
    __syncthreads();
    { float lw[8], p[8];
#pragma unroll
      for (int j = 0; j < 8; ++j) lw[j] = RLW[(8 * wave + j) * 64 + lane];
      if (dir == 0) { float a = 0.f;
#pragma unroll
          for (int j = 0; j < 8; ++j) { a += lw[j]; p[j] = a; } PART[wave * 64 + lane] = a; }
      else { float a = 0.f;
#pragma unroll
          for (int j = 7; j >= 0; --j) { a += lw[j]; p[j] = a; } PART[wave * 64 + lane] = a; }
      __syncthreads();
      float off = 0.f, tot = 0.f;
#pragma unroll
      for (int w2 = 0; w2 < 8; ++w2) { const float t = PART[w2 * 64 + lane]; tot += t; if (dir == 0 ? (w2 < wave) : (w2 > wave)) off += t; }
      if (wave == 0) { const float pc = __expf(tot); PC[lane] = pc; ((float*)(P.ws + A_RPC))[uu * 64 + lane] = pc; }
#pragma unroll
      for (int j = 0; j < 8; ++j) { const int t = 8 * wave + j; const float lp = off + p[j], lpex = lp - lw[j];
          const float rr = bf2f(RAW[0 * 4096 + t * 64 + lane]), vv = bf2f(RAW[1 * 4096 + t * 64 + lane]), kk = bf2f(RAW[2 * 4096 + t * 64 + lane]), kd = bf2f(RAW[3 * 4096 + t * 64 + lane]), ka = bf2f(RAW[4 * 4096 + t * 64 + lane]);
          const float en = __expf(-lp);
          KAP[t * 72 + lane] = (bf16)f2bf(kk * __expf(lpex)); KH[t * 72 + lane] = (bf16)f2bf(kd * en); AH[t * 72 + lane] = (bf16)f2bf(ka * en); RHO[t * 72 + lane] = (bf16)f2bf(rr * __expf(lp)); VV[t * 72 + lane] = (bf16)f2bf(vv); } }
    __syncthreads();
    { const int mat = wave >> 1, tt = wave & 1; const LAS bf16* Xs = (mat == 0 || mat == 3) ? AH : KH; const LAS bf16* Ys = mat < 2 ? KAP : RHO; const int t = 32 * tt + l31;
#pragma unroll
      for (int st = 0; st < 2; ++st) { f32x16 acc = zero16();
        acc = mma_ks<4>(acc, [&](int ks) { return frag_l(Xs, 72, 32 * st, 16 * ks, lane); }, [&](int ks) { return frag_l(Ys, 72, 32 * tt, 16 * ks, lane); });
#pragma unroll
        for (int qd = 0; qd < 4; ++qd) { const int s0 = 32 * st + 8 * qd + 4 * h5; float v[4];
#pragma unroll
            for (int r = 0; r < 4; ++r) { const int sidx = s0 + r; const bool before = dir ? (sidx > t) : (sidx < t); v[r] = (before || (mat >= 2 && sidx == t)) ? acc[4 * qd + r] : 0.f; }
            { LAS bf16* O = mat == 0 ? Lb : (mat == 1 ? AKK : (mat == 2 ? BQK : BQA)); u32x2 w; w.x = pk2(v[0], v[1]); w.y = pk2(v[2], v[3]); *(LAS u32x2*)(O + t * 72 + s0) = w; } } } }
    __syncthreads();
    nilp_inverse(Lb, ZT, (LAS bf16*)(F.lds + RL_LF + 9216), NWT, NU0T, wave, lane,
        [&](const f32x16& acc, int it, int jt) { st_tile_tm(Tm, 32 * it + l31, 32 * jt, acc, h5, 1.f); },
        [&]() { const int tt = (wave >> 1) & 1, vt = wave & 1; f32x16 acc = zero16();
            acc = mma_ks<4>(acc, [&](int ks) { return frag_l(AKK, 72, 32 * tt, 16 * ks, lane); }, [&](int ks) { return frag_tr(VV, 72, 16 * ks, 32 * vt, lane); });
            st_tile_tm(ZT, 32 * vt + l31, 32 * tt, acc, h5, 1.f); });
    { const int which = wave >> 2, tt = (wave >> 1) & 1, ct = wave & 1; f32x16 acc = zero16();
      acc = mma_ks<4>(acc, [&](int ks) { return frag_l(Tm, 72, 32 * tt, 16 * ks, lane); }, [&](int ks) { return which ? frag_l(ZT, 72, 32 * ct, 16 * ks, lane) : frag_tr(KAP, 72, 16 * ks, 32 * ct, lane); });
      st_tile_tm(which ? NU0T : NWT, 32 * ct + l31, 32 * tt, acc, h5, -1.f); }
    __syncthreads();
    { bf16* gpsi = (bf16*)(P.ws + A_RPSI) + uu * 4096; bf16* glam = (bf16*)(P.ws + A_RLAM) + uu * 4096; bf16* grt = (bf16*)(P.ws + A_RRT) + uu * 4096; bf16* gy0 = (bf16*)(P.ws + A_RY0) + uu * 4096;
      const int a2 = (wave >> 1) & 1, b2 = wave & 1;
      if (wave < 4) {
        { const int tt = a2, ct = b2; f32x16 acc = zero16();
          acc = mma_ks<4>(acc, [&](int ks) { return frag_l(NWT, 72, 32 * ct, 16 * ks, lane); }, [&](int ks) { return frag_l(BQA, 72, 32 * tt, 16 * ks, lane); });
          const int t = 32 * tt + l31;
#pragma unroll
          for (int qd = 0; qd < 4; ++qd) { const u32x2 rw = *(const LAS u32x2*)(RHO + t * 72 + 32 * ct + 8 * qd + 4 * h5);
              acc[4 * qd] += bflo(rw.x); acc[4 * qd + 1] += bfhi(rw.x); acc[4 * qd + 2] += bflo(rw.y); acc[4 * qd + 3] += bfhi(rw.y); }
          st_frag2(grt + (tt * 4 + 2 * ct) * 512, acc, lane); }
        { const int tt = a2, vt = b2; f32x16 acc = zero16();
          acc = mma_ks<4>(acc, [&](int ks) { return frag_tr(VV, 72, 16 * ks, 32 * vt, lane); }, [&](int ks) { return frag_l(BQK, 72, 32 * tt, 16 * ks, lane); });
          acc = mma_ks<4>(acc, [&](int ks) { return frag_l(NU0T, 72, 32 * vt, 16 * ks, lane); }, [&](int ks) { return frag_l(BQA, 72, 32 * tt, 16 * ks, lane); });
          st_acc(gy0 + (vt * 2 + tt) * 1024, acc, lane); }
      } else {
        { const int ct = a2, cpt = b2; f32x16 acc = zero16();
          acc = mma_ks<4>(acc, [&](int ks) { return frag_l(NWT, 72, 32 * cpt, 16 * ks, lane); }, [&](int ks) { return frag_tr(AH, 72, 16 * ks, 32 * ct, lane); });
          const float pc = PC[32 * ct + l31];
#pragma unroll
          for (int r = 0; r < 16; ++r) acc[r] *= pc;
          st_frag2(glam + (ct * 4 + 2 * cpt) * 512, acc, lane); }
        { const int ct = a2, vt = b2; f32x16 acc = zero16();
          acc = mma_ks<4>(acc, [&](int ks) { return frag_tr(KH, 72, 16 * ks, 32 * ct, lane); }, [&](int ks) { return frag_tr(VV, 72, 16 * ks, 32 * vt, lane); });
          acc = mma_ks<4>(acc, [&](int ks) { return frag_tr(AH, 72, 16 * ks, 32 * ct, lane); }, [&](int ks) { return frag_l(NU0T, 72, 32 * vt, 16 * ks, lane); });
#pragma unroll
          for (int qd = 0; qd < 4; ++qd) { const f32x4 pc = *(const LAS f32x4*)(PC + 32 * ct + 8 * qd + 4 * h5);
#pragma unroll
              for (int r = 0; r < 4; ++r) acc[4 * qd + r] *= pc[r]; }
          st_acc(gpsi + (ct * 2 + vt) * 1024, acc, lane); }
      } }
}
__device__ __forceinline__ void phase_rwkv_a(Frame& F, const Params& P) {
    int lane = F.lane; asm volatile("" : "+v"(lane)); int tid = F.tid; asm volatile("" : "+v"(tid));
    RwkvRaw A, B; int u = F.vcu; if (u >= 4096) return;
    rwkv_a_load(P, u, tid, A);
    for (;;) { rwkv_a_unit(F, P, u, tid, lane, A, u + F.G, B); u += F.G; if (u >= 4096) break;
               rwkv_a_unit(F, P, u, tid, lane, B, u + F.G, A); u += F.G; if (u >= 4096) break; }
}
struct RwkvScanOps { bf16x8 lam[4]; u32x4 ps0, ps1; f32x4 pc[4]; };
__device__ __forceinline__ void rwkv_scan_unit(Frame& F, const Params& P, int unit, int lane) {
    const int wave = F.wave, chain = unit, ct = (wave >> 1) & 1, vt = wave & 1, bd = chain >> 3, head = chain & 7, h5 = lane >> 5;
    LAS bf16* Hf = (LAS bf16*)(F.lds);
    __syncthreads();
    if (wave >= 4) {
#pragma unroll 1
        for (int cq = 0; cq < 128; ++cq) { asm volatile("s_waitcnt lgkmcnt(0)" ::: "memory"); __builtin_amdgcn_s_barrier(); }
        return; }
    f32x16 Hm = zero16();
    const bf16* gpsi = (const bf16*)(P.ws + A_RPSI); const bf16* glam = (const bf16*)(P.ws + A_RLAM); bf16* gh = (bf16*)(P.ws + A_RH); const float* gpc = (const float*)(P.ws + A_RPC);
#define RS_LOAD(S, cqx) do { const size_t un_ = (size_t)(bd * 128 + ((cqx) < 128 ? (cqx) : 127)) * 8 + head; \
        _Pragma("unroll") for (int ks = 0; ks < 4; ++ks) S.lam[ks] = *(const bf16x8*)(glam + un_ * 4096 + (ct * 4 + ks) * 512 + lane * 8); \
        S.ps0 = *(const u32x4*)(gpsi + un_ * 4096 + (ct * 2 + vt) * 1024 + lane * 16); S.ps1 = *(const u32x4*)(gpsi + un_ * 4096 + (ct * 2 + vt) * 1024 + lane * 16 + 8); \
        _Pragma("unroll") for (int qd = 0; qd < 4; ++qd) S.pc[qd] = *(const f32x4*)(gpc + un_ * 64 + 32 * ct + 8 * qd + 4 * h5); } while (0)
#define RS_STEP(CUR, NXT, cqx) do { const size_t uu_ = (size_t)(bd * 128 + (cqx)) * 8 + head; const int par_ = (cqx) & 1; \
        { u32x4 w0, w1; w0.x = pk2(Hm[0], Hm[1]); w0.y = pk2(Hm[2], Hm[3]); w0.z = pk2(Hm[4], Hm[5]); w0.w = pk2(Hm[6], Hm[7]); w1.x = pk2(Hm[8], Hm[9]); w1.y = pk2(Hm[10], Hm[11]); w1.z = pk2(Hm[12], Hm[13]); w1.w = pk2(Hm[14], Hm[15]); \
          LAS bf16* lf = Hf + (((par_ * 2 + vt) * 4) + 2 * ct) * 512 + lane * 8; *(LAS u32x4*)lf = w0; *(LAS u32x4*)(lf + 512) = w1; \
          bf16* gf = gh + uu_ * 4096 + (vt * 4 + 2 * ct) * 512 + lane * 8; *(u32x4*)gf = w0; *(u32x4*)(gf + 512) = w1; } \
        RS_LOAD(NXT, (cqx) + 2); \
        asm volatile("s_waitcnt lgkmcnt(0)" ::: "memory"); __builtin_amdgcn_s_barrier(); asm volatile("" ::: "memory"); \
        bf16x8 hv[4]; const LAS bf16* hb = Hf + ((par_ * 2 + vt) * 4) * 512 + lane * 8; \
        _Pragma("unroll") for (int ks = 0; ks < 4; ++ks) hv[ks] = *(const LAS bf16x8*)(hb + ks * 512); \
        f32x16 acc; { float f[8]; unpack8(CUR.ps0, f); _Pragma("unroll") for (int j = 0; j < 4; ++j) { acc[j] = CUR.pc[0][j] * Hm[j] + f[j]; acc[4 + j] = CUR.pc[1][j] * Hm[4 + j] + f[4 + j]; } \
          unpack8(CUR.ps1, f); _Pragma("unroll") for (int j = 0; j < 4; ++j) { acc[8 + j] = CUR.pc[2][j] * Hm[8 + j] + f[j]; acc[12 + j] = CUR.pc[3][j] * Hm[12 + j] + f[4 + j]; } } \
        asm volatile("s_waitcnt lgkmcnt(0)" ::: "memory"); __builtin_amdgcn_sched_barrier(0); \
        _Pragma("unroll") for (int ks = 0; ks < 4; ++ks) acc = MFMA32(CUR.lam[ks], hv[ks], acc); \
        Hm = acc; } while (0)
    RwkvScanOps A, B, C;
    RS_LOAD(A, 0); RS_LOAD(B, 1);
#pragma unroll 1
    for (int cq = 0; cq < 126; cq += 3) { RS_STEP(A, C, cq); RS_STEP(B, A, cq + 1); RS_STEP(C, B, cq + 2); }
    RS_STEP(A, C, 126); RS_STEP(B, A, 127);
#undef RS_LOAD
#undef RS_STEP
}
__device__ __forceinline__ void rwkv_out_wave(Frame& F, const Params& P, int l_, int u, int lane) {
    const int head = u & 7, c = (u >> 3) & 127, b = u >> 10, h5 = lane >> 5, l31 = lane & 31; const size_t m0 = (size_t)b * SEQ + c * 64;
    const bf16* gh = (const bf16*)(P.ws + A_RH); const bf16* grt = (const bf16*)(P.ws + A_RRT); const bf16* gy0 = (const bf16*)(P.ws + A_RY0);
    const bf16* rkv = (const bf16*)(P.ws + A_RKV); const bf16* rkdir = (const bf16*)(P.ws + A_RKDIR); const bf16* rg = (const bf16*)(P.ws + A_RG); bf16* ymix = (bf16*)(P.ws + A_YMIX);
    const float* r_k = P.in[I_R_RK] + (size_t)l_ * 512; const float* lng = P.in[I_R_LNG] + (size_t)l_ * 512; const float* lnb = P.in[I_R_LNB] + (size_t)l_ * 512;
    LAS float* Yst = (LAS float*)(F.lds + F.wave * 17408);
    const size_t uf = (size_t)((b * 2 + 0) * 128 + c) * 8 + head, ub = (size_t)((b * 2 + 1) * 128 + (127 - c)) * 8 + head;
    bf16x8 hf[2][4], hb[2][4];
#pragma unroll
    for (int vt = 0; vt < 2; ++vt)
#pragma unroll
        for (int ks = 0; ks < 4; ++ks) { hf[vt][ks] = *(const bf16x8*)(gh + uf * 4096 + (vt * 4 + ks) * 512 + lane * 8); hb[vt][ks] = *(const bf16x8*)(gh + ub * 4096 + (vt * 4 + ks) * 512 + lane * 8); }
#pragma unroll
    for (int tt = 0; tt < 2; ++tt) { bf16x8 rf[4], rb[4];
#pragma unroll
        for (int ks = 0; ks < 4; ++ks) { rf[ks] = *(const bf16x8*)(grt + uf * 4096 + (tt * 4 + ks) * 512 + lane * 8); rb[ks] = *(const bf16x8*)(grt + ub * 4096 + (tt * 4 + ks) * 512 + lane * 8); }
#pragma unroll
        for (int vt = 0; vt < 2; ++vt) { f32x16 acc = zero16();
            ld_acc_add(gy0 + uf * 4096 + (vt * 2 + tt) * 1024, acc, lane); ld_acc_add(gy0 + ub * 4096 + (vt * 2 + tt) * 1024, acc, lane);
#pragma unroll
            for (int ks = 0; ks < 4; ++ks) { acc = MFMA32(hf[vt][ks], rf[ks], acc); acc = MFMA32(hb[vt][ks], rb[ks], acc); }
#pragma unroll
            for (int qd = 0; qd < 4; ++qd) *(LAS f32x4*)(Yst + (32 * tt + l31) * 68 + 32 * vt + 8 * qd + 4 * h5) = (f32x4){acc[4 * qd], acc[4 * qd + 1], acc[4 * qd + 2], acc[4 * qd + 3]}; } }
    const int v0 = 8 * (lane & 7), ch = head * 64 + v0;
    const f32x4 rk0 = *(const f32x4*)(r_k + ch), rk1 = *(const f32x4*)(r_k + ch + 4), g0 = *(const f32x4*)(lng + ch), g1 = *(const f32x4*)(lng + ch + 4), c0 = *(const f32x4*)(lnb + ch), c1 = *(const f32x4*)(lnb + ch + 4);
    u32x4 nr, nv, nk0, nk1, ng;
#define RO_LD(pass_) do { const size_t m_ = m0 + (pass_) * 8 + (lane >> 3); nr = *(const u32x4*)(rkv + m_ * 1536 + ch); nv = *(const u32x4*)(rkv + m_ * 1536 + 1024 + ch); \
        nk0 = *(const u32x4*)(rkdir + m_ * 1024 + ch); nk1 = *(const u32x4*)(rkdir + m_ * 1024 + 512 + ch); ng = *(const u32x4*)(rg + m_ * 512 + ch); } while (0)
    RO_LD(0);
    LDS_WAIT();
#pragma unroll 1
    for (int pass = 0; pass < 8; ++pass) { const int tok = pass * 8 + (lane >> 3); const size_t m = m0 + tok;
      const f32x4 a0 = *(const LAS f32x4*)(Yst + tok * 68 + v0), a1 = *(const LAS f32x4*)(Yst + tok * 68 + v0 + 4); float y[8] = {a0[0], a0[1], a0[2], a0[3], a1[0], a1[1], a1[2], a1[3]}, r[8], v[8], kd0[8], kd1[8], gg[8];
      unpack8(nr, r); unpack8(nv, v); unpack8(nk0, kd0); unpack8(nk1, kd1); unpack8(ng, gg);
      if (pass < 7) RO_LD(pass + 1);
      float sm = 0.f;
#pragma unroll
      for (int j = 0; j < 8; ++j) sm += y[j];
      sm += __shfl_xor(sm, 1); sm += __shfl_xor(sm, 2); sm += __shfl_xor(sm, 4);
      const float mu = sm * (1.f / 64.f); float q = 0.f;
#pragma unroll
      for (int j = 0; j < 8; ++j) { y[j] -= mu; q += y[j] * y[j]; }
      q += __shfl_xor(q, 1); q += __shfl_xor(q, 2); q += __shfl_xor(q, 4);
      const float rs = rsqrtf(q * (1.f / 64.f) + 64e-5f);
      float bo = 0.f;
#pragma unroll
      for (int j = 0; j < 8; ++j) bo += r[j] * (kd0[j] + kd1[j]) * (j < 4 ? rk0[j] : rk1[j - 4]);
      bo += __shfl_xor(bo, 1); bo += __shfl_xor(bo, 2); bo += __shfl_xor(bo, 4);
#pragma unroll
      for (int j = 0; j < 8; ++j) y[j] = (y[j] * rs * (j < 4 ? g0[j] : g1[j - 4]) + (j < 4 ? c0[j] : c1[j - 4]) + bo * v[j]) * gg[j];
      *(u32x4*)(ymix + m * 2048 + 512 + ch) = pack8(y); }
#undef RO_LD
    LDS_WAIT();
}
__device__ __forceinline__ void phase_rwkv_out(Frame& F, const Params& P, int l) {
    int lane = F.lane; asm volatile("" : "+v"(lane));
    for (int u = F.vcu * NWAVES + F.wave; u < 2048; u += F.G * NWAVES) rwkv_out_wave(F, P, l, u, lane);
}


__device__ __forceinline__ void phase_ln1_router(Frame& F, const Params& P, int l) {
    int lane = F.lane; asm volatile("" : "+v"(lane)); int tid = F.tid; asm volatile("" : "+v"(tid));
    const int gw = F.vcu * NWAVES + F.wave;
    const float* wr = P.in[I_W_RT] + (size_t)l * 1024 * 32; const float* br = P.in[I_B_RT] + (size_t)l * 32;
    const float* g1 = P.in[I_LN1G] + (size_t)l * DM; const float* b1 = P.in[I_LN1B] + (size_t)l * DM;
    LAS int* hist = (LAS int*)(F.lds + L_EXTRA); LAS int* base = hist + 32; LAS float* gb = (LAS float*)(F.lds + L_EXTRA + 512);
    for (int f = tid; f < 4096; f += NTHR) { const int fl = f & 63, st = f >> 6, e = 16 * (st & 1) + (fl & 15), d0 = 32 * (st >> 1) + 4 * (fl >> 4);
        float w[8];
#pragma unroll
        for (int i = 0; i < 8; ++i) w[i] = wr[(size_t)(d0 + (i < 4 ? i : 12 + i)) * 32 + e];
        u32x4 hi, lo; hi.x = pk2(w[0], w[1]); hi.y = pk2(w[2], w[3]); hi.z = pk2(w[4], w[5]); hi.w = pk2(w[6], w[7]);
        lo.x = pk2(w[0] - bflo(hi.x), w[1] - bfhi(hi.x)); lo.y = pk2(w[2] - bflo(hi.y), w[3] - bfhi(hi.y)); lo.z = pk2(w[4] - bflo(hi.z), w[5] - bfhi(hi.z)); lo.w = pk2(w[6] - bflo(hi.w), w[7] - bfhi(hi.w));
        *(LAS u32x4*)(F.lds + f * 16) = hi; *(LAS u32x4*)(F.lds + 65536 + f * 16) = lo; }
    if (tid < 256) *(LAS f32x4*)(gb + 4 * tid) = *(const f32x4*)(g1 + 4 * tid); else *(LAS f32x4*)(gb + 4 * tid) = *(const f32x4*)(b1 + 4 * (tid - 256));
    if (tid < 32) hist[tid] = 0;
    __syncthreads();
    const float* pre = (const float*)(P.ws + A_PRE); float* x1f = (float*)(P.ws + A_X1F); bf16* x1b = (bf16*)(P.ws + A_X1B);
    int* tope = (int*)(P.ws + A_TOPE); float* topg = (float*)(P.ws + A_TOPG); int* topr = (int*)(P.ws + A_TOPR);
    const int q = lane >> 4, m = gw * 8 + (lane & 7); const bool real = !(lane & 8) && m < MTOK;
    int my_e = 0, my_r = 0;
    if (gw * 8 < MTOK) {
        const float* prow = pre + (size_t)m * DM + 4 * q;
        float s1 = 0.f, s2 = 0.f;
        { f32x4 vq[16];
#pragma unroll
          for (int u = 0; u < 8; ++u) { vq[2 * u] = *(const f32x4*)(prow + 32 * u); vq[2 * u + 1] = *(const f32x4*)(prow + 32 * u + 16); }
#pragma unroll 1
          for (int sb = 0; sb < 32; sb += 8) { f32x4 v[16];
#pragma unroll
            for (int u = 0; u < 16; ++u) v[u] = vq[u];
            if (sb + 8 < 32) {
#pragma unroll
                for (int u = 0; u < 8; ++u) { vq[2 * u] = *(const f32x4*)(prow + 32 * (sb + 8 + u)); vq[2 * u + 1] = *(const f32x4*)(prow + 32 * (sb + 8 + u) + 16); } }
#pragma unroll
            for (int u = 0; u < 16; ++u) { s1 += (v[u].x + v[u].y) + (v[u].z + v[u].w); s2 += (v[u].x * v[u].x + v[u].y * v[u].y) + (v[u].z * v[u].z + v[u].w * v[u].w); } } }
        f32x4 vn[8];
#pragma unroll
        for (int u = 0; u < 4; ++u) { vn[2 * u] = *(const f32x4*)(prow + 32 * u); vn[2 * u + 1] = *(const f32x4*)(prow + 32 * u + 16); }
        s1 += __shfl_xor(s1, 16); s1 += __shfl_xor(s1, 32); s2 += __shfl_xor(s2, 16); s2 += __shfl_xor(s2, 32);
        const float mean = s1 * (1.f / DM); const float var = fmaxf(s2 * (1.f / DM) - mean * mean, 0.f); const float rstd = 1.f / sqrtf(var + LN_EPS);
        f32x4 acc0 = {0.f, 0.f, 0.f, 0.f}, acc1 = {0.f, 0.f, 0.f, 0.f};
        float* of = x1f + (size_t)m * DM + 4 * q; bf16* ob = x1b + (size_t)m * DM + 4 * q;
#pragma unroll 1
        for (int sb = 0; sb < 32; sb += 4) { f32x4 v[8];
#pragma unroll
            for (int u = 0; u < 8; ++u) v[u] = vn[u];
            if (sb + 4 < 32) {
#pragma unroll
                for (int u = 0; u < 4; ++u) { vn[2 * u] = *(const f32x4*)(prow + 32 * (sb + 4 + u)); vn[2 * u + 1] = *(const f32x4*)(prow + 32 * (sb + 4 + u) + 16); } }
#pragma unroll
            for (int u = 0; u < 4; ++u) { const int s = sb + u;
                const f32x4 gA = *(const LAS f32x4*)(gb + 32 * s + 4 * q), gB = *(const LAS f32x4*)(gb + 32 * s + 16 + 4 * q), bA = *(const LAS f32x4*)(gb + 1024 + 32 * s + 4 * q), bB = *(const LAS f32x4*)(gb + 1024 + 32 * s + 16 + 4 * q);
                const f32x4 xa = (v[2 * u] - mean) * rstd * gA + bA, xb = (v[2 * u + 1] - mean) * rstd * gB + bB;
                u32x4 H; H.x = pk2(xa.x, xa.y); H.y = pk2(xa.z, xa.w); H.z = pk2(xb.x, xb.y); H.w = pk2(xb.z, xb.w);
                if (real) { *(f32x4*)(of + 32 * s) = xa; *(f32x4*)(of + 32 * s + 16) = xb; *(u32x2*)(ob + 32 * s) = (u32x2){H.x, H.y}; *(u32x2*)(ob + 32 * s + 16) = (u32x2){H.z, H.w}; }
                u32x4 L; L.x = pk2(xa.x - bflo(H.x), xa.y - bfhi(H.x)); L.y = pk2(xa.z - bflo(H.y), xa.w - bfhi(H.y)); L.z = pk2(xb.x - bflo(H.z), xb.y - bfhi(H.z)); L.w = pk2(xb.z - bflo(H.w), xb.w - bfhi(H.w));
                const bf16x8 Hh = __builtin_bit_cast(bf16x8, H), Ll = __builtin_bit_cast(bf16x8, L);
                const bf16x8 Wh0 = *(const LAS bf16x8*)(F.lds + ((2 * s) * 64 + lane) * 16), Wh1 = *(const LAS bf16x8*)(F.lds + ((2 * s + 1) * 64 + lane) * 16);
                const bf16x8 Wl0 = *(const LAS bf16x8*)(F.lds + 65536 + ((2 * s) * 64 + lane) * 16), Wl1 = *(const LAS bf16x8*)(F.lds + 65536 + ((2 * s + 1) * 64 + lane) * 16);
                acc0 = __builtin_amdgcn_mfma_f32_16x16x32_bf16(Wh0, Hh, acc0, 0, 0, 0); acc1 = __builtin_amdgcn_mfma_f32_16x16x32_bf16(Wh1, Hh, acc1, 0, 0, 0);
                acc0 = __builtin_amdgcn_mfma_f32_16x16x32_bf16(Wl0, Hh, acc0, 0, 0, 0); acc1 = __builtin_amdgcn_mfma_f32_16x16x32_bf16(Wl1, Hh, acc1, 0, 0, 0);
                acc0 = __builtin_amdgcn_mfma_f32_16x16x32_bf16(Wh0, Ll, acc0, 0, 0, 0); acc1 = __builtin_amdgcn_mfma_f32_16x16x32_bf16(Wh1, Ll, acc1, 0, 0, 0); } }
        unsigned key[8];
#pragma unroll
        for (int j = 0; j < 8; ++j) { const int e = 16 * (j >> 2) + 4 * q + (j & 3); const float lg = (j < 4 ? acc0[j & 3] : acc1[j & 3]) + br[e];
            unsigned u = __builtin_bit_cast(unsigned, lg); u = (u & 0x80000000u) ? ~u : (u | 0x80000000u); key[j] = (u & ~31u) | (unsigned)(31 - e); }
        unsigned M[4];
#pragma unroll
        for (int r = 0; r < 4; ++r) { unsigned mx = max(max(max(key[0], key[1]), max(key[2], key[3])), max(max(key[4], key[5]), max(key[6], key[7])));
            mx = max(mx, (unsigned)__shfl_xor((int)mx, 16)); mx = max(mx, (unsigned)__shfl_xor((int)mx, 32)); M[r] = mx;
#pragma unroll
            for (int j = 0; j < 8; ++j) key[j] = key[j] == mx ? 0u : key[j]; }
        float tv[4];
#pragma unroll
        for (int r = 0; r < 4; ++r) { const unsigned ub = M[r] & ~31u; tv[r] = __builtin_bit_cast(float, (ub & 0x80000000u) ? (ub & 0x7fffffffu) : ~ub); }
        const float e1 = __expf(tv[1] - tv[0]), e2 = __expf(tv[2] - tv[0]), e3 = __expf(tv[3] - tv[0]), inv = 1.f / (1.f + e1 + e2 + e3);
        if (real) { const unsigned mk = q == 0 ? M[0] : q == 1 ? M[1] : q == 2 ? M[2] : M[3]; const int e = 31 - (int)(mk & 31u); const float gt = (q == 0 ? 1.f : q == 1 ? e1 : q == 2 ? e2 : e3) * inv;
            my_e = e; my_r = __hip_atomic_fetch_add(hist + e, 1, __ATOMIC_RELAXED, __HIP_MEMORY_SCOPE_WORKGROUP);
            tope[(size_t)m * 4 + q] = e; topg[(size_t)m * 4 + q] = gt; }
    }
    __syncthreads();
    if (tid < 32) base[tid] = (int)__hip_atomic_fetch_add((unsigned*)(F.ctl + CW_GCNT + l * 32 + tid), (unsigned)hist[tid], RLX_AGENT);
    __syncthreads();
    if (real) topr[(size_t)m * 4 + q] = base[my_e] + my_r;
    __syncthreads();
}
constexpr int L_MOE = L_MISC - 2048;
__device__ __forceinline__ MoeTab moe_tables(Frame& F, int l) {
    LAS int* ps = (LAS int*)(F.lds + L_MOE); LAS int* pe = ps + 64;
    __syncthreads();
    if (F.tid < 32) { const int e = F.tid;
        const int c = (int)__hip_atomic_load((unsigned*)(F.ctl + CW_GCNT + l * 32 + e), RLX_AGENT); const int np = (c + 255) >> 8;
        int incl = np;
#pragma unroll
        for (int o = 1; o < 32; o <<= 1) { const int t = __shfl_up(incl, o, 32); if (e >= o) incl += t; }
        const int st = incl - np < 288 ? incl - np : 288, en = incl < 288 ? incl : 288;
        ps[e] = st; for (int p = st; p < en; ++p) pe[p] = e;
        if (e == 31) ps[32] = en; }
    __syncthreads();
    MoeTab T; T.pstart = ps; T.panel_e = pe; T.npanels = ps[32]; return T;
}
__device__ __forceinline__ void phase_dispatch(Frame& F, const Params& P, const MoeTab& T) {
    const int* tope = (const int*)(P.ws + A_TOPE); const int* topr = (const int*)(P.ws + A_TOPR); int* rowtok = (int*)(P.ws + A_ROWTOK);
    int tid = F.tid; asm volatile("" : "+v"(tid));
    for (int s = F.vcu * NTHR + tid; s < MTOK * 4; s += F.G * NTHR) { const int e = tope[s], r = topr[s]; const int pos = T.pstart[e] * 256 + r; if (pos < MPAD) rowtok[pos] = s >> 2; }
    for (int s = F.vcu * NTHR + tid; s < MTOK; s += F.G * NTHR) rowtok[MPAD + s] = s;
}
__device__ __forceinline__ void phase_ln2(Frame& F, const Params& P, int l, const MoeTab& T, float* outf, bf16* outb) {
    int lane = F.lane; asm volatile("" : "+v"(lane));
    const int gw = F.vcu * NWAVES + F.wave, NGW = F.G * NWAVES;
    const float* x1f = (const float*)(P.ws + A_X1F); const bf16* ye = (const bf16*)(P.ws + A_YE); const bf16* pleb = (const bf16*)(P.ws + A_PLEB);
    const int* tope = (const int*)(P.ws + A_TOPE); const float* topg = (const float*)(P.ws + A_TOPG); const int* topr = (const int*)(P.ws + A_TOPR);
    const float* g2 = P.in[I_LN2G] + (size_t)l * DM; const float* b2 = P.in[I_LN2B] + (size_t)l * DM;
    f32x4 gq_[2][2], bq_[2][2];
#pragma unroll
    for (int q = 0; q < 2; ++q) { const int ch = 8 * lane + 512 * q; gq_[q][0] = *(const f32x4*)(g2 + ch); gq_[q][1] = *(const f32x4*)(g2 + ch + 4); bq_[q][0] = *(const f32x4*)(b2 + ch); bq_[q][1] = *(const f32x4*)(b2 + ch + 4); }
    for (int m = gw; m < MTOK; m += NGW) {
        float v[16];
#pragma unroll
        for (int q = 0; q < 2; ++q) { const int ch = 8 * lane + 512 * q; const f32x4 a0 = *(const f32x4*)(x1f + (size_t)m * DM + ch), a1 = *(const f32x4*)(x1f + (size_t)m * DM + ch + 4);
            float pl[8]; unpack8(*(const u32x4*)(pleb + (size_t)m * DM + ch), pl);
#pragma unroll
            for (int j = 0; j < 8; ++j) v[8 * q + j] = DN_ALPHA * (j < 4 ? a0[j] : a1[j - 4]) + pl[j]; }
#pragma unroll
        for (int k = 0; k < 4; ++k) { const int e = tope[(size_t)m * 4 + k], r = topr[(size_t)m * 4 + k]; const float gt = topg[(size_t)m * 4 + k]; int pos = T.pstart[e] * 256 + r; pos = pos < MPAD ? pos : MPAD - 1;
#pragma unroll
            for (int q = 0; q < 2; ++q) { float y[8]; unpack8(*(const u32x4*)(ye + (size_t)pos * DM + 8 * lane + 512 * q), y);
#pragma unroll
                for (int j = 0; j < 8; ++j) v[8 * q + j] += gt * y[j]; } }
        float s = 0.f;
#pragma unroll
        for (int j = 0; j < 16; ++j) s += v[j];
        const float mean = wave_sum(s) * (1.f / DM); float s2 = 0.f;
#pragma unroll
        for (int j = 0; j < 16; ++j) { v[j] -= mean; s2 += v[j] * v[j]; }
        const float rstd = 1.f / sqrtf(wave_sum(s2) * (1.f / DM) + LN_EPS);
#pragma unroll
        for (int q = 0; q < 2; ++q) { const int ch = 8 * lane + 512 * q; const f32x4 ga = gq_[q][0], gb = gq_[q][1], ba = bq_[q][0], bb = bq_[q][1];
            float o[8];
#pragma unroll
            for (int j = 0; j < 8; ++j) o[j] = v[8 * q + j] * rstd * (j < 4 ? ga[j] : gb[j - 4]) + (j < 4 ? ba[j] : bb[j - 4]);
            *(f32x4*)(outf + (size_t)m * DM + ch) = (f32x4){o[0], o[1], o[2], o[3]}; *(f32x4*)(outf + (size_t)m * DM + ch + 4) = (f32x4){o[4], o[5], o[6], o[7]};
            if (outb) *(u32x4*)(outb + (size_t)m * DM + ch) = pack8(o); }
    }
}

#ifndef STOP_AT
#define STOP_AT 1000
#endif
#define GRID_BAR() xcd_barrier(bar)
#define CKPT(n) do { if (l * 100 + (n) >= STOP_AT) return; } while (0)
template <int l> __device__ __forceinline__ void layer_body(Frame& F, const Params& P, const XcdBarrier& bar) {
    const int c = (int)blockIdx.x, G = F.G;
    { SchedPlain S{(const char*)(P.ws + A_XB), (const char*)(P.ws + WS_W_IN + l * W_IN_SZ), 2048, 2048, 16, 64, NPN_IN, G, c};
      EpiInproj E{(bf16*)(P.ws + A_COLS), (float*)(P.ws + A_SIDE)};
      pg8::gemm_phase<false>(F.lds + L_STAGE, S, E, 2048, 2048, nullptr); }
    GRID_BAR(); CKPT(1);
    phase_prep(F, P, l);
    GRID_BAR(); CKPT(2);
    { SchedPlain S{(const char*)(P.ws + A_LIN), (const char*)(P.ws + WS_W_LORA + l * W_LORA_SZ), 768, 768, 6, 64, 10, G, c};
      EpiLora E{(float*)(P.ws + A_RLOGW), (bf16*)(P.ws + A_RKDIR), (bf16*)(P.ws + A_RKKA), (bf16*)(P.ws + A_RG), (const bf16*)(P.ws + A_RKV), (const bf16*)(P.ws + A_RKK),
                P.in[I_R_W0] + (size_t)l * 1024, P.in[I_R_A0] + (size_t)l * 1024, P.in[I_R_KA] + (size_t)l * 512};
      pg8::gemm_phase<false>(F.lds + L_STAGE, S, E, 768, 768, nullptr); }
    phase_ssd_states(F, P);
    GRID_BAR(); CKPT(3);
    phase_gdn_a(F, P);
    phase_rwkv_a(F, P);
    { int lane2 = F.lane; asm volatile("" : "+v"(lane2)); for (int item = (F.vcu * NWAVES + F.wave) * 64 + lane2; item < 64 * 2048; item += F.G * NTHR) ssd_scan_item(P, item); }
    GRID_BAR();
    phase_scan_seq(F, P, l);
    GRID_BAR(); CKPT(4);
    phase_gdn_out(F, P, l);
    phase_rwkv_out(F, P, l);
    GRID_BAR(); CKPT(5);
    { SchedBranch S{(const char*)(P.ws + A_YMIX), (const char*)(P.ws + WS_W_BR + l * W_BR_SZ), G, c};
      EpiBranch E{(const bf16*)(P.ws + A_COLS), (bf16*)(P.ws + A_MERGED)};
      pg8::gemm_phase<false>(F.lds + L_STAGE, S, E, 4096, 4096, nullptr); }
    GRID_BAR(); CKPT(6);
    { SchedPlain S{(const char*)(P.ws + A_MERGED), (const char*)(P.ws + WS_W_O + l * W_SQ_SZ), 2048, 2048, 16, 64, 4, G, c};
      EpiWo E{(const float*)(P.ws + A_XF), (float*)(P.ws + A_PRE)};
      pg8::gemm_phase<false>(F.lds + L_STAGE, S, E, 2048, 2048, nullptr); }
    GRID_BAR(); CKPT(7);
    phase_ln1_router(F, P, l);
    GRID_BAR(); CKPT(8);
    MoeTab T = moe_tables(F, l);
    phase_dispatch(F, P, T);
    GRID_BAR(); CKPT(9);
    { SchedGu S{(const char*)(P.ws + A_X1B), (const char*)(P.ws + WS_W_GU + (size_t)l * 32 * W_GU_SZ), (const char*)(P.ws + WS_W_PLG + l * W_SQ_SZ), T, G, c};
      EpiGuPlg E{EpiGu{(bf16*)(P.ws + A_ACT), P.in[I_B_GU] + (size_t)l * 32 * 2048}, EpiPlg{(bf16*)(P.ws + A_SG)}};
      pg8::gemm_phase<true>(F.lds + L_STAGE, S, E, 2048, 2048, (const int*)(P.ws + A_ROWTOK)); }
    GRID_BAR(); CKPT(10);
    { SchedDnPle S{(const char*)(P.ws + A_ACT), (const char*)(P.ws + WS_W_DN + (size_t)l * 32 * W_SQ_SZ), (const char*)(P.ws + A_PB + (size_t)l * MTOK * 2048), (const char*)(P.ws + WS_W_PL + l * W_PL_SZ), (const char*)(P.ws + A_X1B), (const char*)(P.ws + WS_W_PLG + l * W_SQ_SZ), T, G, c};
      EpiDnPle E{(bf16*)(P.ws + A_YE), P.in[I_B_DN] + (size_t)l * 32 * 1024, (bf16*)(P.ws + A_PLEB), (const bf16*)(P.ws + A_SG), (bf16*)(P.ws + A_SG)};
      pg8::gemm_phase<false>(F.lds + L_STAGE, S, E, 2048, 2048, nullptr); }
    GRID_BAR(); CKPT(11);
    if (l + 1 < DEPTH) phase_ln2(F, P, l, T, (float*)(P.ws + A_XF), (bf16*)(P.ws + A_XB));
    else phase_ln2(F, P, l, T, P.out, nullptr);
    if (l + 1 < DEPTH) GRID_BAR(); CKPT(12);
}

__global__ void __launch_bounds__(NTHR, 2) fwd_kernel(Params P) {
    extern __shared__ __attribute__((aligned(16))) unsigned char lds_raw[];
    Frame F;
    F.lds = (LAS unsigned char*)lds_raw; F.MISC = (volatile LAS unsigned*)(F.lds + L_MISC);
    F.tid = threadIdx.x; F.lane = F.tid & 63; F.wave = __builtin_amdgcn_readfirstlane(F.tid >> 6);
    F.G = gridDim.x; { const int bx = blockIdx.x; F.vcu = (bx % 8) * (F.G / 8) + bx / 8; }
    F.ws = P.ws; F.ctl = (gu32*)(P.ws + WS_CTL);
    if (F.tid < 64) F.MISC[F.tid] = 0u;
    __syncthreads();
    XcdBarrier bar = xcd_barrier_post((unsigned*)(F.ctl + CW_BAR), F.MISC + 8);

    phase_prologue(F, P);
    GRID_BAR();
    if (STOP_AT <= 0) return;
    layer_body<0>(F, P, bar);
    if (STOP_AT < 100) return;
    layer_body<1>(F, P, bar);
}

extern "C" void kernel_launch(void* const* d_in, const int* in_sizes, int n_in, void* d_out, int out_size, void* d_ws, size_t ws_size, hipStream_t stream) {
    static int grid = 0;
    if (grid == 0) {
        if (n_in != 41 || out_size != MTOK * DM || ws_size < WS_END) { fprintf(stderr, "kernel_launch: unexpected shapes (n_in %d, out %d, ws %zu < %zu)\n", n_in, out_size, ws_size, (size_t)WS_END); grid = -1; return; }
        static const int exp_sizes[41] = {16777216, 8388608, 1024, 1024, 19759104, 15360, 16, 16, 256, 3840, 3840, 2048, 131072, 2048, 131072, 131072, 1024, 1024, 1024, 1024, 1024,
            15360, 3072, 64, 64, 32, 2048, 4194304, 2097152, 2048, 2048, 65536, 64, 134217728, 131072, 67108864, 65536, 524288, 2097152, 2048, 2048};
        for (int i = 0; i < 41; ++i) if (in_sizes[i] != exp_sizes[i]) { fprintf(stderr, "kernel_launch: input %d has %d elements, expected %d\n", i, in_sizes[i], exp_sizes[i]); grid = -1; return; }
        int dev = 0, cus = 0, per_cu = 0;
        if (hipGetDevice(&dev) != hipSuccess || hipDeviceGetAttribute(&cus, hipDeviceAttributeMultiprocessorCount, dev) != hipSuccess) { grid = -1; return; }
        if (hipFuncSetAttribute((const void*)fwd_kernel, hipFuncAttributeMaxDynamicSharedMemorySize, LDS_BYTES) != hipSuccess) { fprintf(stderr, "kernel_launch: hipFuncSetAttribute failed\n"); grid = -1; return; }
        if (hipOccupancyMaxActiveBlocksPerMultiprocessor(&per_cu, (const void*)fwd_kernel, NTHR, LDS_BYTES) != hipSuccess || per_cu < 1) { fprintf(stderr, "kernel_launch: occupancy query says %d\n", per_cu); }
        (void)hipGetLastError();
        grid = cus;
        if (grid != 256) { fprintf(stderr, "kernel_launch: built for 256 CUs, device has %d\n", cus); grid = -1; return; }
    }
    if (grid < 0) return;
    (void)hipMemsetAsync((char*)d_ws + WS_CTL, 0, CTL_ZERO_BYTES, stream);
    Params p{};
    for (int i = 0; i < 41; ++i) p.in[i] = (const float*)d_in[i];
    p.out = (float*)d_out; p.ws = (unsigned char*)d_ws;
    hipLaunchKernelGGL(fwd_kernel, dim3(grid), dim3(NTHR), LDS_BYTES, stream, p);
}
```

```cpp
#include <hip/hip_runtime.h>
#include <cstdio>
#include <cstdint>

#define GAS __attribute__((address_space(1)))
#define LAS __attribute__((address_space(3)))
typedef unsigned short bf16;
typedef unsigned u32x4 __attribute__((ext_vector_type(4)));
typedef unsigned u32x2 __attribute__((ext_vector_type(2)));
typedef float f32x4 __attribute__((ext_vector_type(4)));
typedef float f32x2 __attribute__((ext_vector_type(2)));
typedef short bf16x8 __attribute__((ext_vector_type(8)));
typedef GAS unsigned gu32;
#define RLX_AGENT __ATOMIC_RELAXED, __HIP_MEMORY_SCOPE_AGENT

constexpr int DM = 1024, SEQ = 8192, NB = 2, MTOK = NB * SEQ, DEPTH = 2, PLE = 256, NEXP = 32, TOPK = 4, DEXP = 1024;
constexpr int NCB = 9472;
constexpr int NPN_IN = 38;
constexpr int MPAD = 73728;
constexpr float LN_EPS = 1e-5f;
constexpr float DN_ALPHA = 1.4142135623730951f;
constexpr int C_GQKV = 0, C_GZ = 1536, C_RRKV = 2048, C_RAL = 3584, C_RGL = 3712, C_SZ = 3840, C_SXBC = 4864, C_GATE = 6400;

constexpr size_t MiB = 1u << 20;
constexpr size_t WS_CTL = 0, CTL_ZERO_BYTES = 1 * MiB;
constexpr size_t W_IN_SZ = (size_t)9728 * 1024 * 2, W_BR_SZ = (size_t)1024 * 2048 * 2, W_SQ_SZ = (size_t)1024 * 1024 * 2, W_GU_SZ = (size_t)2048 * 1024 * 2,
                 W_PL_SZ = (size_t)1024 * 1024 * 2, W_LORA_SZ = (size_t)2560 * 384 * 2;
constexpr size_t WS_W_IN = 1 * MiB;
constexpr size_t WS_W_BR = WS_W_IN + 2 * W_IN_SZ;
constexpr size_t WS_W_O = WS_W_BR + 2 * W_BR_SZ;
constexpr size_t WS_W_PLG = WS_W_O + 2 * W_SQ_SZ;
constexpr size_t WS_W_PL = WS_W_PLG + 2 * W_SQ_SZ;
constexpr size_t WS_W_LORA = WS_W_PL + 2 * W_PL_SZ;
constexpr size_t WS_W_GU = ((WS_W_LORA + 2 * W_LORA_SZ + MiB - 1) / MiB) * MiB;
constexpr size_t WS_W_DN = WS_W_GU + 64 * W_GU_SZ;
constexpr size_t WS_ACT0 = WS_W_DN + 64 * W_SQ_SZ;
constexpr size_t A_XF = WS_ACT0;
constexpr size_t A_XB = A_XF + 64 * MiB;
constexpr size_t A_COLS = A_XB + 32 * MiB;
constexpr size_t A_ACT = A_COLS;
constexpr size_t A_YE = A_COLS + 144 * MiB;
constexpr size_t A_SIDE = A_COLS + 296 * MiB;
constexpr size_t A_PB = A_SIDE + 16 * MiB;
constexpr size_t A_GQKV = A_PB + 64 * MiB;
constexpr size_t A_GSC = A_GQKV + 48 * MiB;
constexpr size_t A_SXBC = A_GSC + 1 * MiB;
constexpr size_t A_SSC = A_SXBC + 48 * MiB;
constexpr size_t A_RKV = A_SSC + 4 * MiB;
constexpr size_t A_RKK = A_RKV + 48 * MiB;
constexpr size_t A_LIN = A_RKK + 16 * MiB;
constexpr size_t A_RLOGW = A_LIN + 12 * MiB;
constexpr size_t A_RKDIR = A_RLOGW + 64 * MiB;
constexpr size_t A_RKKA = A_RKDIR + 32 * MiB;
constexpr size_t A_RG = A_RKKA + 32 * MiB;
constexpr size_t A_OG = A_RG + 16 * MiB;
constexpr size_t A_OR = A_OG + 64 * MiB;
constexpr size_t A_OS = A_OR + 64 * MiB;
constexpr size_t A_HS = A_OS;
constexpr size_t A_SDEC = A_OS + 64 * MiB;
constexpr size_t A_YMIX = A_OS + 128 * MiB;
constexpr size_t A_MPART = A_YMIX + 64 * MiB;
constexpr size_t A_MERGED = A_MPART + 64 * MiB;
constexpr size_t A_PRE = A_OG;
constexpr size_t A_X1F = A_OR;
constexpr size_t A_X1B = A_OS;
constexpr size_t A_SG = A_OS + 32 * MiB;
constexpr size_t A_PLEB = A_OS + 64 * MiB;
constexpr size_t A_TOPE = A_RKK;
constexpr size_t A_TOPG = A_TOPE + 256 * 1024;
constexpr size_t A_TOPR = A_TOPG + 256 * 1024;
constexpr size_t A_ROWTOK = A_TOPR + 256 * 1024;
constexpr size_t A_WRT = A_MERGED + 32 * MiB;
constexpr size_t A_GPSI = A_WRT + 1 * MiB;
constexpr size_t A_GLAM = A_GPSI + 64 * MiB;
constexpr size_t A_GQT = A_GLAM + 64 * MiB;
constexpr size_t A_GO0 = A_GQT + 32 * MiB;
constexpr size_t A_GH = A_GO0 + 32 * MiB;
constexpr size_t A_GD = A_GH + 64 * MiB;
constexpr size_t A_RPSI = A_OG;
constexpr size_t A_RLAM = A_OG + 32 * MiB;
constexpr size_t A_RRT = A_OR;
constexpr size_t A_RY0 = A_OR + 32 * MiB;
constexpr size_t A_RH = A_MPART;
constexpr size_t A_RPC = A_MPART + 32 * MiB;
constexpr size_t WS_END = A_GD + 1 * MiB;
static_assert(WS_END <= (size_t)2040 * MiB, "d_ws map");
constexpr int CW_BAR = 4096;
constexpr int CW_GCNT = 16384;

constexpr int LDS_BYTES = 163840;
constexpr int L_STAGE = 0;
constexpr int L_EXTRA = 131072;
constexpr int L_MISC = LDS_BYTES - 256;
constexpr int NWAVES = 8, NTHR = 512;

#define LDS_WAIT() asm volatile("s_waitcnt lgkmcnt(0)" ::: "memory")
#define VM_WAIT() asm volatile("s_waitcnt vmcnt(0)" ::: "memory")
__device__ __forceinline__ unsigned f2bf(float f) { unsigned u = __builtin_bit_cast(unsigned, f); return (u + 0x7fffu + ((u >> 16) & 1u)) >> 16; }
typedef __bf16 bf16x2_t __attribute__((ext_vector_type(2)));
__device__ __forceinline__ unsigned pk2(float lo, float hi) { const f32x2 v = {lo, hi}; return __builtin_bit_cast(unsigned, __builtin_convertvector(v, bf16x2_t)); }
__device__ __forceinline__ float bf2f(unsigned h) { return __builtin_bit_cast(float, h << 16); }
__device__ __forceinline__ float bflo(unsigned w) { return __builtin_bit_cast(float, w << 16); }
__device__ __forceinline__ float bfhi(unsigned w) { return __builtin_bit_cast(float, w & 0xffff0000u); }
__device__ __forceinline__ float sigmoidf_(float x) { return __builtin_amdgcn_rcpf(1.0f + __expf(-x)); }
__device__ __forceinline__ float siluf_(float x) { return x * __builtin_amdgcn_rcpf(1.0f + __expf(-x)); }
__device__ __forceinline__ float softplusf_(float x) { return x > 20.f ? x : log1pf(__expf(x)); }
__device__ __forceinline__ float wave_sum(float v) {
#pragma unroll
    for (int o = 1; o < 64; o <<= 1) v += __shfl_xor(v, o);
    return v;
}
__device__ __forceinline__ void unpack8(u32x4 w, float (&f)[8]) {
    f[0] = bflo(w.x); f[1] = bfhi(w.x); f[2] = bflo(w.y); f[3] = bfhi(w.y); f[4] = bflo(w.z); f[5] = bfhi(w.z); f[6] = bflo(w.w); f[7] = bfhi(w.w);
}
__device__ __forceinline__ u32x4 pack8(const float (&f)[8]) { u32x4 w; w.x = pk2(f[0], f[1]); w.y = pk2(f[2], f[3]); w.z = pk2(f[4], f[5]); w.w = pk2(f[6], f[7]); return w; }

#define XB_TMO      128
#define XB_XCNT(j)  (256  + 64 * (j))
#define XB_XSUB(j)  (1280 + 64 * (j))
#define XB_XGEN(j)  (2304 + 64 * (j))
#define XB_TOP      3328
#define XB_TOPGEN   3392
#define XCD_BAR_WORDS 3456
#define XB_SPIN_CAP (1u << 22)
__device__ __forceinline__ unsigned xb_ld(unsigned* p)              { return __hip_atomic_load(p, __ATOMIC_RELAXED, __HIP_MEMORY_SCOPE_AGENT); }
__device__ __forceinline__ unsigned xb_add(unsigned* p, unsigned v) { return __hip_atomic_fetch_add(p, v, __ATOMIC_RELAXED, __HIP_MEMORY_SCOPE_AGENT); }
__device__ __forceinline__ unsigned xb_xcc_id() { return (unsigned)__builtin_amdgcn_s_getreg((3 << 11) | 20) & 0xFu; }
#define XB_SPIN(cond, bar) do { unsigned _sp = 0; while (cond) { __builtin_amdgcn_s_sleep(1); \
    if ((++_sp & 255u) == 0u) { if (xb_ld(&(bar)[XB_TMO])) break; if (_sp > XB_SPIN_CAP) { atomicAdd(&(bar)[XB_TMO], 1u); break; } } } } while (0)
struct XcdBarrier { unsigned* bar; unsigned x; volatile LAS unsigned* st; };
__device__ __forceinline__ XcdBarrier xcd_barrier_post(unsigned* bar, volatile LAS unsigned* st) {
    XcdBarrier b; b.bar = bar; b.x = xb_xcc_id(); b.st = st;
    if (threadIdx.x == 0) (void)xb_add(&bar[XB_XCNT(b.x)], 1u);
    return b;
}
__device__ __forceinline__ void xcd_barrier_complete(unsigned* bar, unsigned x, unsigned& nloc, unsigned& nx) {
    const unsigned G = gridDim.x * gridDim.y * gridDim.z;
    unsigned sum, cnt, mine, sp = 0u;
    for (;;) {
        sum = 0u; cnt = 0u; mine = 0u;
#pragma unroll
        for (unsigned j = 0; j < 16; ++j) { const unsigned c = xb_ld(&bar[XB_XCNT(j)]); sum += c; cnt += (c > 0u) ? 1u : 0u; mine = (j == x) ? c : mine; }
        if (sum == G) break;
        __builtin_amdgcn_s_sleep(1);
        if ((++sp & 255u) == 0u) { if (xb_ld(&bar[XB_TMO])) break; if (sp > XB_SPIN_CAP) { atomicAdd(&bar[XB_TMO], 1u); break; } }
    }
    nloc = mine > 0u ? mine : 1u; nx = cnt > 0u ? cnt : 1u;
}
__device__ __forceinline__ void xcd_barrier(const XcdBarrier& b) {
    asm volatile("s_waitcnt vmcnt(0)" ::: "memory");
    __syncthreads();
    if (threadIdx.x == 0) {
        unsigned* bar = b.bar;
        __builtin_amdgcn_s_waitcnt(0);
        unsigned nloc = b.st[0], nx = b.st[1];
        if (nloc == 0u) { xcd_barrier_complete(bar, b.x, nloc, nx); b.st[0] = nloc; b.st[1] = nx; }
        const unsigned old = xb_add(&bar[XB_XSUB(b.x)], 1u);
        const unsigned gen = old / nloc;
        if (old + 1u == (gen + 1u) * nloc) {
            __builtin_amdgcn_fence(__ATOMIC_RELEASE, "agent");
            asm volatile("s_waitcnt vmcnt(0)" ::: "memory");
            const unsigned og = xb_add(&bar[XB_TOP], 1u);
            const unsigned tg = og / nx;
            if (og + 1u == (tg + 1u) * nx) xb_add(&bar[XB_TOPGEN], 1u);
            else XB_SPIN(xb_ld(&bar[XB_TOPGEN]) == tg, bar);
            __builtin_amdgcn_fence(__ATOMIC_ACQUIRE, "agent");
            xb_add(&bar[XB_XGEN(b.x)], 1u);
            asm volatile("s_waitcnt vmcnt(0)" ::: "memory");
        } else {
            XB_SPIN(xb_ld(&bar[XB_XGEN(b.x)]) == gen, bar);
            __builtin_amdgcn_fence(__ATOMIC_ACQUIRE, "agent");
            asm volatile("s_waitcnt vmcnt(0)" ::: "memory");
        }
    }
    __syncthreads();
}

struct Params {
    const float* in[41];
    float* out;
    unsigned char* ws;
};
enum { I_X = 0, I_P, I_LNIN_G, I_LNIN_B, I_W_IN, I_GDN_CONV, I_GDN_ALOG, I_GDN_DTB, I_GDN_NORM, I_R_MUP, I_R_MUN, I_R_W0, I_R_WUP, I_R_A0, I_R_AUP, I_R_GUP,
       I_R_KK, I_R_KA, I_R_RK, I_R_LNG, I_R_LNB, I_S_CONV, I_S_CONVB, I_S_ALOG, I_S_DTB, I_S_D, I_S_NORM, I_W_BR, I_W_O, I_LN1G, I_LN1B, I_W_RT, I_B_RT,
       I_W_GU, I_B_GU, I_W_DN, I_B_DN, I_W_PL, I_W_PLG, I_LN2G, I_LN2B };

struct Frame {
    LAS unsigned char* lds;
    volatile LAS unsigned* MISC;
    gu32* ctl;
    unsigned char* ws;
    int tid, lane, wave, vcu, G;
};
#define WSP(T, off) ((T*)(F.ws + (off)))

namespace pg8 {
constexpr int BM = 256, BK = 64, HALF = 128, HTB = HALF * BK * 2, STAGE_BYTES = 8 * HTB, NXCD = 8, WGM = 8;
__host__ __device__ __forceinline__ int lds_byte(int r, int c) { const int st = (r >> 4) * 2 + (c >> 5), rr = r & 15, cc = c & 31, ob = rr * 64 + cc * 2; return st * 1024 + (ob ^ (((ob >> 9) & 1) << 5)); }
__host__ __device__ __forceinline__ void stage_rc(int b, int& R, int& C) { const int st = b / 1024, sb = b % 1024, swz = sb ^ (((sb >> 9) & 1) << 5); R = (st >> 1) * 16 + swz / 64; C = (st & 1) * 32 + (swz % 64) / 2; }
__host__ __device__ __forceinline__ int perm32(int rho) { const int n = rho >> 4, i = rho & 15; return 8 * (i >> 2) + 4 * n + (i & 3); }

struct GUnit {
    const char* A; const char* B;
    int nt;
    int arow0;
    int kind, pm, pn, aux;
};
__device__ __forceinline__ void tile_order(int L, int nM, int nN, int& pm, int& pn) {
    const int nwg = nM * nN; int wgid = L;
    { const int q = nwg / NXCD, r = nwg % NXCD, xcd = wgid % NXCD, off = wgid / NXCD; wgid = (xcd < r ? xcd * (q + 1) : r * (q + 1) + (xcd - r) * q) + off; }
    const int nig = WGM * nN, gid = wgid / nig, fm = gid * WGM, gsz = (nM - fm) < WGM ? (nM - fm) : WGM;
    pm = fm + ((wgid % nig) % gsz); pn = (wgid % nig) / gsz;
}

template <bool GATHER, class Sched, class Epi>
__device__ __forceinline__ void gemm_phase(LAS unsigned char* lds, const Sched& S, const Epi& E, const int lda, const int ldb, const int* gather) {
    int tid = threadIdx.x; asm volatile("" : "+v"(tid));
    const int wid = __builtin_amdgcn_readfirstlane(tid >> 6), lane = tid & 63, wr = wid >> 2, wc = wid & 3, fr = lane & 15, fq = lane >> 4;
    unsigned voffA[2], voffB[2], gA1[2]; int gR[2], gC[2];
#pragma unroll
    for (int i = 0; i < 2; ++i) { int R, C; stage_rc(tid * 16 + i * 8192, R, C); const int Rb = (R & ~31) + perm32(R & 31);
        voffA[i] = (unsigned)(R * lda + C * 2); voffB[i] = (unsigned)(Rb * ldb + C * 2); gR[i] = R; gC[i] = C * 2; gA1[i] = 0u; }
    const size_t kstep = (size_t)(BK * 2);
    const size_t hstepA = GATHER ? 0 : (size_t)HALF * lda, hstepB = (size_t)HALF * ldb;
    const unsigned ldsw = (unsigned)wid * 1024u;
    const int aoff = lds_byte(wr * 64 + fr, fq * 8), boff = lds_byte(wc * 32 + fr, fq * 8);
#define PG8_SA(b, h) (((b) * 2 + (h)) * HTB)
#define PG8_SB(b, h) ((4 + (b) * 2 + (h)) * HTB)
#define PG8_STAGE(bufoff, gbase, voff) do { _Pragma("unroll") for (int _i = 0; _i < 2; ++_i) \
        __builtin_amdgcn_global_load_lds((const unsigned*)((const char*)(gbase) + (voff)[_i]), (LAS unsigned*)(lds + (bufoff) + ldsw + _i * 8192), 16, 0, 0); } while (0)
#define PG8_LDA(dst, b, h) do { _Pragma("unroll") for (int m = 0; m < 4; ++m) _Pragma("unroll") for (int k = 0; k < 2; ++k) dst[m][k] = *(const LAS bf16x8*)(lds + PG8_SA(b, h) + aoff + m * 2048 + k * 1024); } while (0)
#define PG8_LDB(dst, b, h) do { _Pragma("unroll") for (int n = 0; n < 2; ++n) _Pragma("unroll") for (int k = 0; k < 2; ++k) dst[n][k] = *(const LAS bf16x8*)(lds + PG8_SB(b, h) + boff + n * 2048 + k * 1024); } while (0)
#define PG8_MMA(ai, bj, At, Bt) do { __builtin_amdgcn_s_setprio(1); _Pragma("unroll") for (int m = 0; m < 4; ++m) _Pragma("unroll") for (int n = 0; n < 2; ++n) _Pragma("unroll") for (int k = 0; k < 2; ++k) \
        acc[ai][bj][m][n] = __builtin_amdgcn_mfma_f32_16x16x32_bf16(Bt[n][k], At[m][k], acc[ai][bj][m][n], 0, 0, 0); __builtin_amdgcn_s_setprio(0); } while (0)
#define PG8_WAIT_V(n) asm volatile("s_waitcnt vmcnt(" #n ")" ::: "memory")
#define PG8_WAIT_L(n) asm volatile("s_waitcnt lgkmcnt(" #n ")" ::: "memory")
#define PG8_BAR __builtin_amdgcn_s_barrier()
#define PG8_SCHED __builtin_amdgcn_sched_barrier(0)
#define PG8_GOFFS(slot, o0, o1) do { _Pragma("unroll") for (int _i = 0; _i < 2; ++_i) { \
        unsigned r0 = (unsigned)gidx[(slot) * 256 + gR[_i]], r1 = (unsigned)gidx[(slot) * 256 + HALF + gR[_i]]; \
        r0 = r0 < (unsigned)MTOK ? r0 : (unsigned)(MTOK - 1); r1 = r1 < (unsigned)MTOK ? r1 : (unsigned)(MTOK - 1); \
        o0[_i] = r0 * (unsigned)lda + (unsigned)gC[_i]; o1[_i] = r1 * (unsigned)lda + (unsigned)gC[_i]; } } while (0)
    GUnit cur, nxt; int ui = 0;
    LAS int* gidx = (LAS int*)(lds + STAGE_BYTES);
    if constexpr (GATHER) {
#pragma unroll 1
        for (int i = 0; i < 16; ++i) { GUnit t; if (!S.next(i, t)) break; if (tid < 256) gidx[i * 256 + tid] = gather[t.arow0 + tid]; }
        __syncthreads(); }
    if (!S.next(0, cur)) return;
    f32x4 acc[2][2][4][2];
#pragma unroll
    for (int a = 0; a < 2; ++a)
#pragma unroll
        for (int b = 0; b < 2; ++b)
#pragma unroll
            for (int m = 0; m < 4; ++m)
#pragma unroll
                for (int n = 0; n < 2; ++n) acc[a][b][m][n] = (f32x4){0.f, 0.f, 0.f, 0.f};
    bf16x8 At[4][2], B0[2][2], B1[2][2];
    if constexpr (GATHER) { PG8_GOFFS(0, voffA, gA1); }
    const char* cA = cur.A; const char* cB = cur.B;
#define PG8_A1(off) (GATHER ? gA1 : voffA)
    PG8_STAGE(PG8_SB(0, 0), cB, voffB); PG8_STAGE(PG8_SB(0, 1), cB + hstepB, voffB); PG8_STAGE(PG8_SA(0, 0), cA, voffA);
    if constexpr (GATHER) { PG8_STAGE(PG8_SA(0, 1), cA, gA1); } else { PG8_STAGE(PG8_SA(0, 1), cA + hstepA, voffA); }
    if (wr == 1) PG8_BAR;
    PG8_WAIT_V(2); PG8_BAR;
    PG8_STAGE(PG8_SB(1, 0), cB + kstep, voffB); PG8_STAGE(PG8_SA(1, 0), cA + kstep, voffA); PG8_STAGE(PG8_SB(1, 1), cB + hstepB + kstep, voffB);
    PG8_WAIT_V(6); PG8_BAR;
    for (;;) {
        const bool has_next = S.next(ui + 1, nxt);
        const int nt = cur.nt;
        const char* nA = has_next ? nxt.A : cA; const char* nB = has_next ? nxt.B : cB;
        for (int t = 0; t < nt; t += 2) {
            const bool last = (t == nt - 2);
            const char* a1 = cA + (size_t)(t + 1) * kstep;
            const char* a2 = last ? nA : cA + (size_t)(t + 2) * kstep; const char* b2 = last ? nB : cB + (size_t)(t + 2) * kstep;
            const char* a3 = a2 + kstep; const char* b3 = b2 + kstep;
            unsigned pA0[2], pA1[2];
            if constexpr (GATHER) {
                if (last && has_next) { PG8_GOFFS(ui + 1, pA0, pA1); }
                else {
#pragma unroll
                    for (int i = 0; i < 2; ++i) { pA0[i] = voffA[i]; pA1[i] = gA1[i]; } }
            }
            PG8_LDB(B0, 0, 0); PG8_LDB(B1, 0, 1); PG8_SCHED; PG8_LDA(At, 0, 0);
            if constexpr (GATHER) { PG8_STAGE(PG8_SA(1, 1), a1, gA1); } else { PG8_STAGE(PG8_SA(1, 1), a1 + hstepA, voffA); }
            PG8_WAIT_V(8); PG8_WAIT_L(0); PG8_BAR; PG8_MMA(0, 0, At, B0); PG8_MMA(0, 1, At, B1); PG8_BAR; PG8_SCHED;
            PG8_LDA(At, 0, 1); PG8_STAGE(PG8_SB(0, 0), b2, voffB); PG8_STAGE(PG8_SB(0, 1), b2 + hstepB, voffB);
            if constexpr (GATHER) { PG8_STAGE(PG8_SA(0, 0), a2, pA0); } else { PG8_STAGE(PG8_SA(0, 0), a2, voffA); }
            PG8_WAIT_V(8); PG8_WAIT_L(0); PG8_BAR; PG8_MMA(1, 0, At, B0); PG8_MMA(1, 1, At, B1); PG8_BAR; PG8_SCHED;
            PG8_LDB(B0, 1, 0); PG8_LDB(B1, 1, 1); PG8_SCHED; PG8_LDA(At, 1, 0);
            if constexpr (GATHER) { PG8_STAGE(PG8_SA(0, 1), a2, pA1); } else { PG8_STAGE(PG8_SA(0, 1), a2 + hstepA, voffA); }
            PG8_WAIT_V(8); PG8_WAIT_L(0); PG8_BAR; PG8_MMA(0, 0, At, B0); PG8_MMA(0, 1, At, B1); PG8_BAR; PG8_SCHED;
            PG8_LDA(At, 1, 1); PG8_STAGE(PG8_SB(1, 0), b3, voffB); PG8_STAGE(PG8_SB(1, 1), b3 + hstepB, voffB);
            if constexpr (GATHER) { PG8_STAGE(PG8_SA(1, 0), a3, pA0); } else { PG8_STAGE(PG8_SA(1, 0), a3, voffA); }
            PG8_WAIT_V(8); PG8_WAIT_L(0); PG8_BAR; PG8_MMA(1, 0, At, B0); PG8_MMA(1, 1, At, B1); PG8_BAR; PG8_SCHED;
            if constexpr (GATHER) { if (last) {
#pragma unroll
                for (int i = 0; i < 2; ++i) { voffA[i] = pA0[i]; gA1[i] = pA1[i]; } } }
        }
        if (wr == 0) PG8_BAR;
        bool keep = false;
        if constexpr (Epi::CHAIN) { keep = E.chain(acc, cur, wr, wc, fr, fq); }
        if (!keep) E(acc, cur, wr, wc, fr, fq);
        if (!has_next) break;
        if (!keep) {
#pragma unroll
        for (int a = 0; a < 2; ++a)
#pragma unroll
            for (int b = 0; b < 2; ++b)
#pragma unroll
                for (int m = 0; m < 4; ++m)
#pragma unroll
                    for (int n = 0; n < 2; ++n) acc[a][b][m][n] = (f32x4){0.f, 0.f, 0.f, 0.f}; }
        cur = nxt; cA = nA; cB = nB; ++ui;
        if (wr == 1) PG8_BAR;
    }
    PG8_WAIT_V(0);
    PG8_BAR;
#undef PG8_SA
#undef PG8_SB
#undef PG8_STAGE
#undef PG8_LDA
#undef PG8_LDB
#undef PG8_MMA
#undef PG8_WAIT_V
#undef PG8_WAIT_L
#undef PG8_BAR
#undef PG8_SCHED
#undef PG8_GOFFS
#undef PG8_A1
}
}

using pg8::GUnit;
#define EPI_LOOP for (int ai = 0; ai < 2; ++ai) _Pragma("unroll") for (int m = 0; m < 4; ++m) _Pragma("unroll") for (int bj = 0; bj < 2; ++bj)
#define EPI_ARGS const f32x4 (&acc)[2][2][4][2], const GUnit& u, int wr, int wc, int fr, int fq

struct EpiInproj {
    static constexpr bool CHAIN = false;
    bf16* cols; float* side;
    __device__ __forceinline__ void operator()(EPI_ARGS) const {
        const int row0 = u.pm * 256 + wr * 64 + fr, cw = wc * 32 + 8 * fq;
        if (u.pn < 37) {
            const bool sg = u.pn >= 25;
#pragma unroll
            EPI_LOOP { f32x4 v0 = acc[ai][bj][m][0], v1 = acc[ai][bj][m][1];
                if (sg) {
#pragma unroll
                    for (int j = 0; j < 4; ++j) { v0[j] = sigmoidf_(v0[j]); v1[j] = sigmoidf_(v1[j]); } }
                u32x4 w; w.x = pk2(v0[0], v0[1]); w.y = pk2(v0[2], v0[3]); w.z = pk2(v1[0], v1[1]); w.w = pk2(v1[2], v1[3]);
                *(u32x4*)(cols + (size_t)(row0 + ai * 128 + m * 16) * NCB + u.pn * 256 + bj * 128 + cw) = w; }
        } else {
#pragma unroll
            EPI_LOOP { float* p = side + (size_t)(row0 + ai * 128 + m * 16) * 256 + bj * 128 + cw;
                *(f32x4*)p = acc[ai][bj][m][0]; *(f32x4*)(p + 4) = acc[ai][bj][m][1]; }
        }
    }
};
struct EpiLora {
    static constexpr bool CHAIN = false;
    float* rlogw; bf16* rkdir; bf16* rkka; bf16* rg; const bf16* rkv; const bf16* rkk; const float* w0; const float* a0; const float* k_a;
    __device__ __forceinline__ void operator()(EPI_ARGS) const {
        const int row0 = u.pm * 256 + wr * 64 + fr, cw = wc * 32 + 8 * fq;
        if (u.pn < 4) {
            f32x4 wb[2][2];
#pragma unroll
            for (int bj = 0; bj < 2; ++bj) { wb[bj][0] = *(const f32x4*)(w0 + u.pn * 256 + bj * 128 + cw); wb[bj][1] = *(const f32x4*)(w0 + u.pn * 256 + bj * 128 + cw + 4); }
#pragma unroll
            EPI_LOOP { const int col = u.pn * 256 + bj * 128 + cw; const size_t row = (size_t)(row0 + ai * 128 + m * 16);
                f32x4 v0 = acc[ai][bj][m][0] + wb[bj][0], v1 = acc[ai][bj][m][1] + wb[bj][1];
#pragma unroll
                for (int j = 0; j < 4; ++j) { v0[j] = -__expf(-softplusf_(-v0[j]) - 0.5f); v1[j] = -__expf(-softplusf_(-v1[j]) - 0.5f); }
                *(f32x4*)(rlogw + row * 1024 + col) = v0; *(f32x4*)(rlogw + row * 1024 + col + 4) = v1; }
        } else if (u.pn < 8) {
            f32x4 pb0[2], pb1[2], pk0[2], pk1[2];
#pragma unroll
            for (int bj = 0; bj < 2; ++bj) { const int col = (u.pn - 4) * 256 + bj * 128 + cw, ch = col & 511;
                pb0[bj] = *(const f32x4*)(a0 + col); pb1[bj] = *(const f32x4*)(a0 + col + 4); pk0[bj] = *(const f32x4*)(k_a + ch); pk1[bj] = *(const f32x4*)(k_a + ch + 4); }
#pragma unroll
            EPI_LOOP { const int col = (u.pn - 4) * 256 + bj * 128 + cw, ch = col & 511; const size_t row = (size_t)(row0 + ai * 128 + m * 16);
                const f32x4 b0 = pb0[bj], b1 = pb1[bj], ka0 = pk0[bj], ka1 = pk1[bj];
                float a[8], kv[8], kkv[8], kd[8], ka[8];
#pragma unroll
                for (int j = 0; j < 4; ++j) { a[j] = sigmoidf_(acc[ai][bj][m][0][j] + b0[j]); a[4 + j] = sigmoidf_(acc[ai][bj][m][1][j] + b1[j]); }
                unpack8(*(const u32x4*)(rkv + row * 1536 + 512 + ch), kv); unpack8(*(const u32x4*)(rkk + row * 512 + ch), kkv);
#pragma unroll
                for (int j = 0; j < 8; ++j) { const float kaj = j < 4 ? ka0[j] : ka1[j - 4]; kd[j] = kv[j] * (1.f + (a[j] - 1.f) * kaj); ka[j] = kkv[j] * a[j]; }
                *(u32x4*)(rkdir + row * 1024 + col) = pack8(kd); *(u32x4*)(rkka + row * 1024 + col) = pack8(ka); }
        } else {
#pragma unroll
            EPI_LOOP { const int col = (u.pn - 8) * 256 + bj * 128 + cw; const size_t row = (size_t)(row0 + ai * 128 + m * 16);
                const f32x4 v0 = acc[ai][bj][m][0], v1 = acc[ai][bj][m][1]; u32x4 w; w.x = pk2(v0[0], v0[1]); w.y = pk2(v0[2], v0[3]); w.z = pk2(v1[0], v1[1]); w.w = pk2(v1[2], v1[3]);
                *(u32x4*)(rg + row * 512 + col) = w; }
        }
    }
};
struct EpiBranch {
    static constexpr bool CHAIN = true;
    const bf16* cols; bf16* merged;
    __device__ __forceinline__ bool chain(f32x4 (&acc)[2][2][4][2], const GUnit& u, int wr, int wc, int fr, int fq) const {
        const int br = u.aux; if (br >= 2) return false;
        const int row0 = u.pm * 256 + wr * 64 + fr, cw = wc * 32 + 8 * fq;
#pragma unroll
        EPI_LOOP { const int col = u.pn * 256 + bj * 128 + cw; const size_t row = (size_t)(row0 + ai * 128 + m * 16);
            float g[8], gn[8]; unpack8(*(const u32x4*)(cols + row * NCB + C_GATE + br * 1024 + col), g); unpack8(*(const u32x4*)(cols + row * NCB + C_GATE + (br + 1) * 1024 + col), gn);
#pragma unroll
            for (int j = 0; j < 4; ++j) { acc[ai][bj][m][0][j] *= g[j] * __builtin_amdgcn_rcpf(fmaxf(gn[j], 1e-20f)); acc[ai][bj][m][1][j] *= g[4 + j] * __builtin_amdgcn_rcpf(fmaxf(gn[4 + j], 1e-20f)); } }
        return true;
    }
    __device__ __forceinline__ void operator()(EPI_ARGS) const {
        const int row0 = u.pm * 256 + wr * 64 + fr, cw = wc * 32 + 8 * fq;
#pragma unroll
        EPI_LOOP { const int col = u.pn * 256 + bj * 128 + cw; const size_t row = (size_t)(row0 + ai * 128 + m * 16);
            float g[8]; unpack8(*(const u32x4*)(cols + row * NCB + C_GATE + 2 * 1024 + col), g);
            const f32x4 v0 = acc[ai][bj][m][0], v1 = acc[ai][bj][m][1];
            u32x4 w; w.x = pk2(v0[0] * fmaxf(g[0], 1e-20f), v0[1] * fmaxf(g[1], 1e-20f)); w.y = pk2(v0[2] * fmaxf(g[2], 1e-20f), v0[3] * fmaxf(g[3], 1e-20f));
            w.z = pk2(v1[0] * fmaxf(g[4], 1e-20f), v1[1] * fmaxf(g[5], 1e-20f)); w.w = pk2(v1[2] * fmaxf(g[6], 1e-20f), v1[3] * fmaxf(g[7], 1e-20f)); *(u32x4*)(merged + row * 1024 + col) = w; }
    }
};
struct EpiWo {
    static constexpr bool CHAIN = false;
    const float* xf; float* pre;
    __device__ __forceinline__ void operator()(EPI_ARGS) const {
        const int row0 = u.pm * 256 + wr * 64 + fr, cw = wc * 32 + 8 * fq;
        f32x4 nx[2][2];
#define EW_LD(ai_, m_) do { _Pragma("unroll") for (int bj = 0; bj < 2; ++bj) { const size_t o_ = (size_t)(row0 + (ai_) * 128 + (m_) * 16) * 1024 + u.pn * 256 + bj * 128 + cw; \
            nx[bj][0] = *(const f32x4*)(xf + o_); nx[bj][1] = *(const f32x4*)(xf + o_ + 4); } } while (0)
        EW_LD(0, 0);
#pragma unroll
        for (int ai = 0; ai < 2; ++ai)
#pragma unroll
        for (int m = 0; m < 4; ++m) { const f32x4 c00 = nx[0][0], c01 = nx[0][1], c10 = nx[1][0], c11 = nx[1][1];
            if (!(ai == 1 && m == 3)) { if (m < 3) EW_LD(ai, m + 1); else EW_LD(ai + 1, 0); }
#pragma unroll
            for (int bj = 0; bj < 2; ++bj) { const size_t o = (size_t)(row0 + ai * 128 + m * 16) * 1024 + u.pn * 256 + bj * 128 + cw;
                *(f32x4*)(pre + o) = (bj ? c10 : c00) * DN_ALPHA + acc[ai][bj][m][0]; *(f32x4*)(pre + o + 4) = (bj ? c11 : c01) * DN_ALPHA + acc[ai][bj][m][1]; } }
#undef EW_LD
    }
};
struct EpiPlg {
    static constexpr bool CHAIN = false;
    bf16* sg;
    __device__ __forceinline__ void operator()(EPI_ARGS) const {
        const int row0 = u.pm * 256 + wr * 64 + fr, cw = wc * 32 + 8 * fq;
#pragma unroll
        EPI_LOOP { const size_t o = (size_t)(row0 + ai * 128 + m * 16) * 1024 + u.pn * 256 + bj * 128 + cw; const f32x4 v0 = acc[ai][bj][m][0], v1 = acc[ai][bj][m][1];
            u32x4 w; w.x = pk2(sigmoidf_(v0[0]), sigmoidf_(v0[1])); w.y = pk2(sigmoidf_(v0[2]), sigmoidf_(v0[3])); w.z = pk2(sigmoidf_(v1[0]), sigmoidf_(v1[1])); w.w = pk2(sigmoidf_(v1[2]), sigmoidf_(v1[3]));
            *(u32x4*)(sg + o) = w; }
    }
};
struct EpiGu {
    static constexpr bool CHAIN = false;
    bf16* act; const float* b_gu;
    __device__ __forceinline__ void operator()(EPI_ARGS) const {
        const int row0 = u.pm * 256 + wr * 64 + fr, cw = wc * 32 + 8 * fq, c0 = u.pn * 128 + cw; const float* bg = b_gu + (size_t)u.aux * 2048;
        const f32x4 bg0 = *(const f32x4*)(bg + c0), bg1 = *(const f32x4*)(bg + c0 + 4), bu0 = *(const f32x4*)(bg + 1024 + c0), bu1 = *(const f32x4*)(bg + 1024 + c0 + 4);
#pragma unroll
        for (int ai = 0; ai < 2; ++ai)
#pragma unroll
            for (int m = 0; m < 4; ++m) { float o[8];
#pragma unroll
                for (int j = 0; j < 8; ++j) { float gl = (j < 4 ? acc[ai][0][m][0][j] + bg0[j] : acc[ai][0][m][1][j - 4] + bg1[j - 4]), up = (j < 4 ? acc[ai][1][m][0][j] + bu0[j] : acc[ai][1][m][1][j - 4] + bu1[j - 4]);
                    gl = fminf(gl, 7.0f); up = fminf(fmaxf(up, -7.0f), 7.0f); o[j] = (up + 1.0f) * gl * sigmoidf_(1.702f * gl); }
                *(u32x4*)(act + (size_t)(row0 + ai * 128 + m * 16) * 1024 + c0) = pack8(o); }
    }
};
enum { K_DN = 0, K_PLE = 1, K_PLG = 2 };
struct EpiGuPlg {
    static constexpr bool CHAIN = false;
    EpiGu gu; EpiPlg plg;
    __device__ __forceinline__ void operator()(EPI_ARGS) const { if (u.kind == K_PLG) plg(acc, u, wr, wc, fr, fq); else gu(acc, u, wr, wc, fr, fq); }
};
struct EpiDnPle {
    static constexpr bool CHAIN = false;
    bf16* ye; const float* b_dn; bf16* pleb; const bf16* sg; bf16* sgw;
    __device__ __forceinline__ void operator()(EPI_ARGS) const {
        const int row0 = u.pm * 256 + wr * 64 + fr, cw = wc * 32 + 8 * fq;
        if (u.kind == K_DN) { const float* bd = b_dn + (size_t)u.aux * 1024;
            f32x4 bb[2][2];
#pragma unroll
            for (int bj = 0; bj < 2; ++bj) { bb[bj][0] = *(const f32x4*)(bd + u.pn * 256 + bj * 128 + cw); bb[bj][1] = *(const f32x4*)(bd + u.pn * 256 + bj * 128 + cw + 4); }
#pragma unroll
            EPI_LOOP { const int col = u.pn * 256 + bj * 128 + cw; const f32x4 v0 = acc[ai][bj][m][0] + bb[bj][0], v1 = acc[ai][bj][m][1] + bb[bj][1];
                u32x4 w; w.x = pk2(v0[0], v0[1]); w.y = pk2(v0[2], v0[3]); w.z = pk2(v1[0], v1[1]); w.w = pk2(v1[2], v1[3]);
                *(u32x4*)(ye + (size_t)(row0 + ai * 128 + m * 16) * 1024 + col) = w; }
        } else if (u.kind == K_PLG) { EpiPlg{sgw}(acc, u, wr, wc, fr, fq);
        } else {
            u32x4 ng[2];
#define EP_LD(ai_, m_) do { _Pragma("unroll") for (int bj = 0; bj < 2; ++bj) ng[bj] = *(const u32x4*)(sg + (size_t)(row0 + (ai_) * 128 + (m_) * 16) * 1024 + u.pn * 256 + bj * 128 + cw); } while (0)
            EP_LD(0, 0);
#pragma unroll
            for (int ai = 0; ai < 2; ++ai)
#pragma unroll
            for (int m = 0; m < 4; ++m) { const u32x4 cg0 = ng[0], cg1 = ng[1];
                if (!(ai == 1 && m == 3)) { if (m < 3) EP_LD(ai, m + 1); else EP_LD(ai + 1, 0); }
#pragma unroll
              for (int bj = 0; bj < 2; ++bj) { const size_t o = (size_t)(row0 + ai * 128 + m * 16) * 1024 + u.pn * 256 + bj * 128 + cw; float s[8]; unpack8(bj ? cg1 : cg0, s);
                const f32x4 v0 = acc[ai][bj][m][0], v1 = acc[ai][bj][m][1];
                u32x4 w; w.x = pk2(v0[0] * s[0], v0[1] * s[1]); w.y = pk2(v0[2] * s[2], v0[3] * s[3]); w.z = pk2(v1[0] * s[4], v1[1] * s[5]); w.w = pk2(v1[2] * s[6], v1[3] * s[7]);
                *(u32x4*)(pleb + o) = w; } }
#undef EP_LD
        }
    }
};

struct SchedPlain {
    const char* A; const char* B; int lda, ldb, nt, nM, nN, G, c;
    __device__ __forceinline__ bool next(int i, GUnit& u) const {
        const int L = i * G + c; if (L >= nM * nN) return false;
        pg8::tile_order(L, nM, nN, u.pm, u.pn);
        u.A = A + (size_t)u.pm * 256 * lda; u.B = B + (size_t)u.pn * 256 * ldb; u.nt = nt; u.arow0 = 0; u.kind = 0; u.aux = 0; return true;
    }
};
struct SchedBranch {
    const char* ymix; const char* wbr; int G, c;
    __device__ __forceinline__ bool next(int i, GUnit& u) const {
        const int tile = (i / 3) * G + c, br = i % 3; if (tile >= 256) return false;
        pg8::tile_order(tile, 64, 4, u.pm, u.pn);
        const int k0 = br == 0 ? 0 : (br == 1 ? 512 : 1024);
        u.A = ymix + (size_t)u.pm * 256 * 4096 + k0 * 2; u.B = wbr + (size_t)u.pn * 256 * 4096 + k0 * 2; u.nt = br == 2 ? 16 : 8; u.arow0 = 0; u.kind = 0; u.aux = br; return true;
    }
};
struct MoeTab { const LAS int* pstart; const LAS int* panel_e; int npanels; };
struct SchedGu {
    const char* x1b; const char* wgu; const char* wplg; MoeTab T; int G, c;
    static __device__ __forceinline__ int plg_in_gu(int npanels, int G) { const int r = (npanels * 8) % G; const int x = r ? G - r : 0; return x < 256 ? x : 256; }
    __device__ __forceinline__ bool next(int i, GUnit& u) const {
        const int L = i * G + c, n1 = T.npanels * 8;
        if (L >= n1) { const int x = L - n1; if (x >= plg_in_gu(T.npanels, G)) return false;
            pg8::tile_order(x, 64, 4, u.pm, u.pn);
            u.A = x1b; u.B = wplg + (size_t)u.pn * 256 * 2048; u.nt = 16; u.arow0 = MPAD + u.pm * 256; u.kind = K_PLG; u.aux = 0; return true; }
        pg8::tile_order(L, T.npanels, 8, u.pm, u.pn);
        const int e = T.panel_e[u.pm];
        u.A = x1b; u.B = wgu + (size_t)e * W_GU_SZ + (size_t)u.pn * 256 * 2048; u.nt = 16; u.arow0 = u.pm * 256; u.kind = 0; u.aux = e; return true;
    }
};
struct SchedDnPle {
    const char* act; const char* wdn; const char* pb; const char* wpl; const char* x1b; const char* wplg; MoeTab T; int G, c;
    __device__ __forceinline__ bool next(int i, GUnit& u) const {
        const int L = i * G + c, n1 = T.npanels * 4;
        if (L < n1) { pg8::tile_order(L, T.npanels, 4, u.pm, u.pn); const int e = T.panel_e[u.pm];
            u.A = act + (size_t)u.pm * 256 * 2048; u.B = wdn + (size_t)e * W_SQ_SZ + (size_t)u.pn * 256 * 2048; u.nt = 16; u.arow0 = 0; u.kind = K_DN; u.aux = e; return true; }
        const int nmine = c < n1 ? (n1 - c + G - 1) / G : 0, j = i - nmine, r = n1 % G, rho = (c - r + G) % G, XG = SchedGu::plg_in_gu(T.npanels, G), NP = 256 - XG;
        int x; bool plg;
        if (rho < NP) { if (j > 1) return false; x = XG + rho; plg = (j == 0); } else { if (j > 0) return false; x = rho - NP; plg = false; }
        pg8::tile_order(x, 64, 4, u.pm, u.pn);
        if (plg) { u.A = x1b + (size_t)u.pm * 256 * 2048; u.B = wplg + (size_t)u.pn * 256 * 2048; u.nt = 16; u.arow0 = 0; u.kind = K_PLG; u.aux = 0; return true; }
        u.A = pb + (size_t)u.pm * 256 * 2048; u.B = wpl + (size_t)u.pn * 256 * 2048; u.nt = 4; u.arow0 = 0; u.kind = K_PLE; u.aux = 0; return true;
    }
};

struct TrDesc { const float* W; bf16* WT; int Nsrc, k0, srccol, dstK, n0, dk0; };
__device__ __forceinline__ void tr_load(const TrDesc& d, f32x4 (&v)[16], int lane) {
    const int kr = lane >> 4; const float* p = d.W + (size_t)(d.k0 + kr) * d.Nsrc + (d.srccol >= 0 ? d.srccol : 0);
#pragma unroll
    for (int t = 0; t < 16; ++t) v[t] = d.srccol >= 0 ? __builtin_nontemporal_load((const f32x4*)(p + (size_t)(4 * t) * d.Nsrc)) : (f32x4){0.f, 0.f, 0.f, 0.f};
}
__device__ __forceinline__ void tr_proc(const TrDesc& d, const f32x4 (&v)[16], LAS float* scr, int lane) {
    const int q = lane & 15, kr = lane >> 4;
#pragma unroll
    for (int t = 0; t < 16; ++t) { const int kk = 4 * t + kr; *(LAS f32x4*)(scr + kk * 64 + ((q ^ ((kk >> 3) & 7)) << 2)) = v[t]; }
    LDS_WAIT(); asm volatile("" ::: "memory");
    const int c = lane & 7;
#pragma unroll
    for (int jj = 0; jj < 8; ++jj) { const int n = (lane >> 3) + 8 * jj; const LAS float* sp = scr + (8 * c) * 64 + ((((n >> 2) ^ c) & 15) << 2) + (n & 3);
        u32x4 o; o.x = pk2(sp[0], sp[64]); o.y = pk2(sp[2 * 64], sp[3 * 64]); o.z = pk2(sp[4 * 64], sp[5 * 64]); o.w = pk2(sp[6 * 64], sp[7 * 64]);
        __builtin_nontemporal_store(o, (u32x4*)(d.WT + (size_t)(d.n0 + n) * d.dstK + d.dk0 + 8 * c)); }
    LDS_WAIT(); asm volatile("" ::: "memory");
}
template <class DescFn> __device__ __forceinline__ void tr_run(int n, int first, int stride, const DescFn& fn, LAS float* scr, int lane) {
    int it = first; if (it >= n) return;
    TrDesc dA = fn(it), dB = dA; f32x4 vA[16], vB[16]; tr_load(dA, vA, lane);
    for (;;) {
        const int it2 = it + stride; const bool has2 = it2 < n; if (has2) { dB = fn(it2); tr_load(dB, vB, lane); }
        tr_proc(dA, vA, scr, lane); if (!has2) break;
        const int it3 = it2 + stride; const bool has3 = it3 < n; if (has3) { dA = fn(it3); tr_load(dA, vA, lane); }
        tr_proc(dB, vB, scr, lane); if (!has3) break;
        it = it3;
    }
}
__device__ __forceinline__ int win_src(int n) {
    if (n < 2048) return n;
    if (n < 3584) return n - 2048 + 2064;
    if (n < 3712) return n - 3584 + 3728;
    if (n < 3840) return n - 3712 + 3856;
    if (n < 4864) return n - 3840 + 3984;
    if (n < 6400) return n - 4864 + 5008;
    if (n < 9472) return n - 6400 + 6576;
    if (n < 9488) return n - 9472 + 2048;
    if (n < 9520) return n - 9488 + 6544;
    if (n < 9648) return n - 9520 + 3600;
    return -1;
}
__device__ __forceinline__ void ln_row(f32x4 (&v)[4], const f32x4 (&gg)[4], const f32x4 (&bb)[4], float* of, bf16* ob, int lane) {
    float s = 0.f;
#pragma unroll
    for (int j = 0; j < 4; ++j) s += (v[j].x + v[j].y) + (v[j].z + v[j].w);
    const float mean = wave_sum(s) * (1.f / DM); float s2 = 0.f;
#pragma unroll
    for (int j = 0; j < 4; ++j) { v[j] = v[j] - mean; s2 += (v[j].x * v[j].x + v[j].y * v[j].y) + (v[j].z * v[j].z + v[j].w * v[j].w); }
    const float rstd = 1.f / sqrtf(wave_sum(s2) * (1.f / DM) + LN_EPS);
#pragma unroll
    for (int j = 0; j < 4; ++j) { const f32x4 o = v[j] * rstd * gg[j] + bb[j];
        *(f32x4*)(of + 256 * j + 4 * lane) = o; u32x2 w; w.x = pk2(o.x, o.y); w.y = pk2(o.z, o.w); *(u32x2*)(ob + 256 * j + 4 * lane) = w; }
}
__device__ __forceinline__ void phase_prologue(Frame& F, const Params& P) {
    LAS float* scr = (LAS float*)(F.lds + F.wave * 16384);
    const int gw = F.vcu * NWAVES + F.wave, NGW = F.G * NWAVES; int lane = F.lane; asm volatile("" : "+v"(lane)); const int q4 = 4 * (lane & 15);
    int rot = 0;
#define ITEMS(n, ...) do { const int _n = (n); tr_run(_n, (gw + NGW - rot) % NGW, NGW, [&](int it) -> TrDesc { __VA_ARGS__ }, scr, lane); rot = (rot + _n) % NGW; } while (0)
    for (int l = 0; l < DEPTH; ++l) {
        { const float* W = P.in[I_W_IN] + (size_t)l * 1024 * 9648; bf16* D = (bf16*)(P.ws + WS_W_IN + l * W_IN_SZ);
          ITEMS(16 * 152, const int kb = it / 152, nb = it % 152; return TrDesc{W, D, 9648, kb * 64, win_src(nb * 64 + q4), 1024, nb * 64, kb * 64};); }
        { const float* W = P.in[I_W_BR] + (size_t)l * 2048 * 1024; bf16* D = (bf16*)(P.ws + WS_W_BR + l * W_BR_SZ);
          ITEMS(32 * 16, const int kb = it / 16, nb = it % 16; return TrDesc{W, D, 1024, kb * 64, nb * 64 + q4, 2048, nb * 64, kb * 64};); }
        { const float* W = P.in[I_W_O] + (size_t)l * 1024 * 1024; bf16* D = (bf16*)(P.ws + WS_W_O + l * W_SQ_SZ);
          ITEMS(16 * 16, const int kb = it / 16, nb = it % 16; return TrDesc{W, D, 1024, kb * 64, nb * 64 + q4, 1024, nb * 64, kb * 64};); }
        { const float* W = P.in[I_W_PLG] + (size_t)l * 1024 * 1024; bf16* D = (bf16*)(P.ws + WS_W_PLG + l * W_SQ_SZ);
          ITEMS(16 * 16, const int kb = it / 16, nb = it % 16; return TrDesc{W, D, 1024, kb * 64, nb * 64 + q4, 1024, nb * 64, kb * 64};); }
        { const float* W = P.in[I_W_PL] + (size_t)l * 256 * 1024; bf16* D = (bf16*)(P.ws + WS_W_PL + l * W_PL_SZ);
          ITEMS(4 * 16, const int kb = it / 16, nb = it % 16; return TrDesc{W, D, 1024, kb * 64, nb * 64 + q4, 1024, nb * 64, kb * 64};); }
        { bf16* D = (bf16*)(P.ws + WS_W_LORA + l * W_LORA_SZ); const float* wup = P.in[I_R_WUP]; const float* aup = P.in[I_R_AUP]; const float* gup = P.in[I_R_GUP];
          ITEMS(6 * 40, const int kb = it / 40, nb = it % 40; const int rb = nb / 8;
              const float* W = nullptr; int kl = 0;
              if (rb < 4) { if (kb == rb) { W = (rb < 2 ? wup : aup) + ((size_t)l * 2 + (rb & 1)) * 64 * 512; kl = 0; } }
              else if (kb >= 4) { W = gup + (size_t)l * 128 * 512; kl = (kb - 4) * 64; }
              return TrDesc{W ? W : gup, D, 512, kl, W ? (nb % 8) * 64 + q4 : -1, 384, nb * 64, kb * 64};); }
        { const float* W = P.in[I_W_GU] + (size_t)l * 32 * 1024 * 2048; bf16* D = (bf16*)(P.ws + WS_W_GU + (size_t)l * 32 * W_GU_SZ);
          ITEMS(32 * 16 * 32, const int e = it / 512, r = it % 512, kb = r / 32, nb = r % 32; const int n0 = nb * 64, pn = n0 >> 8, bj = (n0 >> 7) & 1, j0 = n0 & 127;
              return TrDesc{W + (size_t)e * 1024 * 2048, D + (size_t)e * 2048 * 1024, 2048, kb * 64, bj * 1024 + pn * 128 + j0 + q4, 1024, n0, kb * 64};); }
        { const float* W = P.in[I_W_DN] + (size_t)l * 32 * 1024 * 1024; bf16* D = (bf16*)(P.ws + WS_W_DN + (size_t)l * 32 * W_SQ_SZ);
          ITEMS(32 * 16 * 16, const int e = it / 256, r = it % 256, kb = r / 16, nb = r % 16;
              return TrDesc{W + (size_t)e * 1024 * 1024, D + (size_t)e * 1024 * 1024, 1024, kb * 64, nb * 64 + q4, 1024, nb * 64, kb * 64};); }
    }
#undef ITEMS
    { f32x4 gg[4], bb[4], vn[4];
#pragma unroll
      for (int j = 0; j < 4; ++j) { gg[j] = *(const f32x4*)(P.in[I_LNIN_G] + 256 * j + 4 * lane); bb[j] = *(const f32x4*)(P.in[I_LNIN_B] + 256 * j + 4 * lane); vn[j] = (f32x4){0.f, 0.f, 0.f, 0.f}; }
      if (gw < MTOK) {
#pragma unroll
          for (int j = 0; j < 4; ++j) vn[j] = *(const f32x4*)(P.in[I_X] + (size_t)gw * DM + 256 * j + 4 * lane); }
      for (int m = gw; m < MTOK; m += NGW) { f32x4 v[4];
#pragma unroll
          for (int j = 0; j < 4; ++j) v[j] = vn[j];
          if (m + NGW < MTOK) {
#pragma unroll
              for (int j = 0; j < 4; ++j) vn[j] = *(const f32x4*)(P.in[I_X] + (size_t)(m + NGW) * DM + 256 * j + 4 * lane); }
          ln_row(v, gg, bb, (float*)(P.ws + A_XF) + (size_t)m * DM, (bf16*)(P.ws + A_XB) + (size_t)m * DM, lane); } }
    for (int r0 = gw; r0 < DEPTH * MTOK; r0 += 4 * NGW) { f32x4 v[4];
#pragma unroll
        for (int k = 0; k < 4; ++k) v[k] = *(const f32x4*)(P.in[I_P] + (size_t)(r0 + k * NGW) * PLE + 4 * lane);
#pragma unroll
        for (int k = 0; k < 4; ++k) { u32x2 w; w.x = pk2(v[k].x, v[k].y); w.y = pk2(v[k].z, v[k].w); *(u32x2*)((bf16*)(P.ws + A_PB) + (size_t)(r0 + k * NGW) * 1024 + 4 * lane) = w; } }
}

__device__ __forceinline__ void phase_prep(Frame& F, const Params& P, int l) {
    const int gw = F.vcu * NWAVES + F.wave, NGW = F.G * NWAVES; int lane = F.lane; asm volatile("" : "+v"(lane));
    const bf16* cols = (const bf16*)(P.ws + A_COLS); const float* side = (const float*)(P.ws + A_SIDE);
    bf16* gqkv = (bf16*)(P.ws + A_GQKV); float* gsc = (float*)(P.ws + A_GSC); bf16* sxbc = (bf16*)(P.ws + A_SXBC); float* ssc = (float*)(P.ws + A_SSC);
    bf16* rkv = (bf16*)(P.ws + A_RKV); bf16* rkk = (bf16*)(P.ws + A_RKK); bf16* lin = (bf16*)(P.ws + A_LIN);
    const float* gconv = P.in[I_GDN_CONV] + (size_t)l * 5 * 1536; const float* sconv = P.in[I_S_CONV] + (size_t)l * 5 * 1536; const float* sconvb = P.in[I_S_CONVB] + (size_t)l * 1536;
    const float* mup = P.in[I_R_MUP] + (size_t)l * 1920; const float* mun = P.in[I_R_MUN] + (size_t)l * 1920; const float* k_k = P.in[I_R_KK] + (size_t)l * 512;
    for (int g8 = gw; g8 < MTOK / 8; g8 += NGW) {
        const int m0 = g8 * 8, t0 = m0 % SEQ; const bf16* crow = cols + (size_t)m0 * NCB;
        u32x4 xn[12];
#define PREP_LD(part_) do { const int p_ = (part_); const bf16* src_ = crow + (p_ < 3 ? C_GQKV + p_ * 512 : C_SXBC + (p_ - 3) * 512) + 8 * lane; \
            _Pragma("unroll") for (int rr = 0; rr < 12; ++rr) { const int tt = t0 - 2 + rr; xn[rr] = (tt >= 0 && tt < SEQ) ? *(const u32x4*)(src_ + (ptrdiff_t)(rr - 2) * NCB) : (u32x4){0u, 0u, 0u, 0u}; } } while (0)
        PREP_LD(0);
#pragma unroll 1
        for (int part = 0; part < 6; ++part) { const bool isg = part < 3; const int pp = isg ? part : part - 3, ch = pp * 512 + 8 * lane; const float* cw = (isg ? gconv : sconv) + ch;
            u32x4 xr[12];
#pragma unroll
            for (int rr = 0; rr < 12; ++rr) xr[rr] = xn[rr];
            if (part < 5) PREP_LD(part + 1);
            float w[5][8];
#pragma unroll
            for (int tap = 0; tap < 5; ++tap) { const f32x4 w0 = *(const f32x4*)(cw + tap * 1536), w1 = *(const f32x4*)(cw + tap * 1536 + 4);
#pragma unroll
                for (int j = 0; j < 4; ++j) { w[tap][j] = w0[j]; w[tap][4 + j] = w1[j]; } }
            float bias[8];
#pragma unroll
            for (int j = 0; j < 8; ++j) bias[j] = 0.f;
            if (!isg) { const f32x4 b0 = *(const f32x4*)(sconvb + ch), b1 = *(const f32x4*)(sconvb + ch + 4);
#pragma unroll
                for (int j = 0; j < 4; ++j) { bias[j] = b0[j]; bias[4 + j] = b1[j]; } }
#pragma unroll
            for (int tk = 0; tk < 8; ++tk) { float o[8];
#pragma unroll
                for (int j = 0; j < 8; ++j) o[j] = bias[j];
#pragma unroll
                for (int tap = 0; tap < 5; ++tap) { float x[8]; unpack8(xr[tk + tap], x);
#pragma unroll
                    for (int j = 0; j < 8; ++j) o[j] += x[j] * w[tap][j]; }
                float ss = 0.f;
#pragma unroll
                for (int j = 0; j < 8; ++j) { o[j] = siluf_(o[j]); ss += o[j] * o[j]; }
                if (isg && pp < 2) { ss += __shfl_xor(ss, 1); ss += __shfl_xor(ss, 2); ss += __shfl_xor(ss, 4); ss += __shfl_xor(ss, 8);
                    const float sc = rsqrtf(ss + 1e-6f) * (pp == 0 ? 0.08838834764831845f : 1.0f);
#pragma unroll
                    for (int j = 0; j < 8; ++j) o[j] *= sc; }
                *(u32x4*)((isg ? gqkv : sxbc) + (size_t)(m0 + tk) * 1536 + ch) = pack8(o); } }
#undef PREP_LD
        { const int tk = lane >> 3, i8 = lane & 7; const size_t m = (size_t)m0 + tk;
          { const float r0 = side[m * 256 + i8], r1 = side[m * 256 + 8 + i8];
            gsc[m * 16 + i8] = sigmoidf_(r0); gsc[m * 16 + 8 + i8] = -__expf(P.in[I_GDN_ALOG][l * 8 + i8]) * softplusf_(r1 + P.in[I_GDN_DTB][l * 8 + i8]); }
#pragma unroll
          for (int q = 0; q < 4; ++q) { const int i = i8 + 8 * q; const float dt = softplusf_(side[m * 256 + 16 + i] + P.in[I_S_DTB][l * 32 + i]);
              ssc[m * 64 + i] = dt; ssc[m * 64 + 32 + i] = -__expf(P.in[I_S_ALOG][l * 32 + i]) * dt; } }
        f32x2 lw[10]; unsigned la[10], lg[10];
#pragma unroll
        for (int rr = 0; rr < 10; ++rr) { const int tt = t0 - 1 + rr; const bool ok = tt >= 0 && tt < SEQ; const ptrdiff_t mr = (ptrdiff_t)m0 - 1 + rr;
            lw[rr] = ok ? *(const f32x2*)(side + mr * 256 + 48 + 2 * lane) : (f32x2){0.f, 0.f};
            la[rr] = ok ? *(const unsigned*)(cols + mr * NCB + C_RAL + 2 * lane) : 0u; lg[rr] = ok ? *(const unsigned*)(cols + mr * NCB + C_RAL + 128 + 2 * lane) : 0u; }
        u32x4 yn[10];
#define PREP_LR(part_) do { const bf16* src_ = crow + C_RRKV + (part_) * 512 + 8 * lane; \
            _Pragma("unroll") for (int rr = 0; rr < 10; ++rr) { const int tt = t0 - 1 + rr; yn[rr] = (tt >= 0 && tt < SEQ) ? *(const u32x4*)(src_ + (ptrdiff_t)(rr - 1) * NCB) : (u32x4){0u, 0u, 0u, 0u}; } } while (0)
        PREP_LR(0);
#pragma unroll 1
        for (int part = 0; part < 3; ++part) { const int ch = part * 512 + 8 * lane;
            u32x4 xr[10];
#pragma unroll
            for (int rr = 0; rr < 10; ++rr) xr[rr] = yn[rr];
            if (part < 2) PREP_LR(part + 1);
            const f32x4 mp0 = *(const f32x4*)(mup + ch), mp1 = *(const f32x4*)(mup + ch + 4), mn0 = *(const f32x4*)(mun + ch), mn1 = *(const f32x4*)(mun + ch + 4);
            const f32x4 kk0 = *(const f32x4*)(k_k + 8 * lane), kk1 = *(const f32x4*)(k_k + 8 * lane + 4);
#pragma unroll
            for (int tk = 0; tk < 8; ++tk) { float c[8], p[8], n[8], o[8]; unpack8(xr[tk], p); unpack8(xr[tk + 1], c); unpack8(xr[tk + 2], n);
#pragma unroll
                for (int j = 0; j < 8; ++j) o[j] = c[j] + (j < 4 ? mp0[j] : mp1[j - 4]) * (p[j] - c[j]) + (j < 4 ? mn0[j] : mn1[j - 4]) * (n[j] - c[j]);
                *(u32x4*)(rkv + (size_t)(m0 + tk) * 1536 + ch) = pack8(o);
                if (part == 1) { float ss = 0.f;
#pragma unroll
                    for (int j = 0; j < 8; ++j) { o[j] *= (j < 4 ? kk0[j] : kk1[j - 4]); ss += o[j] * o[j]; }
                    ss += __shfl_xor(ss, 1); ss += __shfl_xor(ss, 2); ss += __shfl_xor(ss, 4);
                    const float sc = rsqrtf(ss + 1e-6f);
#pragma unroll
                    for (int j = 0; j < 8; ++j) o[j] *= sc;
                    *(u32x4*)(rkk + (size_t)(m0 + tk) * 512 + 8 * lane) = pack8(o); } } }
#undef PREP_LR
        { const f32x2 mp0 = *(const f32x2*)(mup + 1536 + 2 * lane), mn0 = *(const f32x2*)(mun + 1536 + 2 * lane), mp1 = *(const f32x2*)(mup + 1664 + 2 * lane), mn1 = *(const f32x2*)(mun + 1664 + 2 * lane),
                      mp2 = *(const f32x2*)(mup + 1792 + 2 * lane), mn2 = *(const f32x2*)(mun + 1792 + 2 * lane);
#pragma unroll
          for (int tk = 0; tk < 8; ++tk) { const size_t m = (size_t)m0 + tk;
              { const f32x2 c = lw[tk + 1], p = lw[tk], n = lw[tk + 2]; const float o0 = c.x + mp0.x * (p.x - c.x) + mn0.x * (n.x - c.x), o1 = c.y + mp0.y * (p.y - c.y) + mn0.y * (n.y - c.y);
                *(unsigned*)(lin + m * 384 + 2 * lane) = pk2(tanhf(o0), tanhf(o1)); }
              { const float c0 = bflo(la[tk + 1]), c1 = bfhi(la[tk + 1]), p0 = bflo(la[tk]), p1 = bfhi(la[tk]), n0 = bflo(la[tk + 2]), n1 = bfhi(la[tk + 2]);
                *(unsigned*)(lin + m * 384 + 128 + 2 * lane) = pk2(c0 + mp1.x * (p0 - c0) + mn1.x * (n0 - c0), c1 + mp1.y * (p1 - c1) + mn1.y * (n1 - c1)); }
              { const float c0 = bflo(lg[tk + 1]), c1 = bfhi(lg[tk + 1]), p0 = bflo(lg[tk]), p1 = bfhi(lg[tk]), n0 = bflo(lg[tk + 2]), n1 = bfhi(lg[tk + 2]);
                *(unsigned*)(lin + m * 384 + 256 + 2 * lane) = pk2(sigmoidf_(c0 + mp2.x * (p0 - c0) + mn2.x * (n0 - c0)), sigmoidf_(c1 + mp2.y * (p1 - c1) + mn2.y * (n1 - c1))); } } }
    }
}

__device__ __forceinline__ void ssd_scan_item(const Params& P, int item);
__device__ __forceinline__ void gdn_scan_unit(Frame& F, const Params& P, int unit, int lane);
__device__ __forceinline__ void rwkv_scan_unit(Frame& F, const Params& P, int unit, int lane);
__device__ __forceinline__ void ssd_out_unit(Frame& F, const Params& P, int l_, int u, int tid, int lane);
__device__ __forceinline__ void phase_scan_seq(Frame& F, const Params& P, int l_) {
    int lane = F.lane; asm volatile("" : "+v"(lane));
    const int xg = F.vcu >> 5, xi = F.vcu & 31;
    if (xi < 8) { const int chain = xg + 8 * (xi >> 2); gdn_scan_unit(F, P, chain * 4 + (xi & 3), lane); return; }
    if (xi < 12) { rwkv_scan_unit(F, P, xg + 8 * (xi - 8), lane); return; }
    { int tid2 = F.tid; asm volatile("" : "+v"(tid2)); for (int u = xg * 20 + (xi - 12); u < 256; u += 160) ssd_out_unit(F, P, l_, u, tid2, lane); }
}

typedef float f32x16 __attribute__((ext_vector_type(16)));
typedef short s16x4 __attribute__((ext_vector_type(4)));
#define MFMA32(X, Y, C) __builtin_amdgcn_mfma_f32_32x32x16_bf16((X), (Y), (C), 0, 0, 0)
__device__ __forceinline__ bf16x8 frag_g(const bf16* M, int ld, int row0, int k0, int lane) { return *(const bf16x8*)(M + (size_t)(row0 + (lane & 31)) * ld + k0 + 8 * (lane >> 5)); }
__device__ __forceinline__ bf16x8 frag_l(const LAS bf16* M, int ld, int row0, int k0, int lane) { return *(const LAS bf16x8*)(M + (row0 + (lane & 31)) * ld + k0 + 8 * (lane >> 5)); }
__device__ __forceinline__ bf16x8 frag_tr(const LAS bf16* T, int ld, int k0, int n0, int lane) {
    const int h = lane >> 5, blk = (lane >> 4) & 1, q = (lane & 15) >> 2, p = lane & 3;
    const LAS bf16* a = T + (k0 + 8 * h + q) * ld + n0 + 16 * blk + 4 * p;
    const s16x4 lo = __builtin_bit_cast(s16x4, __builtin_amdgcn_ds_read_tr16_b64_v4i16((LAS s16x4*)a)), hi = __builtin_bit_cast(s16x4, __builtin_amdgcn_ds_read_tr16_b64_v4i16((LAS s16x4*)(a + 4 * ld)));
    return (bf16x8){lo[0], lo[1], lo[2], lo[3], hi[0], hi[1], hi[2], hi[3]};
}
template <int KS, class FX, class FY> __device__ __forceinline__ f32x16 mma_ks(f32x16 acc, const FX& fx, const FY& fy) {
    bf16x8 xa[KS], ya[KS];
#pragma unroll
    for (int ks = 0; ks < KS; ++ks) { xa[ks] = fx(ks); ya[ks] = fy(ks); }
    __builtin_amdgcn_sched_barrier(0);
#pragma unroll
    for (int ks = 0; ks < KS; ++ks) acc = MFMA32(xa[ks], ya[ks], acc);
    return acc;
}
__device__ __forceinline__ float scan_incl(float v, int lane) {
#pragma unroll
    for (int o = 1; o < 64; o <<= 1) { const float t = __shfl_up(v, o); v += lane >= o ? t : 0.f; }
    return v;
}
__device__ __forceinline__ float scan_incl_rev(float v, int lane) {
#pragma unroll
    for (int o = 1; o < 64; o <<= 1) { const float t = __shfl_down(v, o); v += lane + o < 64 ? t : 0.f; }
    return v;
}
__device__ __forceinline__ f32x16 zero16() { f32x16 z; for (int i = 0; i < 16; ++i) z[i] = 0.f; return z; }

__device__ __forceinline__ void st_frag2(bf16* f0, const f32x16& a, int lane);
constexpr int SSD_LDB = 136, SSD_LDX = 264;
__device__ __forceinline__ void ssd_states_unit(Frame& F, const Params& P, int u, int tid, int lane) {
    const int b = u >> 8, c = (u >> 2) & 63, g = (u >> 1) & 1, hh = u & 1, wave = F.wave; const size_t m0 = (size_t)b * SEQ + c * 128;
    const bf16* sx = (const bf16*)(P.ws + A_SXBC); const float* ssc = (const float*)(P.ws + A_SSC);
    LAS bf16* Bl = (LAS bf16*)(F.lds); LAS bf16* Xl = (LAS bf16*)(F.lds + 34816); LAS float* wS = (LAS float*)(F.lds + 102400) + wave * 128;
    __syncthreads();
    for (int i = tid; i < 2048; i += NTHR) { const int row = i >> 4, ch = i & 15; *(LAS u32x4*)(Bl + row * SSD_LDB + ch * 8) = *(const u32x4*)(sx + (m0 + row) * 1536 + 1024 + g * 128 + ch * 8); }
    for (int i = tid; i < 4096; i += NTHR) { const int row = i >> 5, ch = i & 31; *(LAS u32x4*)(Xl + row * SSD_LDX + ch * 8) = *(const u32x4*)(sx + (m0 + row) * 1536 + g * 512 + hh * 256 + ch * 8); }
    const int hq = wave & 3, dir = wave >> 2, head = g * 8 + hh * 4 + hq;
    { const float a0 = ssc[(m0 + lane) * 64 + 32 + dir * 16 + head], a1 = ssc[(m0 + lane + 64) * 64 + 32 + dir * 16 + head];
      const float d0 = ssc[(m0 + lane) * 64 + dir * 16 + head], d1 = ssc[(m0 + lane + 64) * 64 + dir * 16 + head];
      float p0, p1, tot;
      if (dir == 0) { p0 = scan_incl(a0, lane); const float t0 = __shfl(p0, 63); p1 = scan_incl(a1, lane) + t0; tot = __shfl(p1, 63); }
      else { p1 = scan_incl_rev(a1, lane); const float t1 = __shfl(p1, 0); p0 = scan_incl_rev(a0, lane) + t1; tot = __shfl(p0, 0); }
      wS[lane] = d0 * __expf(tot - p0); wS[lane + 64] = d1 * __expf(tot - p1);
      if (lane == 0) ((float*)(P.ws + A_SDEC))[((b * 2 + dir) * 64 + (dir ? 63 - c : c)) * 16 + head] = __expf(tot); }
    __syncthreads();
    bf16* hs = (bf16*)(P.ws + A_HS) + ((size_t)(((b * 2 + dir) * 64 + (dir ? 63 - c : c)) * 16 + head)) * 8192;
#pragma unroll 1
    for (int pt = 0; pt < 2; ++pt) {
        bf16x8 Yf[8];
#pragma unroll
        for (int ks = 0; ks < 8; ++ks) { const bf16x8 raw = frag_tr(Xl, SSD_LDX, 16 * ks, hq * 64 + 32 * pt, lane);
            const f32x4 w0 = *(const LAS f32x4*)(wS + 16 * ks + 8 * (lane >> 5)), w1 = *(const LAS f32x4*)(wS + 16 * ks + 8 * (lane >> 5) + 4);
            float f[8];
#pragma unroll
            for (int j = 0; j < 8; ++j) f[j] = bf2f((unsigned short)raw[j]) * (j < 4 ? w0[j] : w1[j - 4]);
            const u32x4 pk = pack8(f); Yf[ks] = __builtin_bit_cast(bf16x8, pk); }
#pragma unroll 1
        for (int nt = 0; nt < 4; ++nt) { f32x16 acc = zero16();
            acc = mma_ks<8>(acc, [&](int ks) { return frag_tr(Bl, SSD_LDB, 16 * ks, 32 * nt, lane); }, [&](int ks) { return Yf[ks]; });
            st_frag2(hs + (pt * 8 + 2 * nt) * 512, acc, lane); }
    }
}
__device__ __forceinline__ void phase_ssd_states(Frame& F, const Params& P) {
    int lane = F.lane; asm volatile("" : "+v"(lane)); int tid = F.tid; asm volatile("" : "+v"(tid));
    for (int u = F.vcu; u < 512; u += F.G) ssd_states_unit(F, P, u, tid, lane);
}
__device__ __forceinline__ void ssd_scan_item(const Params& P, int item) {
    const int bdh = item >> 11, e4 = item & 2047, bd = bdh >> 4, h = bdh & 15;
    bf16* base = (bf16*)(P.ws + A_HS) + ((size_t)(bd * 64) * 16 + h) * 8192 + e4 * 4; const float* dec = (const float*)(P.ws + A_SDEC) + (bd * 64) * 16 + h;
    float run[4] = {0.f, 0.f, 0.f, 0.f};
#pragma unroll 1
    for (int c0 = 0; c0 < 64; c0 += 32) { u32x2 v[32]; float d[32];
#pragma unroll
        for (int j = 0; j < 32; ++j) { v[j] = *(const u32x2*)(base + (size_t)(c0 + j) * 16 * 8192); d[j] = dec[(c0 + j) * 16]; }
#pragma unroll
        for (int j = 0; j < 32; ++j) { u32x2 o; o.x = pk2(run[0], run[1]); o.y = pk2(run[2], run[3]); *(u32x2*)(base + (size_t)(c0 + j) * 16 * 8192) = o;
            run[0] = run[0] * d[j] + bflo(v[j].x); run[1] = run[1] * d[j] + bfhi(v[j].x); run[2] = run[2] * d[j] + bflo(v[j].y); run[3] = run[3] * d[j] + bfhi(v[j].y); } }
}
__device__ __forceinline__ bf16x8 frag_l_perm(const LAS bf16* M, int ld, int row0, int k0, int lane) {
    const LAS bf16* p = M + (row0 + (lane & 31)) * ld + k0 + 4 * (lane >> 5); const s16x4 lo = *(const LAS s16x4*)p, hi = *(const LAS s16x4*)(p + 8);
    return (bf16x8){lo[0], lo[1], lo[2], lo[3], hi[0], hi[1], hi[2], hi[3]};
}
constexpr int SO_G = 0, SO_C = 34816, SO_X = 69632, SO_Y = 104448, SO_SC = 141312, SO_SQ = 145408;
__device__ __forceinline__ void ssd_out_unit(Frame& F, const Params& P, int l_, int u, int tid, int lane) {
    const int b = u >> 7, c = (u >> 1) & 63, g = u & 1, wave = F.wave, h5 = lane >> 5, l31 = lane & 31; const size_t m0 = (size_t)b * SEQ + c * 128;
    const bf16* sx = (const bf16*)(P.ws + A_SXBC); const float* ssc = (const float*)(P.ws + A_SSC); const bf16* cols = (const bf16*)(P.ws + A_COLS); bf16* ymix = (bf16*)(P.ws + A_YMIX);
    LAS bf16* Gl = (LAS bf16*)(F.lds + SO_G); LAS bf16* Cl = (LAS bf16*)(F.lds + SO_C); LAS bf16* Xl = (LAS bf16*)(F.lds + SO_X); LAS bf16* Yst = (LAS bf16*)(F.lds + SO_Y + wave * 4608);
    LAS float* sumsq = (LAS float*)(F.lds + SO_SQ);
    const float* sd = P.in[I_S_D] + (size_t)l_ * 16; const float* snorm = P.in[I_S_NORM] + (size_t)l_ * 1024;
    __syncthreads();
    for (int i = tid; i < 2048; i += NTHR) { const int row = i >> 4, ch = i & 15; const bf16* src = sx + (m0 + row) * 1536 + 1024 + g * 128 + ch * 8;
        *(LAS u32x4*)(Xl + row * SSD_LDB + ch * 8) = *(const u32x4*)src; *(LAS u32x4*)(Cl + row * SSD_LDB + ch * 8) = *(const u32x4*)(src + 256); }
    __syncthreads();
    { const int lt = wave >> 1;
#pragma unroll 1
      for (int k2 = 0; k2 < 2; ++k2) { const int st = (wave & 1) * 2 + k2; f32x16 acc = zero16();
        acc = mma_ks<8>(acc, [&](int ks) { return frag_l(Xl, SSD_LDB, 32 * st, 16 * ks, lane); }, [&](int ks) { return frag_l(Cl, SSD_LDB, 32 * lt, 16 * ks, lane); });
        LAS bf16* o = Gl + (32 * lt + l31) * SSD_LDB + 32 * st + 4 * h5;
#pragma unroll
        for (int qd = 0; qd < 4; ++qd) { u32x2 w; w.x = pk2(acc[4 * qd], acc[4 * qd + 1]); w.y = pk2(acc[4 * qd + 2], acc[4 * qd + 3]); *(LAS u32x2*)(o + 8 * qd) = w; } } }
    const int hq = wave >> 2, lt = wave & 3, l = 32 * lt + l31;
    u32x4 xr[4]; float sv[8];
#define SO_PF(rr) do { _Pragma("unroll") for (int k = 0; k < 4; ++k) { const int i = tid + NTHR * k, row = i >> 4, ch = i & 15; xr[k] = *(const u32x4*)(sx + (m0 + row) * 1536 + g * 512 + (rr) * 128 + ch * 8); } \
        if (lt == 0) { const int hd_ = g * 8 + (rr) * 2 + hq; const float* s0_ = ssc + (m0 + lane) * 64 + hd_; const float* s1_ = s0_ + 64 * 64; \
            sv[0] = s0_[32]; sv[1] = s1_[32]; sv[2] = s0_[48]; sv[3] = s1_[48]; sv[4] = s0_[0]; sv[5] = s1_[0]; sv[6] = s0_[16]; sv[7] = s1_[16]; } } while (0)
#pragma unroll
    for (int k = 0; k < 8; ++k) sv[k] = 0.f;
    SO_PF(0);
#pragma unroll 1
    for (int r = 0; r < 4; ++r) {
        const int head = g * 8 + r * 2 + hq;
        LAS float* sc = (LAS float*)(F.lds + SO_SC + hq * 2048); LAS float* af = sc, *ab = sc + 128, *dtf = sc + 256, *dtb = sc + 384;
        __syncthreads();
#pragma unroll
        for (int k = 0; k < 4; ++k) { const int i = tid + NTHR * k, row = i >> 4, ch = i & 15; *(LAS u32x4*)(Xl + row * SSD_LDB + ch * 8) = xr[k]; }
        if (lt == 0) { const float a0 = sv[0], a1 = sv[1], c0 = sv[2], c1 = sv[3];
          const float p0 = scan_incl(a0, lane), t0 = __shfl(p0, 63), p1 = scan_incl(a1, lane) + t0;
          const float q1 = scan_incl_rev(c1, lane), t1 = __shfl(q1, 0), q0 = scan_incl_rev(c0, lane) + t1;
          af[lane] = p0; af[lane + 64] = p1; ab[lane] = q0; ab[lane + 64] = q1;
          dtf[lane] = sv[4]; dtf[lane + 64] = sv[5]; dtb[lane] = sv[6]; dtb[lane + 64] = sv[7]; }
        __syncthreads();
        const bf16* hf = (const bf16*)(P.ws + A_HS) + ((size_t)(((b * 2 + 0) * 64 + c) * 16 + head)) * 8192;
        const bf16* hb = (const bf16*)(P.ws + A_HS) + ((size_t)(((b * 2 + 1) * 64 + (63 - c)) * 16 + head)) * 8192;
        const float dskip = sd[head], afl = af[l], abl = ab[l];
        f32x16 acc0 = zero16(), acc1 = zero16();
        acc0 = mma_ks<8>(acc0, [&](int ks) { return *(const bf16x8*)(hf + (0 * 8 + ks) * 512 + lane * 8); }, [&](int ks) { return frag_l_perm(Cl, SSD_LDB, 32 * lt, 16 * ks, lane); });
        acc1 = mma_ks<8>(acc1, [&](int ks) { return *(const bf16x8*)(hf + (1 * 8 + ks) * 512 + lane * 8); }, [&](int ks) { return frag_l_perm(Cl, SSD_LDB, 32 * lt, 16 * ks, lane); });
        { const float e = __expf(afl);
#pragma unroll
          for (int i = 0; i < 16; ++i) { acc0[i] *= e; acc1[i] *= e; } }
        { f32x16 t0 = zero16(), t1 = zero16();
          t0 = mma_ks<8>(t0, [&](int ks) { return *(const bf16x8*)(hb + (0 * 8 + ks) * 512 + lane * 8); }, [&](int ks) { return frag_l_perm(Cl, SSD_LDB, 32 * lt, 16 * ks, lane); });
          t1 = mma_ks<8>(t1, [&](int ks) { return *(const bf16x8*)(hb + (1 * 8 + ks) * 512 + lane * 8); }, [&](int ks) { return frag_l_perm(Cl, SSD_LDB, 32 * lt, 16 * ks, lane); });
          const float e = __expf(abl);
#pragma unroll
          for (int i = 0; i < 16; ++i) { acc0[i] += t0[i] * e; acc1[i] += t1[i] * e; } }
        if (r < 3) SO_PF(r + 1);
#pragma unroll 1
        for (int kh = 0; kh < 2; ++kh) {
            bf16x8 xx0[4], xx1[4], grw[4];
#pragma unroll
            for (int k4 = 0; k4 < 4; ++k4) { const int ks = 4 * kh + k4, s0 = 16 * ks + 8 * h5; xx0[k4] = frag_tr(Xl, SSD_LDB, 16 * ks, hq * 64, lane); xx1[k4] = frag_tr(Xl, SSD_LDB, 16 * ks, hq * 64 + 32, lane); grw[k4] = *(const LAS bf16x8*)(Gl + l * SSD_LDB + s0); }
#pragma unroll
            for (int k4 = 0; k4 < 4; ++k4) { const int ks = 4 * kh + k4, s0 = 16 * ks + 8 * h5; float f[8];
                f32x4 afs[2], abs_[2], dfs[2], dbs[2];
#pragma unroll
                for (int q = 0; q < 2; ++q) { afs[q] = *(const LAS f32x4*)(af + s0 + 4 * q); abs_[q] = *(const LAS f32x4*)(ab + s0 + 4 * q); dfs[q] = *(const LAS f32x4*)(dtf + s0 + 4 * q); dbs[q] = *(const LAS f32x4*)(dtb + s0 + 4 * q); }
#pragma unroll
                for (int j = 0; j < 8; ++j) { const int s = s0 + j; const float gv = bf2f((unsigned short)grw[k4][j]);
                    const float afv = afs[j >> 2][j & 3], abv = abs_[j >> 2][j & 3], dfv = dfs[j >> 2][j & 3], dbv = dbs[j >> 2][j & 3];
                    const float e = __expf(s < l ? afl - afv : abl - abv);
                    const float w = s < l ? e * dfv : (s > l ? e * dbv : dfv + dbv);
                    f[j] = gv * w + (s == l ? dskip : 0.f); }
                const u32x4 pk = pack8(f); const bf16x8 mf = __builtin_bit_cast(bf16x8, pk);
                acc0 = MFMA32(xx0[k4], mf, acc0); acc1 = MFMA32(xx1[k4], mf, acc1); } }
        { LAS bf16* o = Yst + l31 * 72 + 4 * h5;
#pragma unroll
          for (int qd = 0; qd < 4; ++qd) { u32x2 w; w.x = pk2(acc0[4 * qd], acc0[4 * qd + 1]); w.y = pk2(acc0[4 * qd + 2], acc0[4 * qd + 3]); *(LAS u32x2*)(o + 8 * qd) = w;
              w.x = pk2(acc1[4 * qd], acc1[4 * qd + 1]); w.y = pk2(acc1[4 * qd + 2], acc1[4 * qd + 3]); *(LAS u32x2*)(o + 32 + 8 * qd) = w; } }
        u32x4 zr[4];
#pragma unroll
        for (int k = 0; k < 4; ++k) { const int it = lane + 64 * k, tl = it >> 3, cg = it & 7; zr[k] = *(const u32x4*)(cols + (m0 + 32 * lt + tl) * NCB + C_SZ + head * 64 + 8 * cg); }
        LDS_WAIT();
#pragma unroll
        for (int k = 0; k < 4; ++k) { const int it = lane + 64 * k, tl = it >> 3, cg = it & 7; const size_t m = m0 + 32 * lt + tl;
            float y[8], z[8]; unpack8(*(const LAS u32x4*)(Yst + tl * 72 + 8 * cg), y); unpack8(zr[k], z);
            float ss = 0.f;
#pragma unroll
            for (int j = 0; j < 8; ++j) { y[j] *= siluf_(z[j]); ss += y[j] * y[j]; }
            ss += __shfl_xor(ss, 1); ss += __shfl_xor(ss, 2); ss += __shfl_xor(ss, 4);
            if (cg == 0) sumsq[(r * 2 + hq) * 128 + 32 * lt + tl] = ss;
            *(u32x4*)(ymix + m * 2048 + 1024 + head * 64 + 8 * cg) = pack8(y); }
        LDS_WAIT();
    }
#undef SO_PF
    __syncthreads();
    { u32x4 yv[4][4];
#pragma unroll
      for (int r = 0; r < 4; ++r) { const int head = g * 8 + r * 2 + hq;
#pragma unroll
          for (int k = 0; k < 4; ++k) { const int it = lane + 64 * k, tl = it >> 3, cg = it & 7; yv[r][k] = *(const u32x4*)(ymix + (m0 + 32 * lt + tl) * 2048 + 1024 + head * 64 + 8 * cg); } }
      float rs4[4];
#pragma unroll
      for (int k = 0; k < 4; ++k) { const int it = lane + 64 * k, tl = it >> 3; float sq = 0.f;
#pragma unroll
          for (int q8 = 0; q8 < 8; ++q8) sq += sumsq[q8 * 128 + 32 * lt + tl];
          rs4[k] = rsqrtf(sq * (1.f / 512.f) + 1e-5f); }
#pragma unroll
      for (int r = 0; r < 4; ++r) { const int head = g * 8 + r * 2 + hq; const int cg = lane & 7;
          const f32x4 w0 = *(const f32x4*)(snorm + head * 64 + 8 * cg), w1 = *(const f32x4*)(snorm + head * 64 + 8 * cg + 4);
#pragma unroll
          for (int k = 0; k < 4; ++k) { const int it = lane + 64 * k, tl = it >> 3; float y[8]; unpack8(yv[r][k], y);
#pragma unroll
              for (int j = 0; j < 8; ++j) y[j] = y[j] * rs4[k] * (j < 4 ? w0[j] : w1[j - 4]);
              *(u32x4*)(ymix + (m0 + 32 * lt + tl) * 2048 + 1024 + head * 64 + 8 * cg) = pack8(y); } } }
}

__device__ __forceinline__ void st_tile_tm(LAS bf16* M, int row, int col0, const f32x16& a, int h5, float sgn) {
#pragma unroll
    for (int qd = 0; qd < 4; ++qd) { u32x2 w; w.x = pk2(sgn * a[4 * qd], sgn * a[4 * qd + 1]); w.y = pk2(sgn * a[4 * qd + 2], sgn * a[4 * qd + 3]); *(LAS u32x2*)(M + row * 72 + col0 + 8 * qd + 4 * h5) = w; }
}
__device__ __forceinline__ f32x16 mm_tile(const LAS bf16* A, const LAS bf16* B, int it, int jt, int lane, f32x16 acc) {
    return mma_ks<4>(acc, [&](int ks) { return frag_tr(B, 72, 16 * ks, 32 * jt, lane); }, [&](int ks) { return frag_l(A, 72, 32 * it, 16 * ks, lane); });
}
__device__ __forceinline__ f32x16 ld_tile_tm(const LAS bf16* M, int row, int col0, int h5) {
    f32x16 a;
#pragma unroll
    for (int qd = 0; qd < 4; ++qd) { const u32x2 w = *(const LAS u32x2*)(M + row * 72 + col0 + 8 * qd + 4 * h5); a[4 * qd] = bflo(w.x); a[4 * qd + 1] = bfhi(w.x); a[4 * qd + 2] = bflo(w.y); a[4 * qd + 3] = bfhi(w.y); }
    return a;
}
template <class Fin, class Extra>
__device__ __forceinline__ void nilp_inverse(const LAS bf16* L, LAS bf16* Sb0, LAS bf16* Sb1, LAS bf16* Tb0, LAS bf16* Tb1, int wave, int lane, const Fin& fin, const Extra& extra) {
    const int it = (wave >> 1) & 1, jt = wave & 1, h5 = lane >> 5, row = 32 * it + (lane & 31);
    LAS bf16* Sb[2] = {Sb0, Sb1}; LAS bf16* Tb[2] = {Tb0, Tb1};
    if (wave < 4) st_tile_tm(Sb[1], row, 32 * jt, mm_tile(L, L, it, jt, lane, zero16()), h5, 1.f);
    else { f32x16 a = ld_tile_tm(L, row, 32 * jt, h5);
#pragma unroll
        for (int r = 0; r < 16; ++r) { const int j = 32 * jt + 8 * (r >> 2) + 4 * h5 + (r & 3); a[r] = (j == row ? 1.f : 0.f) - a[r]; }
        st_tile_tm(Tb[1], row, 32 * jt, a, h5, 1.f); }
    __syncthreads();
#pragma unroll
    for (int k = 1; k <= 5; ++k) {
        if (wave < 4) { const f32x16 acc = mm_tile(Tb[k & 1], Sb[k & 1], it, jt, lane, ld_tile_tm(Tb[k & 1], row, 32 * jt, h5));
            if (k < 5) st_tile_tm(Tb[(k + 1) & 1], row, 32 * jt, acc, h5, 1.f); else fin(acc, it, jt); }
        else { if (k < 5) st_tile_tm(Sb[(k + 1) & 1], row, 32 * jt, mm_tile(Sb[k & 1], Sb[k & 1], it, jt, lane, zero16()), h5, 1.f); else extra(); }
        __syncthreads();
    }
}
__device__ __forceinline__ void st_acc(bf16* tile, const f32x16& a, int lane) {
    u32x4 w0, w1; w0.x = pk2(a[0], a[1]); w0.y = pk2(a[2], a[3]); w0.z = pk2(a[4], a[5]); w0.w = pk2(a[6], a[7]); w1.x = pk2(a[8], a[9]); w1.y = pk2(a[10], a[11]); w1.z = pk2(a[12], a[13]); w1.w = pk2(a[14], a[15]);
    *(u32x4*)(tile + lane * 16) = w0; *(u32x4*)(tile + lane * 16 + 8) = w1; }
__device__ __forceinline__ void ld_acc_add(const bf16* tile, f32x16& a, int lane) {
    float f[8]; unpack8(*(const u32x4*)(tile + lane * 16), f);
#pragma unroll
    for (int j = 0; j < 8; ++j) a[j] += f[j];
    unpack8(*(const u32x4*)(tile + lane * 16 + 8), f);
#pragma unroll
    for (int j = 0; j < 8; ++j) a[8 + j] += f[j]; }
__device__ __forceinline__ void st_frag2(bf16* f0  , const f32x16& a, int lane) {
    u32x4 w0, w1; w0.x = pk2(a[0], a[1]); w0.y = pk2(a[2], a[3]); w0.z = pk2(a[4], a[5]); w0.w = pk2(a[6], a[7]); w1.x = pk2(a[8], a[9]); w1.y = pk2(a[10], a[11]); w1.z = pk2(a[12], a[13]); w1.w = pk2(a[14], a[15]);
    *(u32x4*)(f0 + lane * 8) = w0; *(u32x4*)(f0 + 512 + lane * 8) = w1; }
constexpr int GL_KN = 0, GL_QN = 17408, GL_V = 34816, GL_QK = 52224, GL_TU = 61440, GL_TW = 70656, GL_LF = 79872, GL_UT = 79872, GL_UST = 98304, GL_WT = 116736, GL_WST = 135168, GL_SC = 153600;
struct GdnRaw { u32x4 q[2], k[2], v[2]; float g, bt; };
__device__ __forceinline__ void gdn_a_load(const Params& P, int u, int tid, GdnRaw& r) {
    const int head = (u >> 1) & 3, c = (u >> 3) & 127, b = u >> 10; const size_t m0 = (size_t)b * SEQ + c * 64; const bf16* gq = (const bf16*)(P.ws + A_GQKV);
#pragma unroll
    for (int k = 0; k < 2; ++k) { const int i = tid + k * NTHR, row = i >> 4, ch = i & 15; const bf16* src = gq + (m0 + row) * 1536 + head * 128 + ch * 8;
        r.q[k] = *(const u32x4*)src; r.k[k] = *(const u32x4*)(src + 512); r.v[k] = *(const u32x4*)(src + 1024); }
    r.g = 0.f; r.bt = 0.f;
    if (tid < 64) { const float* gsc = (const float*)(P.ws + A_GSC); const int dir = u & 1; r.g = gsc[(m0 + tid) * 16 + 8 + dir * 4 + head]; r.bt = gsc[(m0 + tid) * 16 + dir * 4 + head]; }
}
__device__ __forceinline__ void gdn_a_unit(Frame& F, const Params& P, int u, int tid, int lane, const GdnRaw& raw, int u_next, GdnRaw& raw_next) {
    const int dir = u & 1, head = (u >> 1) & 3, c = (u >> 3) & 127, b = u >> 10, wave = F.wave, h5 = lane >> 5, l31 = lane & 31; const size_t m0 = (size_t)b * SEQ + c * 64;
    const int uu = ((b * 2 + dir) * 128 + (dir ? 127 - c : c)) * 4 + head;
    const bf16* gq = (const bf16*)(P.ws + A_GQKV); const float* gsc = (const float*)(P.ws + A_GSC);
    LAS bf16* Kn = (LAS bf16*)(F.lds + GL_KN); LAS bf16* Qn = (LAS bf16*)(F.lds + GL_QN); LAS bf16* Vv = (LAS bf16*)(F.lds + GL_V); LAS bf16* QK = (LAS bf16*)(F.lds + GL_QK);
    LAS bf16* Tu = (LAS bf16*)(F.lds + GL_TU); LAS bf16* Tw = (LAS bf16*)(F.lds + GL_TW); LAS bf16* Lb = (LAS bf16*)(F.lds + GL_LF);
    LAS bf16* Ut = (LAS bf16*)(F.lds + GL_UT); LAS bf16* Ust = (LAS bf16*)(F.lds + GL_UST); LAS bf16* Wt = (LAS bf16*)(F.lds + GL_WT); LAS bf16* Wst = (LAS bf16*)(F.lds + GL_WST);
    LAS float* GC = (LAS float*)(F.lds + GL_SC); LAS float* BT = GC + 64; LAS float* EG = GC + 128; LAS float* SV = GC + 192;
    __syncthreads();
#pragma unroll
    for (int k = 0; k < 2; ++k) { const int i = tid + k * NTHR, row = i >> 4, ch = i & 15;
        *(LAS u32x4*)(Qn + row * 136 + ch * 8) = raw.q[k]; *(LAS u32x4*)(Kn + row * 136 + ch * 8) = raw.k[k]; *(LAS u32x4*)(Vv + row * 136 + ch * 8) = raw.v[k]; }
    if (u_next < 2048) gdn_a_load(P, u_next, tid, raw_next);
    if (wave == 0) { const float g = raw.g, bt = raw.bt;
        const float gc = dir ? scan_incl_rev(g, lane) : scan_incl(g, lane), tot = __shfl(gc, dir ? 0 : 63);
        GC[lane] = gc; BT[lane] = bt; EG[lane] = __expf(gc); SV[lane] = __expf(tot - gc);
        if (lane == 0) ((float*)(P.ws + A_GD))[uu] = __expf(tot); }
    __syncthreads();
    { const int kind = wave >> 2, it = (wave >> 1) & 1, jt = wave & 1; f32x16 acc = zero16();
      acc = mma_ks<8>(acc, [&](int ks) { return frag_l(Kn, 136, 32 * jt, 16 * ks, lane); }, [&](int ks) { return frag_l(kind ? Qn : Kn, 136, 32 * it, 16 * ks, lane); });
      const int i = 32 * it + l31; const float gci = GC[i], bi = BT[i];
#pragma unroll
      for (int qd = 0; qd < 4; ++qd) { const int j0 = 32 * jt + 8 * qd + 4 * h5; float v[4];
#pragma unroll
          for (int r = 0; r < 4; ++r) { const int j = j0 + r; const bool before = dir ? (j > i) : (j < i); const float e = __expf(fminf(gci - GC[j], 0.f));
              v[r] = kind == 0 ? (before ? bi * acc[4 * qd + r] * e : 0.f) : ((before || j == i) ? acc[4 * qd + r] * e : 0.f); }
          { u32x2 w; w.x = pk2(v[0], v[1]); w.y = pk2(v[2], v[3]); *(LAS u32x2*)((kind == 0 ? Lb : QK) + i * 72 + j0) = w; } } }
    __syncthreads();
    nilp_inverse(Lb, (LAS bf16*)(F.lds + GL_UST), (LAS bf16*)(F.lds + GL_UST + 9216), (LAS bf16*)(F.lds + GL_WT), (LAS bf16*)(F.lds + GL_WT + 9216), wave, lane,
        [&](const f32x16& acc, int it, int jt) { const int row = 32 * it + l31;
#pragma unroll
            for (int qd = 0; qd < 4; ++qd) { const int j0 = 32 * jt + 8 * qd + 4 * h5; const f32x4 bt = *(const LAS f32x4*)(BT + j0), eg = *(const LAS f32x4*)(EG + j0); u32x2 w;
                w.x = pk2(acc[4 * qd] * bt[0], acc[4 * qd + 1] * bt[1]); w.y = pk2(acc[4 * qd + 2] * bt[2], acc[4 * qd + 3] * bt[3]); *(LAS u32x2*)(Tu + row * 72 + j0) = w;
                w.x = pk2(acc[4 * qd] * bt[0] * eg[0], acc[4 * qd + 1] * bt[1] * eg[1]); w.y = pk2(acc[4 * qd + 2] * bt[2] * eg[2], acc[4 * qd + 3] * bt[3] * eg[3]); *(LAS u32x2*)(Tw + row * 72 + j0) = w; } },
        [&]() {});
    { const int it = wave >> 2, et = wave & 3;
#pragma unroll
      for (int k2 = 0; k2 < 2; ++k2) { f32x16 acc = zero16(); const LAS bf16* Tm = k2 ? Tw : Tu; const LAS bf16* Src = k2 ? Kn : Vv; LAS bf16* O1 = k2 ? Wt : Ut; LAS bf16* O2 = k2 ? Wst : Ust;
        acc = mma_ks<4>(acc, [&](int ks) { return frag_l(Tm, 72, 32 * it, 16 * ks, lane); }, [&](int ks) { return frag_tr(Src, 136, 16 * ks, 32 * et, lane); });
#pragma unroll
        for (int qd = 0; qd < 4; ++qd) { const int i0 = 32 * it + 8 * qd + 4 * h5; const f32x4 sv = *(const LAS f32x4*)(SV + i0); u32x2 w;
            w.x = pk2(acc[4 * qd], acc[4 * qd + 1]); w.y = pk2(acc[4 * qd + 2], acc[4 * qd + 3]); *(LAS u32x2*)(O1 + (32 * et + l31) * 72 + i0) = w;
            w.x = pk2(acc[4 * qd] * sv[0], acc[4 * qd + 1] * sv[1]); w.y = pk2(acc[4 * qd + 2] * sv[2], acc[4 * qd + 3] * sv[3]); *(LAS u32x2*)(O2 + (32 * et + l31) * 72 + i0) = w; } } }
    __syncthreads();
    { bf16* gpsi = (bf16*)(P.ws + A_GPSI) + (size_t)uu * 16384; bf16* glam = (bf16*)(P.ws + A_GLAM) + (size_t)uu * 16384; bf16* gqt = (bf16*)(P.ws + A_GQT) + (size_t)uu * 8192; bf16* go0 = (bf16*)(P.ws + A_GO0) + (size_t)uu * 8192;
      const int dt = wave & 3, hi2 = wave >> 2;
#pragma unroll
      for (int k2 = 0; k2 < 2; ++k2) { const int et = 2 * hi2 + k2; f32x16 acc = zero16();
        acc = mma_ks<4>(acc, [&](int ks) { return frag_tr(Kn, 136, 16 * ks, 32 * dt, lane); }, [&](int ks) { return frag_l(Ust, 72, 32 * et, 16 * ks, lane); });
        st_acc(gpsi + (dt * 4 + et) * 1024, acc, lane); }
#pragma unroll
      for (int k2 = 0; k2 < 2; ++k2) { const int dpt = 2 * hi2 + k2; f32x16 acc = zero16();
        acc = mma_ks<4>(acc, [&](int ks) { return frag_l(Wst, 72, 32 * dpt, 16 * ks, lane); }, [&](int ks) { return frag_tr(Kn, 136, 16 * ks, 32 * dt, lane); });
#pragma unroll
        for (int r = 0; r < 16; ++r) acc[r] = -acc[r];
        st_frag2(glam + (dt * 8 + 2 * dpt) * 512, acc, lane); }
      { const int it = hi2, dpt = dt; f32x16 acc = zero16();
        acc = mma_ks<4>(acc, [&](int ks) { return frag_l(Wt, 72, 32 * dpt, 16 * ks, lane); }, [&](int ks) { return frag_l(QK, 72, 32 * it, 16 * ks, lane); });
        const int i = 32 * it + l31; const float eg = EG[i];
#pragma unroll
        for (int qd = 0; qd < 4; ++qd) { const u32x2 qw = *(const LAS u32x2*)(Qn + i * 136 + 32 * dpt + 8 * qd + 4 * h5);
            acc[4 * qd] = eg * bflo(qw.x) - acc[4 * qd]; acc[4 * qd + 1] = eg * bfhi(qw.x) - acc[4 * qd + 1]; acc[4 * qd + 2] = eg * bflo(qw.y) - acc[4 * qd + 2]; acc[4 * qd + 3] = eg * bfhi(qw.y) - acc[4 * qd + 3]; }
        st_frag2(gqt + (it * 8 + 2 * dpt) * 512, acc, lane); }
      { const int it = hi2, et = dt; f32x16 acc = zero16();
        acc = mma_ks<4>(acc, [&](int ks) { return frag_l(Ut, 72, 32 * et, 16 * ks, lane); }, [&](int ks) { return frag_l(QK, 72, 32 * it, 16 * ks, lane); });
        st_acc(go0 + (et * 2 + it) * 1024, acc, lane); } }
}
__device__ __forceinline__ void phase_gdn_a(Frame& F, const Params& P) {
    int lane = F.lane; asm volatile("" : "+v"(lane)); int tid = F.tid; asm volatile("" : "+v"(tid));
    GdnRaw A, B; int u = F.vcu; if (u >= 2048) return;
    gdn_a_load(P, u, tid, A);
    for (;;) { gdn_a_unit(F, P, u, tid, lane, A, u + F.G, B); u += F.G; if (u >= 2048) break;
               gdn_a_unit(F, P, u, tid, lane, B, u + F.G, A); u += F.G; if (u >= 2048) break; }
}
struct GdnScanOps { bf16x8 lam[8]; u32x4 ps0, ps1; float d; };
__device__ __forceinline__ void gdn_scan_unit(Frame& F, const Params& P, int unit, int lane) {
    const int eq = unit & 3, chain = unit >> 2, wave = F.wave, dt = wave & 3, et = eq, bd = chain >> 2, head = chain & 3;
    LAS bf16* Hf = (LAS bf16*)(F.lds);
    __syncthreads();
    if (wave >= 4) {
        const bf16* glam_ = (const bf16*)(P.ws + A_GLAM); const bf16* gpsi_ = (const bf16*)(P.ws + A_GPSI); const int w4 = wave - 4;
        u32x4 pa[4], pb[4];
#pragma unroll
        for (int j = 0; j < 4; ++j) { pa[j] = (u32x4){0u, 0u, 0u, 0u}; pb[j] = pa[j]; }
#define GS_PF(cqx, J) do { const size_t un_ = (size_t)(bd * 128 + ((cqx) < 128 ? (cqx) : 127)) * 4 + head; \
            pa[J] = *(const u32x4*)(glam_ + un_ * 16384 + (eq * 8 + 2 * w4) * 512 + lane * 16); pb[J] = *(const u32x4*)(gpsi_ + un_ * 16384 + (w4 * 4 + et) * 1024 + lane * 16); } while (0)
#pragma unroll 1
        for (int cq = 0; cq < 128; cq += 4) {
#pragma unroll
            for (int j = 0; j < 4; ++j) { asm volatile("" :: "v"(pa[j]), "v"(pb[j])); GS_PF(cq + j + 5, j);
                asm volatile("s_waitcnt lgkmcnt(0)" ::: "memory"); __builtin_amdgcn_s_barrier(); } }
#pragma unroll
        for (int j = 0; j < 4; ++j) asm volatile("" :: "v"(pa[j]), "v"(pb[j]));
#undef GS_PF
        return; }
    f32x16 Hm = zero16();
    const bf16* gpsi = (const bf16*)(P.ws + A_GPSI); const bf16* glam = (const bf16*)(P.ws + A_GLAM); bf16* gh = (bf16*)(P.ws + A_GH); const float* gd = (const float*)(P.ws + A_GD);
#define GS_LOAD(S, cqx) do { const size_t un_ = (size_t)(bd * 128 + ((cqx) < 128 ? (cqx) : 127)) * 4 + head; \
        _Pragma("unroll") for (int ks = 0; ks < 8; ++ks) S.lam[ks] = *(const bf16x8*)(glam + un_ * 16384 + (dt * 8 + ks) * 512 + lane * 8); \
        S.ps0 = *(const u32x4*)(gpsi + un_ * 16384 + (dt * 4 + et) * 1024 + lane * 16); S.ps1 = *(const u32x4*)(gpsi + un_ * 16384 + (dt * 4 + et) * 1024 + lane * 16 + 8); S.d = gd[un_]; } while (0)
#define GS_STEP(CUR, NXT, cqx) do { const size_t uu_ = (size_t)(bd * 128 + (cqx)) * 4 + head; const int par_ = (cqx) & 1; \
        { u32x4 w0, w1; w0.x = pk2(Hm[0], Hm[1]); w0.y = pk2(Hm[2], Hm[3]); w0.z = pk2(Hm[4], Hm[5]); w0.w = pk2(Hm[6], Hm[7]); w1.x = pk2(Hm[8], Hm[9]); w1.y = pk2(Hm[10], Hm[11]); w1.z = pk2(Hm[12], Hm[13]); w1.w = pk2(Hm[14], Hm[15]); \
          LAS bf16* lf = Hf + (par_ * 8 + 2 * dt) * 512 + lane * 8; *(LAS u32x4*)lf = w0; *(LAS u32x4*)(lf + 512) = w1; \
          bf16* gf = gh + uu_ * 16384 + (et * 8 + 2 * dt) * 512 + lane * 8; *(u32x4*)gf = w0; *(u32x4*)(gf + 512) = w1; } \
        GS_LOAD(NXT, (cqx) + 3); \
        asm volatile("s_waitcnt lgkmcnt(0)" ::: "memory"); __builtin_amdgcn_s_barrier(); asm volatile("" ::: "memory"); \
        bf16x8 hv[8]; const LAS bf16* hb = Hf + (par_ * 8) * 512 + lane * 8; \
        _Pragma("unroll") for (int ks = 0; ks < 8; ++ks) hv[ks] = *(const LAS bf16x8*)(hb + ks * 512); \
        f32x16 acc; { float f[8]; unpack8(CUR.ps0, f); _Pragma("unroll") for (int j = 0; j < 8; ++j) acc[j] = CUR.d * Hm[j] + f[j]; \
          unpack8(CUR.ps1, f); _Pragma("unroll") for (int j = 0; j < 8; ++j) acc[8 + j] = CUR.d * Hm[8 + j] + f[j]; } \
        asm volatile("s_waitcnt lgkmcnt(0)" ::: "memory"); __builtin_amdgcn_sched_barrier(0); \
        _Pragma("unroll") for (int ks = 0; ks < 8; ++ks) acc = MFMA32(CUR.lam[ks], hv[ks], acc); \
        Hm = acc; } while (0)
    GdnScanOps A, B, C, D;
    GS_LOAD(A, 0); GS_LOAD(B, 1); GS_LOAD(C, 2);
#pragma unroll 1
    for (int cq = 0; cq < 128; cq += 4) { GS_STEP(A, D, cq); GS_STEP(B, A, cq + 1); GS_STEP(C, B, cq + 2); GS_STEP(D, C, cq + 3); }
#undef GS_LOAD
#undef GS_STEP
}
__device__ __forceinline__ void gdn_out_wave(Frame& F, const Params& P, int l_, int u, int lane) {
    const int it = u & 1, head = (u >> 1) & 3, c = (u >> 3) & 127, b = u >> 10, h5 = lane >> 5, l31 = lane & 31; const size_t m0 = (size_t)b * SEQ + c * 64 + 32 * it;
    const bf16* gh = (const bf16*)(P.ws + A_GH); const bf16* gqt = (const bf16*)(P.ws + A_GQT); const bf16* go0 = (const bf16*)(P.ws + A_GO0);
    const bf16* cols = (const bf16*)(P.ws + A_COLS); bf16* ymix = (bf16*)(P.ws + A_YMIX); const float* gnorm = P.in[I_GDN_NORM] + (size_t)l_ * 128;
    LAS float* Ost = (LAS float*)(F.lds + F.wave * 17408);
    const size_t uf = (size_t)((b * 2 + 0) * 128 + c) * 4 + head, ub = (size_t)((b * 2 + 1) * 128 + (127 - c)) * 4 + head;
    u32x4 zr[8];
#pragma unroll
    for (int pass = 0; pass < 8; ++pass) zr[pass] = *(const u32x4*)(cols + (m0 + pass * 4 + (lane >> 4)) * NCB + C_GZ + head * 128 + 8 * (lane & 15));
    const f32x4 w0 = *(const f32x4*)(gnorm + 8 * (lane & 15)), w1 = *(const f32x4*)(gnorm + 8 * (lane & 15) + 4);
    f32x16 acc[4];
#pragma unroll
    for (int et = 0; et < 4; ++et) { acc[et] = zero16(); ld_acc_add(go0 + uf * 8192 + (et * 2 + it) * 1024, acc[et], lane); ld_acc_add(go0 + ub * 8192 + (et * 2 + it) * 1024, acc[et], lane); }
    bf16x8 nq[2], nh[2][4];
#define GO_LD(ks_) do { nq[0] = *(const bf16x8*)(gqt + uf * 8192 + (it * 8 + (ks_)) * 512 + lane * 8); nq[1] = *(const bf16x8*)(gqt + ub * 8192 + (it * 8 + (ks_)) * 512 + lane * 8); \
        _Pragma("unroll") for (int et = 0; et < 4; ++et) { nh[0][et] = *(const bf16x8*)(gh + uf * 16384 + (et * 8 + (ks_)) * 512 + lane * 8); nh[1][et] = *(const bf16x8*)(gh + ub * 16384 + (et * 8 + (ks_)) * 512 + lane * 8); } } while (0)
    GO_LD(0);
#pragma unroll 1
    for (int ks = 0; ks < 8; ++ks) { const bf16x8 cq0 = nq[0], cq1 = nq[1]; bf16x8 ch0[4], ch1[4];
#pragma unroll
        for (int et = 0; et < 4; ++et) { ch0[et] = nh[0][et]; ch1[et] = nh[1][et]; }
        if (ks < 7) GO_LD(ks + 1);
#pragma unroll
        for (int et = 0; et < 4; ++et) { acc[et] = MFMA32(ch0[et], cq0, acc[et]); acc[et] = MFMA32(ch1[et], cq1, acc[et]); } }
#undef GO_LD
#pragma unroll
    for (int et = 0; et < 4; ++et) {
#pragma unroll
        for (int qd = 0; qd < 4; ++qd) *(LAS f32x4*)(Ost + l31 * 132 + 32 * et + 8 * qd + 4 * h5) = (f32x4){acc[et][4 * qd], acc[et][4 * qd + 1], acc[et][4 * qd + 2], acc[et][4 * qd + 3]}; }
    LDS_WAIT();
#pragma unroll
    for (int pass = 0; pass < 8; ++pass) { const int tok = pass * 4 + (lane >> 4), e0 = 8 * (lane & 15); const size_t m = m0 + tok;
        const f32x4 a0 = *(const LAS f32x4*)(Ost + tok * 132 + e0), a1 = *(const LAS f32x4*)(Ost + tok * 132 + e0 + 4); float o[8] = {a0[0], a0[1], a0[2], a0[3], a1[0], a1[1], a1[2], a1[3]}, z[8];
        float ss = 0.f;
#pragma unroll
        for (int j = 0; j < 8; ++j) ss += o[j] * o[j];
        ss += __shfl_xor(ss, 1); ss += __shfl_xor(ss, 2); ss += __shfl_xor(ss, 4); ss += __shfl_xor(ss, 8);
        const float sc = rsqrtf(ss * (1.f / 128.f) + 1e-6f); unpack8(zr[pass], z);
#pragma unroll
        for (int j = 0; j < 8; ++j) o[j] = o[j] * sc * (j < 4 ? w0[j] : w1[j - 4]) * siluf_(z[j]);
        *(u32x4*)(ymix + m * 2048 + head * 128 + e0) = pack8(o); }
    LDS_WAIT();
}
__device__ __forceinline__ void phase_gdn_out(Frame& F, const Params& P, int l) {
    int lane = F.lane; asm volatile("" : "+v"(lane));
    for (int u = F.vcu * NWAVES + F.wave; u < 2048; u += F.G * NWAVES) gdn_out_wave(F, P, l, u, lane);
}

constexpr int RL_KAP = 0, RL_KH = 9216, RL_AH = 18432, RL_RHO = 27648, RL_V = 36864, RL_AKK = 46080, RL_BQK = 55296, RL_BQA = 64512, RL_T = 73728, RL_ZT = 82944, RL_NWT = 92160, RL_NU0T = 101376,
              RL_LF = 110592, RL_PART = 128000, RL_PC = 130048;
struct RwkvRaw { u32x4 a0, a1, a2, a3, a4; f32x4 l0, l1; };
__device__ __forceinline__ void rwkv_a_load(const Params& P, int u, int tid, RwkvRaw& r) {
    const int dir = u & 1, head = (u >> 1) & 7, c = (u >> 4) & 127, b = u >> 11; const size_t m0 = (size_t)b * SEQ + c * 64;
    const bf16* rkv = (const bf16*)(P.ws + A_RKV); const bf16* rkk = (const bf16*)(P.ws + A_RKK); const float* rlogw = (const float*)(P.ws + A_RLOGW); const bf16* rkdir = (const bf16*)(P.ws + A_RKDIR); const bf16* rkka = (const bf16*)(P.ws + A_RKKA);
    const int t = tid >> 3, col8 = head * 64 + 8 * (tid & 7); const size_t m = m0 + t;
    r.a0 = *(const u32x4*)(rkv + m * 1536 + col8); r.a1 = *(const u32x4*)(rkv + m * 1536 + 1024 + col8); r.a2 = *(const u32x4*)(rkk + m * 512 + col8);
    r.a3 = *(const u32x4*)(rkdir + m * 1024 + dir * 512 + col8); r.a4 = *(const u32x4*)(rkka + m * 1024 + dir * 512 + col8);
    const int t2 = tid >> 4, q4 = 4 * (tid & 15);
    r.l0 = *(const f32x4*)(rlogw + (m0 + t2) * 1024 + dir * 512 + head * 64 + q4); r.l1 = *(const f32x4*)(rlogw + (m0 + t2 + 32) * 1024 + dir * 512 + head * 64 + q4);
}
__device__ __forceinline__ void rwkv_a_unit(Frame& F, const Params& P, int u, int tid, int lane, const RwkvRaw& raw, int u_next, RwkvRaw& raw_next) {
    const int dir = u & 1, head = (u >> 1) & 7, c = (u >> 4) & 127, b = u >> 11, wave = F.wave, h5 = lane >> 5, l31 = lane & 31; const size_t m0 = (size_t)b * SEQ + c * 64;
    const size_t uu = (size_t)((b * 2 + dir) * 128 + (dir ? 127 - c : c)) * 8 + head;
    const bf16* rkv = (const bf16*)(P.ws + A_RKV); const bf16* rkk = (const bf16*)(P.ws + A_RKK); const float* rlogw = (const float*)(P.ws + A_RLOGW); const bf16* rkdir = (const bf16*)(P.ws + A_RKDIR); const bf16* rkka = (const bf16*)(P.ws + A_RKKA);
    LAS bf16* KAP = (LAS bf16*)(F.lds + RL_KAP); LAS bf16* KH = (LAS bf16*)(F.lds + RL_KH); LAS bf16* AH = (LAS bf16*)(F.lds + RL_AH); LAS bf16* RHO = (LAS bf16*)(F.lds + RL_RHO); LAS bf16* VV = (LAS bf16*)(F.lds + RL_V);
    LAS bf16* AKK = (LAS bf16*)(F.lds + RL_AKK); LAS bf16* BQK = (LAS bf16*)(F.lds + RL_BQK); LAS bf16* BQA = (LAS bf16*)(F.lds + RL_BQA); LAS bf16* Tm = (LAS bf16*)(F.lds + RL_T);
    LAS bf16* ZT = (LAS bf16*)(F.lds + RL_ZT); LAS bf16* NWT = (LAS bf16*)(F.lds + RL_NWT); LAS bf16* NU0T = (LAS bf16*)(F.lds + RL_NU0T); LAS bf16* Lb = (LAS bf16*)(F.lds + RL_LF);
    LAS float* PART = (LAS float*)(F.lds + RL_PART); LAS float* PC = (LAS float*)(F.lds + RL_PC);
    __syncthreads();
    LAS bf16* RAW = (LAS bf16*)(F.lds + RL_AKK); LAS float* RLW = (LAS float*)(F.lds + RL_AKK + 40960);
    { const int t = tid >> 3, q8 = 8 * (tid & 7); const int t2 = tid >> 4, q4 = 4 * (tid & 15);
      *(LAS u32x4*)(RAW + 0 * 4096 + t * 64 + q8) = raw.a0; *(LAS u32x4*)(RAW + 1 * 4096 + t * 64 + q8) = raw.a1; *(LAS u32x4*)(RAW + 2 * 4096 + t * 64 + q8) = raw.a2; *(LAS u32x4*)(RAW + 3 * 4096 + t * 64 + q8) = raw.a3; *(LAS u32x4*)(RAW + 4 * 4096 + t * 64 + q8) = raw.a4;
      *(LAS f32x4*)(RLW + t2 * 64 + q4) = raw.l0; *(LAS f32x4*)(RLW + (t2 + 32) * 64 + q4) = raw.l1; }
    if (u_next < 4096) rwkv_a_load(P, u_next, tid, raw_next);
    __syncthreads();
    { float lw[8], p[8];
#pragma unroll
      for (int j = 0; j < 8; ++j) lw[j] = RLW[(8 * wave + j) * 64 + lane];
      if (dir == 0) { float a = 0.f;
#pragma unroll
          for (int j = 0; j < 8; ++j) { a += lw[j]; p[j] = a; } PART[wave * 64 + lane] = a; }
      else { float a = 0.f;
#pragma unroll
          for (int j = 7; j >= 0; --j) { a += lw[j]; p[j] = a; } PART[wave * 64 + lane] = a; }
      __syncthreads();
      float off = 0.f, tot = 0.f;
#pragma unroll
      for (int w2 = 0; w2 < 8; ++w2) { const float t = PART[w2 * 64 + lane]; tot += t; if (dir == 0 ? (w2 < wave) : (w2 > wave)) off += t; }
      if (wave == 0) { const float pc = __expf(tot); PC[lane] = pc; ((float*)(P.ws + A_RPC))[uu * 64 + lane] = pc; }
#pragma unroll
      for (int j = 0; j < 8; ++j) { const int t = 8 * wave + j; const float lp = off + p[j], lpex = lp - lw[j];
          const float rr = bf2f(RAW[0 * 4096 + t * 64 + lane]), vv = bf2f(RAW[1 * 4096 + t * 64 + lane]), kk = bf2f(RAW[2 * 4096 + t * 64 + lane]), kd = bf2f(RAW[3 * 4096 + t * 64 + lane]), ka = bf2f(RAW[4 * 4096 + t * 64 + lane]);
          const float en = __expf(-lp);
          KAP[t * 72 + lane] = (bf16)f2bf(kk * __expf(lpex)); KH[t * 72 + lane] = (bf16)f2bf(kd * en); AH[t * 72 + lane] = (bf16)f2bf(ka * en); RHO[t * 72 + lane] = (bf16)f2bf(rr * __expf(lp)); VV[t * 72 + lane] = (bf16)f2bf(vv); } }
    __syncthreads();
    { const int mat = wave >> 1, tt = wave & 1; const LAS bf16* Xs = (mat == 0 || mat == 3) ? AH : KH; const LAS bf16* Ys = mat < 2 ? KAP : RHO; const int t = 32 * tt + l31;
#pragma unroll
      for (int st = 0; st < 2; ++st) { f32x16 acc = zero16();
        acc = mma_ks<4>(acc, [&](int ks) { return frag_l(Xs, 72, 32 * st, 16 * ks, lane); }, [&](int ks) { return frag_l(Ys, 72, 32 * tt, 16 * ks, lane); });
#pragma unroll
        for (int qd = 0; qd < 4; ++qd) { const int s0 = 32 * st + 8 * qd + 4 * h5; float v[4];
#pragma unroll
            for (int r = 0; r < 4; ++r) { const int sidx = s0 + r; const bool before = dir ? (sidx > t) : (sidx < t); v[r] = (before || (mat >= 2 && sidx == t)) ? acc[4 * qd + r] : 0.f; }
            { LAS bf16* O = mat == 0 ? Lb : (mat == 1 ? AKK : (mat == 2 ? BQK : BQA)); u32x2 w; w.x = pk2(v[0], v[1]); w.y = pk2(v[2], v[3]); *(LAS u32x2*)(O + t * 72 + s0) = w; } } } }
    __syncthreads();
    nilp_inverse(Lb, ZT, (LAS bf16*)(F.lds + RL_LF + 9216), NWT, NU0T, wave, lane,
        [&](const f32x16& acc, int it, int jt) { st_tile_tm(Tm, 32 * it + l31, 32 * jt, acc, h5, 1.f); },
        [&]() { const int tt = (wave >> 1) & 1, vt = wave & 1; f32x16 acc = zero16();
            acc = mma_ks<4>(acc, [&](int ks) { return frag_l(AKK, 72, 32 * tt, 16 * ks, lane); }, [&](int ks) { return frag_tr(VV, 72, 16 * ks, 32 * vt, lane); });
            st_tile_tm(ZT, 32 * vt + l31, 32 * tt, acc, h5, 1.f); });
    { const int which = wave >> 2, tt = (wave >> 1) & 1, ct = wave & 1; f32x16 acc = zero16();
      acc = mma_ks<4>(acc, [&](int ks) { return frag_l(Tm, 72, 32 * tt, 16 * ks, lane); }, [&](int ks) { return which ? frag_l(ZT, 72, 32 * ct, 16 * ks, lane) : frag_tr(KAP, 72, 16 * ks, 32 * ct, lane); });
      st_tile_tm(which ? NU0T : NWT, 32 * ct + l31, 32 * tt, acc, h5, -1.f); }
    __syncthreads();
    { bf16* gpsi = (bf16*)(P.ws + A_RPSI) + uu * 4096; bf16* glam = (bf16*)(P.ws + A_RLAM) + uu * 4096; bf16* grt = (bf16*)(P.ws + A_RRT) + uu * 4096; bf16* gy0 = (bf16*)(P.ws + A_RY0) + uu * 4096;
      const int a2 = (wave >> 1) & 1, b2 = wave & 1;
      if (wave < 4) {
        { const int tt = a2, ct = b2; f32x16 acc = zero16();
          acc = mma_ks<4>(acc, [&](int ks) { return frag_l(NWT, 72, 32 * ct, 16 * ks, lane); }, [&](int ks) { return frag_l(BQA, 72, 32 * tt, 16 * ks, lane); });
          const int t = 32 * tt + l31;
#pragma unroll
          for (int qd = 0; qd < 4; ++qd) { const u32x2 rw = *(const LAS u32x2*)(RHO + t * 72 + 32 * ct + 8 * qd + 4 * h5);
              acc[4 * qd] += bflo(rw.x); acc[4 * qd + 1] += bfhi(rw.x); acc[4 * qd + 2] += bflo(rw.y); acc[4 * qd + 3] += bfhi(rw.y); }
          st_frag2(grt + (tt * 4 + 2 * ct) * 512, acc, lane); }
        { const int tt = a2, vt = b2; f32x16 acc = zero16();
          acc = mma_ks<4>(acc, [&](int ks) { return frag_tr(VV, 72, 16 * ks, 32 * vt, lane); }, [&](int ks) { return frag_l(BQK, 72, 32 * tt, 16 * ks, lane); });
          acc = mma_ks<4>(acc, [&](int ks) { return frag_l(NU0T, 72, 32 * vt, 16 * ks, lane); }, [&](int ks) { return frag_l(BQA, 72, 32 * tt, 16 * ks, lane); });
          st_acc(gy0 + (vt * 2 + tt) * 1024, acc, lane); }
      } else {
        { const int ct = a2, cpt = b2; f32x16 acc = zero16();
          acc = mma_ks<4>(acc, [&](int ks) { return frag_l(NWT, 72, 32 * cpt, 16 * ks, lane); }, [&](int ks) { return frag_tr(AH, 72, 16 * ks, 32 * ct, lane); });
          const float pc = PC[32 * ct + l31];
#pragma unroll
          for (int r = 0; r < 16; ++r) acc[r] *= pc;
          st_frag2(glam + (ct * 4 + 2 * cpt) * 512, acc, lane); }
        { const int ct = a2, vt = b2; f32x16 acc = zero16();
          acc = mma_ks<4>(acc, [&](int ks) { return frag_tr(KH, 72, 16 * ks, 32 * ct, lane); }, [&](int ks) { return frag_tr(VV, 72, 16 * ks, 32 * vt, lane); });
          acc = mma_ks<4>(acc, [&](int ks) { return frag_tr(AH, 72, 16 * ks, 32 * ct, lane); }, [&](int ks) { return frag_l(NU0T, 72, 32 * vt, 16 * ks, lane); });
#pragma unroll
          for (int qd = 0; qd < 4; ++qd) { const f32x4 pc = *(const LAS f32x4*)(PC + 32 * ct + 8 * qd + 4 * h5);
#pragma unroll
              for (int r = 0; r < 4; ++r) acc[4 * qd + r] *= pc[r]; }
          st_acc(gpsi + (ct * 2 + vt) * 1024, acc, lane); }
      } }
}
__device__ __forceinline__ void phase_rwkv_a(Frame& F, const Params& P) {
    int lane = F.lane; asm volatile("" : "+v"(lane)); int tid = F.tid; asm volatile("" : "+v"(tid));
    RwkvRaw A, B; int u = F.vcu; if (u >= 4096) return;
    rwkv_a_load(P, u, tid, A);
    for (;;) { rwkv_a_unit(F, P, u, tid, lane, A, u + F.G, B); u += F.G; if (u >= 4096) break;
               rwkv_a_unit(F, P, u, tid, lane, B, u + F.G, A); u += F.G; if (u >= 4096) break; }
}
struct RwkvScanOps { bf16x8 lam[4]; u32x4 ps0, ps1; f32x4 pc[4]; };
__device__ __forceinline__ void rwkv_scan_unit(Frame& F, const Params& P, int unit, int lane) {
    const int wave = F.wave, chain = unit, ct = (wave >> 1) & 1, vt = wave & 1, bd = chain >> 3, head = chain & 7, h5 = lane >> 5;
    LAS bf16* Hf = (LAS bf16*)(F.lds);
    __syncthreads();
    if (wave >= 4) {
#pragma unroll 1
        for (int cq = 0; cq < 128; ++cq) { asm volatile("s_waitcnt lgkmcnt(0)" ::: "memory"); __builtin_amdgcn_s_barrier(); }
        return; }
    f32x16 Hm = zero16();
    const bf16* gpsi = (const bf16*)(P.ws + A_RPSI); const bf16* glam = (const bf16*)(P.ws + A_RLAM); bf16* gh = (bf16*)(P.ws + A_RH); const float* gpc = (const float*)(P.ws + A_RPC);
#define RS_LOAD(S, cqx) do { const size_t un_ = (size_t)(bd * 128 + ((cqx) < 128 ? (cqx) : 127)) * 8 + head; \
        _Pragma("unroll") for (int ks = 0; ks < 4; ++ks) S.lam[ks] = *(const bf16x8*)(glam + un_ * 4096 + (ct * 4 + ks) * 512 + lane * 8); \
        S.ps0 = *(const u32x4*)(gpsi + un_ * 4096 + (ct * 2 + vt) * 1024 + lane * 16); S.ps1 = *(const u32x4*)(gpsi + un_ * 4096 + (ct * 2 + vt) * 1024 + lane * 16 + 8); \
        _Pragma("unroll") for (int qd = 0; qd < 4; ++qd) S.pc[qd] = *(const f32x4*)(gpc + un_ * 64 + 32 * ct + 8 * qd + 4 * h5); } while (0)
#define RS_STEP(CUR, NXT, cqx) do { const size_t uu_ = (size_t)(bd * 128 + (cqx)) * 8 + head; const int par_ = (cqx) & 1; \
        { u32x4 w0, w1; w0.x = pk2(Hm[0], Hm[1]); w0.y = pk2(Hm[2], Hm[3]); w0.z = pk2(Hm[4], Hm[5]); w0.w = pk2(Hm[6], Hm[7]); w1.x = pk2(Hm[8], Hm[9]); w1.y = pk2(Hm[10], Hm[11]); w1.z = pk2(Hm[12], Hm[13]); w1.w = pk2(Hm[14], Hm[15]); \
          LAS bf16* lf = Hf + (((par_ * 2 + vt) * 4) + 2 * ct) * 512 + lane * 8; *(LAS u32x4*)lf = w0; *(LAS u32x4*)(lf + 512) = w1; \
          bf16* gf = gh + uu_ * 4096 + (vt * 4 + 2 * ct) * 512 + lane * 8; *(u32x4*)gf = w0; *(u32x4*)(gf + 512) = w1; } \
        RS_LOAD(NXT, (cqx) + 2); \
        asm volatile("s_waitcnt lgkmcnt(0)" ::: "memory"); __builtin_amdgcn_s_barrier(); asm volatile("" ::: "memory"); \
        bf16x8 hv[4]; const LAS bf16* hb = Hf + ((par_ * 2 + vt) * 4) * 512 + lane * 8; \
        _Pragma("unroll") for (int ks = 0; ks < 4; ++ks) hv[ks] = *(const LAS bf16x8*)(hb + ks * 512); \
        f32x16 acc; { float f[8]; unpack8(CUR.ps0, f); _Pragma("unroll") for (int j = 0; j < 4; ++j) { acc[j] = CUR.pc[0][j] * Hm[j] + f[j]; acc[4 + j] = CUR.pc[1][j] * Hm[4 + j] + f[4 + j]; } \
          unpack8(CUR.ps1, f); _Pragma("unroll") for (int j = 0; j < 4; ++j) { acc[8 + j] = CUR.pc[2][j] * Hm[8 + j] + f[j]; acc[12 + j] = CUR.pc[3][j] * Hm[12 + j] + f[4 + j]; } } \
        asm volatile("s_waitcnt lgkmcnt(0)" ::: "memory"); __builtin_amdgcn_sched_barrier(0); \
        _Pragma("unroll") for (int ks = 0; ks < 4; ++ks) acc = MFMA32(CUR.lam[ks], hv[ks], acc); \
        Hm = acc; } while (0)
    RwkvScanOps A, B, C;
    RS_LOAD(A, 0); RS_LOAD(B, 1);
#pragma unroll 1
    for (int cq = 0; cq < 126; cq += 3) { RS_STEP(A, C, cq); RS_STEP(B, A, cq + 1); RS_STEP(C, B, cq + 2); }
    RS_STEP(A, C, 126); RS_STEP(B, A, 127);
#undef RS_LOAD
#undef RS_STEP
}
__device__ __forceinline__ void rwkv_out_wave(Frame& F, const Params& P, int l_, int u, int lane) {
    const int head = u & 7, c = (u >> 3) & 127, b = u >> 10, h5 = lane >> 5, l31 = lane & 31; const size_t m0 = (size_t)b * SEQ + c * 64;
    const bf16* gh = (const bf16*)(P.ws + A_RH); const bf16* grt = (const bf16*)(P.ws + A_RRT); const bf16* gy0 = (const bf16*)(P.ws + A_RY0);
    const bf16* rkv = (const bf16*)(P.ws + A_RKV); const bf16* rkdir = (const bf16*)(P.ws + A_RKDIR); const bf16* rg = (const bf16*)(P.ws + A_RG); bf16* ymix = (bf16*)(P.ws + A_YMIX);
    const float* r_k = P.in[I_R_RK] + (size_t)l_ * 512; const float* lng = P.in[I_R_LNG] + (size_t)l_ * 512; const float* lnb = P.in[I_R_LNB] + (size_t)l_ * 512;
    LAS float* Yst = (LAS float*)(F.lds + F.wave * 17408);
    const size_t uf = (size_t)((b * 2 + 0) * 128 + c) * 8 + head, ub = (size_t)((b * 2 + 1) * 128 + (127 - c)) * 8 + head;
    bf16x8 hf[2][4], hb[2][4];
#pragma unroll
    for (int vt = 0; vt < 2; ++vt)
#pragma unroll
        for (int ks = 0; ks < 4; ++ks) { hf[vt][ks] = *(const bf16x8*)(gh + uf * 4096 + (vt * 4 + ks) * 512 + lane * 8); hb[vt][ks] = *(const bf16x8*)(gh + ub * 4096 + (vt * 4 + ks) * 512 + lane * 8); }
#pragma unroll
    for (int tt = 0; tt < 2; ++tt) { bf16x8 rf[4], rb[4];
#pragma unroll
        for (int ks = 0; ks < 4; ++ks) { rf[ks] = *(const bf16x8*)(grt + uf * 4096 + (tt * 4 + ks) * 512 + lane * 8); rb[ks] = *(const bf16x8*)(grt + ub * 4096 + (tt * 4 + ks) * 512 + lane * 8); }
#pragma unroll
        for (int vt = 0; vt < 2; ++vt) { f32x16 acc = zero16();
            ld_acc_add(gy0 + uf * 4096 + (vt * 2 + tt) * 1024, acc, lane); ld_acc_add(gy0 + ub * 4096 + (vt * 2 + tt) * 1024, acc, lane);
#pragma unroll
            for (int ks = 0; ks < 4; ++ks) { acc = MFMA32(hf[vt][ks], rf[ks], acc); acc = MFMA32(hb[vt][ks], rb[ks], acc); }
#pragma unroll
            for (int qd = 0; qd < 4; ++qd) *(LAS f32x4*)(Yst + (32 * tt + l31) * 68 + 32 * vt + 8 * qd + 4 * h5) = (f32x4){acc[4 * qd], acc[4 * qd + 1], acc[4 * qd + 2], acc[4 * qd + 3]}; } }
    const int v0 = 8 * (lane & 7), ch = head * 64 + v0;
    const f32x4 rk0 = *(const f32x4*)(r_k + ch), rk1 = *(const f32x4*)(r_k + ch + 4), g0 = *(const f32x4*)(lng + ch), g1 = *(const f32x4*)(lng + ch + 4), c0 = *(const f32x4*)(lnb + ch), c1 = *(const f32x4*)(lnb + ch + 4);
    u32x4 nr, nv, nk0, nk1, ng;
#define RO_LD(pass_) do { const size_t m_ = m0 + (pass_) * 8 + (lane >> 3); nr = *(const u32x4*)(rkv + m_ * 1536 + ch); nv = *(const u32x4*)(rkv + m_ * 1536 + 1024 + ch); \
        nk0 = *(const u32x4*)(rkdir + m_ * 1024 + ch); nk1 = *(const u32x4*)(rkdir + m_ * 1024 + 512 + ch); ng = *(const u32x4*)(rg + m_ * 512 + ch); } while (0)
    RO_LD(0);
    LDS_WAIT();
#pragma unroll 1
    for (int pass = 0; pass < 8; ++pass) { const int tok = pass * 8 + (lane >> 3); const size_t m = m0 + tok;
      const f32x4 a0 = *(const LAS f32x4*)(Yst + tok * 68 + v0), a1 = *(const LAS f32x4*)(Yst + tok * 68 + v0 + 4); float y[8] = {a0[0], a0[1], a0[2], a0[3], a1[0], a1[1], a1[2], a1[3]}, r[8], v[8], kd0[8], kd1[8], gg[8];
      unpack8(nr, r); unpack8(nv, v); unpack8(nk0, kd0); unpack8(nk1, kd1); unpack8(ng, gg);
      if (pass < 7) RO_LD(pass + 1);
      float sm = 0.f;
#pragma unroll
      for (int j = 0; j < 8; ++j) sm += y[j];
      sm += __shfl_xor(sm, 1); sm += __shfl_xor(sm, 2); sm += __shfl_xor(sm, 4);
      const float mu = sm * (1.f / 64.f); float q = 0.f;
#pragma unroll
      for (int j = 0; j < 8; ++j) { y[j] -= mu; q += y[j] * y[j]; }
      q += __shfl_xor(q, 1); q += __shfl_xor(q, 2); q += __shfl_xor(q, 4);
      const float rs = rsqrtf(q * (1.f / 64.f) + 64e-5f);
      float bo = 0.f;
#pragma unroll
      for (int j = 0; j < 8; ++j) bo += r[j] * (kd0[j] + kd1[j]) * (j < 4 ? rk0[j] : rk1[j - 4]);
      bo += __shfl_xor(bo, 1); bo += __shfl_xor(bo, 2); bo += __shfl_xor(bo, 4);
#pragma unroll
      for (int j = 0; j < 8; ++j) y[j] = (y[j] * rs * (j < 4 ? g0[j] : g1[j - 4]) + (j < 4 ? c0[j] : c1[j - 4]) + bo * v[j]) * gg[j];
      *(u32x4*)(ymix + m * 2048 + 512 + ch) = pack8(y); }
#undef RO_LD
    LDS_WAIT();
}
__device__ __forceinline__ void phase_rwkv_out(Frame& F, const Params& P, int l) {
    int lane = F.lane; asm volatile("" : "+v"(lane));
    for (int u = F.vcu * NWAVES + F.wave; u < 2048; u += F.G * NWAVES) rwkv_out_wave(F, P, l, u, lane);
}


__device__ __forceinline__ void phase_ln1_router(Frame& F, const Params& P, int l) {
    int lane = F.lane; asm volatile("" : "+v"(lane)); int tid = F.tid; asm volatile("" : "+v"(tid));
    const int gw = F.vcu * NWAVES + F.wave;
    const float* wr = P.in[I_W_RT] + (size_t)l * 1024 * 32; const float* br = P.in[I_B_RT] + (size_t)l * 32;
    const float* g1 = P.in[I_LN1G] + (size_t)l * DM; const float* b1 = P.in[I_LN1B] + (size_t)l * DM;
    LAS int* hist = (LAS int*)(F.lds + L_EXTRA); LAS int* base = hist + 32; LAS float* gb = (LAS float*)(F.lds + L_EXTRA + 512);
    for (int f = tid; f < 4096; f += NTHR) { const int fl = f & 63, st = f >> 6, e = 16 * (st & 1) + (fl & 15), d0 = 32 * (st >> 1) + 4 * (fl >> 4);
        float w[8];
#pragma unroll
        for (int i = 0; i < 8; ++i) w[i] = wr[(size_t)(d0 + (i < 4 ? i : 12 + i)) * 32 + e];
        u32x4 hi, lo; hi.x = pk2(w[0], w[1]); hi.y = pk2(w[2], w[3]); hi.z = pk2(w[4], w[5]); hi.w = pk2(w[6], w[7]);
        lo.x = pk2(w[0] - bflo(hi.x), w[1] - bfhi(hi.x)); lo.y = pk2(w[2] - bflo(hi.y), w[3] - bfhi(hi.y)); lo.z = pk2(w[4] - bflo(hi.z), w[5] - bfhi(hi.z)); lo.w = pk2(w[6] - bflo(hi.w), w[7] - bfhi(hi.w));
        *(LAS u32x4*)(F.lds + f * 16) = hi; *(LAS u32x4*)(F.lds + 65536 + f * 16) = lo; }
    if (tid < 256) *(LAS f32x4*)(gb + 4 * tid) = *(const f32x4*)(g1 + 4 * tid); else *(LAS f32x4*)(gb + 4 * tid) = *(const f32x4*)(b1 + 4 * (tid - 256));
    if (tid < 32) hist[tid] = 0;
    __syncthreads();
    const float* pre = (const float*)(P.ws + A_PRE); float* x1f = (float*)(P.ws + A_X1F); bf16* x1b = (bf16*)(P.ws + A_X1B);
    int* tope = (int*)(P.ws + A_TOPE); float* topg = (float*)(P.ws + A_TOPG); int* topr = (int*)(P.ws + A_TOPR);
    const int q = lane >> 4, m = gw * 8 + (lane & 7); const bool real = !(lane & 8) && m < MTOK;
    int my_e = 0, my_r = 0;
    if (gw * 8 < MTOK) {
        const float* prow = pre + (size_t)m * DM + 4 * q;
        float s1 = 0.f, s2 = 0.f;
        { f32x4 vq[16];
#pragma unroll
          for (int u = 0; u < 8; ++u) { vq[2 * u] = *(const f32x4*)(prow + 32 * u); vq[2 * u + 1] = *(const f32x4*)(prow + 32 * u + 16); }
#pragma unroll 1
          for (int sb = 0; sb < 32; sb += 8) { f32x4 v[16];
#pragma unroll
            for (int u = 0; u < 16; ++u) v[u] = vq[u];
            { const int sn = sb + 8 < 32 ? sb + 8 : sb;
#pragma unroll
                for (int u = 0; u < 8; ++u) { vq[2 * u] = *(const f32x4*)(prow + 32 * (sn + u)); vq[2 * u + 1] = *(const f32x4*)(prow + 32 * (sn + u) + 16); } }
#pragma unroll
            for (int u = 0; u < 16; ++u) { s1 += (v[u].x + v[u].y) + (v[u].z + v[u].w); s2 += (v[u].x * v[u].x + v[u].y * v[u].y) + (v[u].z * v[u].z + v[u].w * v[u].w); } } }
        f32x4 vn[8];
#pragma unroll
        for (int u = 0; u < 4; ++u) { vn[2 * u] = *(const f32x4*)(prow + 32 * u); vn[2 * u + 1] = *(const f32x4*)(prow + 32 * u + 16); }
        s1 += __shfl_xor(s1, 16); s1 += __shfl_xor(s1, 32); s2 += __shfl_xor(s2, 16); s2 += __shfl_xor(s2, 32);
        const float mean = s1 * (1.f / DM); const float var = fmaxf(s2 * (1.f / DM) - mean * mean, 0.f); const float rstd = 1.f / sqrtf(var + LN_EPS);
        f32x4 acc0 = {0.f, 0.f, 0.f, 0.f}, acc1 = {0.f, 0.f, 0.f, 0.f};
        float* of = x1f + (size_t)m * DM + 4 * q; bf16* ob = x1b + (size_t)m * DM + 4 * q;
#pragma unroll 1
        for (int sb = 0; sb < 32; sb += 4) { f32x4 v[8];
#pragma unroll
            for (int u = 0; u < 8; ++u) v[u] = vn[u];
            { const int sn = sb + 4 < 32 ? sb + 4 : sb;
#pragma unroll
                for (int u = 0; u < 4; ++u) { vn[2 * u] = *(const f32x4*)(prow + 32 * (sn + u)); vn[2 * u + 1] = *(const f32x4*)(prow + 32 * (sn + u) + 16); } }
#pragma unroll
            for (int u = 0; u < 4; ++u) { const int s = sb + u;
                const f32x4 gA = *(const LAS f32x4*)(gb + 32 * s + 4 * q), gB = *(const LAS f32x4*)(gb + 32 * s + 16 + 4 * q), bA = *(const LAS f32x4*)(gb + 1024 + 32 * s + 4 * q), bB = *(const LAS f32x4*)(gb + 1024 + 32 * s + 16 + 4 * q);
                const f32x4 xa = (v[2 * u] - mean) * rstd * gA + bA, xb = (v[2 * u + 1] - mean) * rstd * gB + bB;
                u32x4 H; H.x = pk2(xa.x, xa.y); H.y = pk2(xa.z, xa.w); H.z = pk2(xb.x, xb.y); H.w = pk2(xb.z, xb.w);
                if (real) { *(f32x4*)(of + 32 * s) = xa; *(f32x4*)(of + 32 * s + 16) = xb; *(u32x2*)(ob + 32 * s) = (u32x2){H.x, H.y}; *(u32x2*)(ob + 32 * s + 16) = (u32x2){H.z, H.w}; }
                u32x4 L; L.x = pk2(xa.x - bflo(H.x), xa.y - bfhi(H.x)); L.y = pk2(xa.z - bflo(H.y), xa.w - bfhi(H.y)); L.z = pk2(xb.x - bflo(H.z), xb.y - bfhi(H.z)); L.w = pk2(xb.z - bflo(H.w), xb.w - bfhi(H.w));
                const bf16x8 Hh = __builtin_bit_cast(bf16x8, H), Ll = __builtin_bit_cast(bf16x8, L);
                const bf16x8 Wh0 = *(const LAS bf16x8*)(F.lds + ((2 * s) * 64 + lane) * 16), Wh1 = *(const LAS bf16x8*)(F.lds + ((2 * s + 1) * 64 + lane) * 16);
                const bf16x8 Wl0 = *(const LAS bf16x8*)(F.lds + 65536 + ((2 * s) * 64 + lane) * 16), Wl1 = *(const LAS bf16x8*)(F.lds + 65536 + ((2 * s + 1) * 64 + lane) * 16);
                acc0 = __builtin_amdgcn_mfma_f32_16x16x32_bf16(Wh0, Hh, acc0, 0, 0, 0); acc1 = __builtin_amdgcn_mfma_f32_16x16x32_bf16(Wh1, Hh, acc1, 0, 0, 0);
                acc0 = __builtin_amdgcn_mfma_f32_16x16x32_bf16(Wl0, Hh, acc0, 0, 0, 0); acc1 = __builtin_amdgcn_mfma_f32_16x16x32_bf16(Wl1, Hh, acc1, 0, 0, 0);
                acc0 = __builtin_amdgcn_mfma_f32_16x16x32_bf16(Wh0, Ll, acc0, 0, 0, 0); acc1 = __builtin_amdgcn_mfma_f32_16x16x32_bf16(Wh1, Ll, acc1, 0, 0, 0); } }
        unsigned key[8];
#pragma unroll
        for (int j = 0; j < 8; ++j) { const int e = 16 * (j >> 2) + 4 * q + (j & 3); const float lg = (j < 4 ? acc0[j & 3] : acc1[j & 3]) + br[e];
            unsigned u = __builtin_bit_cast(unsigned, lg); u = (u & 0x80000000u) ? ~u : (u | 0x80000000u); key[j] = (u & ~31u) | (unsigned)(31 - e); }
        unsigned M[4];
#pragma unroll
        for (int r = 0; r < 4; ++r) { unsigned mx = max(max(max(key[0], key[1]), max(key[2], key[3])), max(max(key[4], key[5]), max(key[6], key[7])));
            mx = max(mx, (unsigned)__shfl_xor((int)mx, 16)); mx = max(mx, (unsigned)__shfl_xor((int)mx, 32)); M[r] = mx;
#pragma unroll
            for (int j = 0; j < 8; ++j) key[j] = key[j] == mx ? 0u : key[j]; }
        float tv[4];
#pragma unroll
        for (int r = 0; r < 4; ++r) { const unsigned ub = M[r] & ~31u; tv[r] = __builtin_bit_cast(float, (ub & 0x80000000u) ? (ub & 0x7fffffffu) : ~ub); }
        const float e1 = __expf(tv[1] - tv[0]), e2 = __expf(tv[2] - tv[0]), e3 = __expf(tv[3] - tv[0]), inv = 1.f / (1.f + e1 + e2 + e3);
        if (real) { const unsigned mk = q == 0 ? M[0] : q == 1 ? M[1] : q == 2 ? M[2] : M[3]; const int e = 31 - (int)(mk & 31u); const float gt = (q == 0 ? 1.f : q == 1 ? e1 : q == 2 ? e2 : e3) * inv;
            my_e = e; my_r = __hip_atomic_fetch_add(hist + e, 1, __ATOMIC_RELAXED, __HIP_MEMORY_SCOPE_WORKGROUP);
            tope[(size_t)m * 4 + q] = e; topg[(size_t)m * 4 + q] = gt; }
    }
    __syncthreads();
    if (tid < 32) base[tid] = (int)__hip_atomic_fetch_add((unsigned*)(F.ctl + CW_GCNT + l * 32 + tid), (unsigned)hist[tid], RLX_AGENT);
    __syncthreads();
    if (real) topr[(size_t)m * 4 + q] = base[my_e] + my_r;
    __syncthreads();
}
constexpr int L_MOE = L_MISC - 2048;
__device__ __forceinline__ MoeTab moe_tables(Frame& F, int l) {
    LAS int* ps = (LAS int*)(F.lds + L_MOE); LAS int* pe = ps + 64;
    __syncthreads();
    if (F.tid < 32) { const int e = F.tid;
        const int c = (int)__hip_atomic_load((unsigned*)(F.ctl + CW_GCNT + l * 32 + e), RLX_AGENT); const int np = (c + 255) >> 8;
        int incl = np;
#pragma unroll
        for (int o = 1; o < 32; o <<= 1) { const int t = __shfl_up(incl, o, 32); if (e >= o) incl += t; }
        const int st = incl - np < 288 ? incl - np : 288, en = incl < 288 ? incl : 288;
        ps[e] = st; for (int p = st; p < en; ++p) pe[p] = e;
        if (e == 31) ps[32] = en; }
    __syncthreads();
    MoeTab T; T.pstart = ps; T.panel_e = pe; T.npanels = ps[32]; return T;
}
__device__ __forceinline__ void phase_dispatch(Frame& F, const Params& P, const MoeTab& T) {
    const int* tope = (const int*)(P.ws + A_TOPE); const int* topr = (const int*)(P.ws + A_TOPR); int* rowtok = (int*)(P.ws + A_ROWTOK);
    int tid = F.tid; asm volatile("" : "+v"(tid));
    for (int s = F.vcu * NTHR + tid; s < MTOK * 4; s += F.G * NTHR) { const int e = tope[s], r = topr[s]; const int pos = T.pstart[e] * 256 + r; if (pos < MPAD) rowtok[pos] = s >> 2; }
    for (int s = F.vcu * NTHR + tid; s < MTOK; s += F.G * NTHR) rowtok[MPAD + s] = s;
}
__device__ __forceinline__ void phase_ln2(Frame& F, const Params& P, int l, const MoeTab& T, float* outf, bf16* outb) {
    int lane = F.lane; asm volatile("" : "+v"(lane));
    const int gw = F.vcu * NWAVES + F.wave, NGW = F.G * NWAVES;
    const float* x1f = (const float*)(P.ws + A_X1F); const bf16* ye = (const bf16*)(P.ws + A_YE); const bf16* pleb = (const bf16*)(P.ws + A_PLEB);
    const int* tope = (const int*)(P.ws + A_TOPE); const float* topg = (const float*)(P.ws + A_TOPG); const int* topr = (const int*)(P.ws + A_TOPR);
    const float* g2 = P.in[I_LN2G] + (size_t)l * DM; const float* b2 = P.in[I_LN2B] + (size_t)l * DM;
    f32x4 gq_[2][2], bq_[2][2];
#pragma unroll
    for (int q = 0; q < 2; ++q) { const int ch = 8 * lane + 512 * q; gq_[q][0] = *(const f32x4*)(g2 + ch); gq_[q][1] = *(const f32x4*)(g2 + ch + 4); bq_[q][0] = *(const f32x4*)(b2 + ch); bq_[q][1] = *(const f32x4*)(b2 + ch + 4); }
    for (int m = gw; m < MTOK; m += NGW) {
        float v[16];
#pragma unroll
        for (int q = 0; q < 2; ++q) { const int ch = 8 * lane + 512 * q; const f32x4 a0 = *(const f32x4*)(x1f + (size_t)m * DM + ch), a1 = *(const f32x4*)(x1f + (size_t)m * DM + ch + 4);
            float pl[8]; unpack8(*(const u32x4*)(pleb + (size_t)m * DM + ch), pl);
#pragma unroll
            for (int j = 0; j < 8; ++j) v[8 * q + j] = DN_ALPHA * (j < 4 ? a0[j] : a1[j - 4]) + pl[j]; }
#pragma unroll
        for (int k = 0; k < 4; ++k) { const int e = tope[(size_t)m * 4 + k], r = topr[(size_t)m * 4 + k]; const float gt = topg[(size_t)m * 4 + k]; int pos = T.pstart[e] * 256 + r; pos = pos < MPAD ? pos : MPAD - 1;
#pragma unroll
            for (int q = 0; q < 2; ++q) { float y[8]; unpack8(*(const u32x4*)(ye + (size_t)pos * DM + 8 * lane + 512 * q), y);
#pragma unroll
                for (int j = 0; j < 8; ++j) v[8 * q + j] += gt * y[j]; } }
        float s = 0.f;
#pragma unroll
        for (int j = 0; j < 16; ++j) s += v[j];
        const float mean = wave_sum(s) * (1.f / DM); float s2 = 0.f;
#pragma unroll
        for (int j = 0; j < 16; ++j) { v[j] -= mean; s2 += v[j] * v[j]; }
        const float rstd = 1.f / sqrtf(wave_sum(s2) * (1.f / DM) + LN_EPS);
#pragma unroll
        for (int q = 0; q < 2; ++q) { const int ch = 8 * lane + 512 * q; const f32x4 ga = gq_[q][0], gb = gq_[q][1], ba = bq_[q][0], bb = bq_[q][1];
            float o[8];
#pragma unroll
            for (int j = 0; j < 8; ++j) o[j] = v[8 * q + j] * rstd * (j < 4 ? ga[j] : gb[j - 4]) + (j < 4 ? ba[j] : bb[j - 4]);
            *(f32x4*)(outf + (size_t)m * DM + ch) = (f32x4){o[0], o[1], o[2], o[3]}; *(f32x4*)(outf + (size_t)m * DM + ch + 4) = (f32x4){o[4], o[5], o[6], o[7]};
            if (outb) *(u32x4*)(outb + (size_t)m * DM + ch) = pack8(o); }
    }
}

#ifndef STOP_AT
#define STOP_AT 1000
#endif
#define GRID_BAR() xcd_barrier(bar)
#define CKPT(n) do { if (l * 100 + (n) >= STOP_AT) return; } while (0)
template <int l> __device__ __forceinline__ void layer_body(Frame& F, const Params& P, const XcdBarrier& bar) {
    const int c = (int)blockIdx.x, G = F.G;
    { SchedPlain S{(const char*)(P.ws + A_XB), (const char*)(P.ws + WS_W_IN + l * W_IN_SZ), 2048, 2048, 16, 64, NPN_IN, G, c};
      EpiInproj E{(bf16*)(P.ws + A_COLS), (float*)(P.ws + A_SIDE)};
      pg8::gemm_phase<false>(F.lds + L_STAGE, S, E, 2048, 2048, nullptr); }
    GRID_BAR(); CKPT(1);
    phase_prep(F, P, l);
    GRID_BAR(); CKPT(2);
    { SchedPlain S{(const char*)(P.ws + A_LIN), (const char*)(P.ws + WS_W_LORA + l * W_LORA_SZ), 768, 768, 6, 64, 10, G, c};
      EpiLora E{(float*)(P.ws + A_RLOGW), (bf16*)(P.ws + A_RKDIR), (bf16*)(P.ws + A_RKKA), (bf16*)(P.ws + A_RG), (const bf16*)(P.ws + A_RKV), (const bf16*)(P.ws + A_RKK),
                P.in[I_R_W0] + (size_t)l * 1024, P.in[I_R_A0] + (size_t)l * 1024, P.in[I_R_KA] + (size_t)l * 512};
      pg8::gemm_phase<false>(F.lds + L_STAGE, S, E, 768, 768, nullptr); }
    phase_ssd_states(F, P);
    GRID_BAR(); CKPT(3);
    phase_gdn_a(F, P);
    phase_rwkv_a(F, P);
    { int lane2 = F.lane; asm volatile("" : "+v"(lane2)); for (int item = (F.vcu * NWAVES + F.wave) * 64 + lane2; item < 64 * 2048; item += F.G * NTHR) ssd_scan_item(P, item); }
    GRID_BAR();
    phase_scan_seq(F, P, l);
    GRID_BAR(); CKPT(4);
    phase_gdn_out(F, P, l);
    phase_rwkv_out(F, P, l);
    GRID_BAR(); CKPT(5);
    { SchedBranch S{(const char*)(P.ws + A_YMIX), (const char*)(P.ws + WS_W_BR + l * W_BR_SZ), G, c};
      EpiBranch E{(const bf16*)(P.ws + A_COLS), (bf16*)(P.ws + A_MERGED)};
      pg8::gemm_phase<false>(F.lds + L_STAGE, S, E, 4096, 4096, nullptr); }
    GRID_BAR(); CKPT(6);
    { SchedPlain S{(const char*)(P.ws + A_MERGED), (const char*)(P.ws + WS_W_O + l * W_SQ_SZ), 2048, 2048, 16, 64, 4, G, c};
      EpiWo E{(const float*)(P.ws + A_XF), (float*)(P.ws + A_PRE)};
      pg8::gemm_phase<false>(F.lds + L_STAGE, S, E, 2048, 2048, nullptr); }
    GRID_BAR(); CKPT(7);
    phase_ln1_router(F, P, l);
    GRID_BAR(); CKPT(8);
    MoeTab T = moe_tables(F, l);
    phase_dispatch(F, P, T);
    GRID_BAR(); CKPT(9);
    { SchedGu S{(const char*)(P.ws + A_X1B), (const char*)(P.ws + WS_W_GU + (size_t)l * 32 * W_GU_SZ), (const char*)(P.ws + WS_W_PLG + l * W_SQ_SZ), T, G, c};
      EpiGuPlg E{EpiGu{(bf16*)(P.ws + A_ACT), P.in[I_B_GU] + (size_t)l * 32 * 2048}, EpiPlg{(bf16*)(P.ws + A_SG)}};
      pg8::gemm_phase<true>(F.lds + L_STAGE, S, E, 2048, 2048, (const int*)(P.ws + A_ROWTOK)); }
    GRID_BAR(); CKPT(10);
    { SchedDnPle S{(const char*)(P.ws + A_ACT), (const char*)(P.ws + WS_W_DN + (size_t)l * 32 * W_SQ_SZ), (const char*)(P.ws + A_PB + (size_t)l * MTOK * 2048), (const char*)(P.ws + WS_W_PL + l * W_PL_SZ), (const char*)(P.ws + A_X1B), (const char*)(P.ws + WS_W_PLG + l * W_SQ_SZ), T, G, c};
      EpiDnPle E{(bf16*)(P.ws + A_YE), P.in[I_B_DN] + (size_t)l * 32 * 1024, (bf16*)(P.ws + A_PLEB), (const bf16*)(P.ws + A_SG), (bf16*)(P.ws + A_SG)};
      pg8::gemm_phase<false>(F.lds + L_STAGE, S, E, 2048, 2048, nullptr); }
    GRID_BAR(); CKPT(11);
    if (l + 1 < DEPTH) phase_ln2(F, P, l, T, (float*)(P.ws + A_XF), (bf16*)(P.ws + A_XB));
    else phase_ln2(F, P, l, T, P.out, nullptr);
    if (l + 1 < DEPTH) GRID_BAR(); CKPT(12);
}

__global__ void __launch_bounds__(NTHR, 2) fwd_kernel(Params P) {
    extern __shared__ __attribute__((aligned(16))) unsigned char lds_raw[];
    Frame F;
    F.lds = (LAS unsigned char*)lds_raw; F.MISC = (volatile LAS unsigned*)(F.lds + L_MISC);
    F.tid = threadIdx.x; F.lane = F.tid & 63; F.wave = __builtin_amdgcn_readfirstlane(F.tid >> 6);
    F.G = gridDim.x; { const int bx = blockIdx.x; F.vcu = (bx % 8) * (F.G / 8) + bx / 8; }
    F.ws = P.ws; F.ctl = (gu32*)(P.ws + WS_CTL);
    if (F.tid < 64) F.MISC[F.tid] = 0u;
    __syncthreads();
    XcdBarrier bar = xcd_barrier_post((unsigned*)(F.ctl + CW_BAR), F.MISC + 8);

    phase_prologue(F, P);
    GRID_BAR();
    if (STOP_AT <= 0) return;
    layer_body<0>(F, P, bar);
    if (STOP_AT < 100) return;
    layer_body<1>(F, P, bar);
}

extern "C" void kernel_launch(void* const* d_in, const int* in_sizes, int n_in, void* d_out, int out_size, void* d_ws, size_t ws_size, hipStream_t stream) {
    static int grid = 0;
    if (grid == 0) {
        if (n_in != 41 || out_size != MTOK * DM || ws_size < WS_END) { fprintf(stderr, "kernel_launch: unexpected shapes (n_in %d, out %d, ws %zu < %zu)\n", n_in, out_size, ws_size, (size_t)WS_END); grid = -1; return; }
        static const int exp_sizes[41] = {16777216, 8388608, 1024, 1024, 19759104, 15360, 16, 16, 256, 3840, 3840, 2048, 131072, 2048, 131072, 131072, 1024, 1024, 1024, 1024, 1024,
            15360, 3072, 64, 64, 32, 2048, 4194304, 2097152, 2048, 2048, 65536, 64, 134217728, 131072, 67108864, 65536, 524288, 2097152, 2048, 2048};
        for (int i = 0; i < 41; ++i) if (in_sizes[i] != exp_sizes[i]) { fprintf(stderr, "kernel_launch: input %d has %d elements, expected %d\n", i, in_sizes[i], exp_sizes[i]); grid = -1; return; }
        int dev = 0, cus = 0, per_cu = 0;
        if (hipGetDevice(&dev) != hipSuccess || hipDeviceGetAttribute(&cus, hipDeviceAttributeMultiprocessorCount, dev) != hipSuccess) { grid = -1; return; }
        if (hipFuncSetAttribute((const void*)fwd_kernel, hipFuncAttributeMaxDynamicSharedMemorySize, LDS_BYTES) != hipSuccess) { fprintf(stderr, "kernel_launch: hipFuncSetAttribute failed\n"); grid = -1; return; }
        if (hipOccupancyMaxActiveBlocksPerMultiprocessor(&per_cu, (const void*)fwd_kernel, NTHR, LDS_BYTES) != hipSuccess || per_cu < 1) { fprintf(stderr, "kernel_launch: occupancy query says %d\n", per_cu); }
        (void)hipGetLastError();
        grid = cus;
        if (grid != 256) { fprintf(stderr, "kernel_launch: built for 256 CUs, device has %d\n", cus); grid = -1; return; }
    }
    if (grid < 0) return;
    (void)hipMemsetAsync((char*)d_ws + WS_CTL, 0, CTL_ZERO_BYTES, stream);
    Params p{};
    for (int i = 0; i < 41; ++i) p.in[i] = (const float*)d_in[i];
    p.out = (float*)d_out; p.ws = (unsigned char*)d_ws;
    hipLaunchKernelGGL(fwd_kernel, dim3(grid), dim3(NTHR), LDS_BYTES, stream, p);
}
```
